# Optimizing an MI355X kernel written in HIP

```python
import math
import jax, jax.numpy as jnp
from jax import lax
import numpy as np

D_MODEL = 1024
BATCH = 8
SEQ = 4096
DEPTH = 2

CHUNK = 64
EPS = 1e-6
A_HEADS = 8
A_HEAD_DIM = 64
A_WIDTH = A_HEADS * A_HEAD_DIM
KV_RANK = 128
IDX_HEADS = 4
IDX_DIM = 64
TOPK_MAX = 256
Q_BLOCK = 128
S5_WIDTH = 512
S5_GROUP = 16
S5_GROUPS = S5_WIDTH // S5_GROUP
S5_STATE = 64
DT_MIN = 0.001
DT_MAX = 0.1
C_HEADS = 4
C_HEAD_DIM = 128
C_WIDTH = C_HEADS * C_HEAD_DIM
C_CONV = 4
D_FF = 2816
FFN_CONV = 3
N_BRANCH = 3
IN_SPLITS = (A_WIDTH, KV_RANK, IDX_HEADS * IDX_DIM, IDX_DIM, IDX_HEADS,
             S5_WIDTH,
             3 * C_WIDTH, C_WIDTH, C_HEADS, C_HEADS,
             N_BRANCH * D_MODEL)
N_IN = (A_WIDTH + KV_RANK + IDX_HEADS * IDX_DIM + IDX_DIM + IDX_HEADS + S5_WIDTH
        + 3 * C_WIDTH + C_WIDTH + 2 * C_HEADS + N_BRANCH * D_MODEL)

kernel_name = 'hybrid_dsa_s5_gdn_encoder'


def rms_norm(x, g):
    xf = x.astype(jnp.float32)
    y = xf * lax.rsqrt(jnp.mean(xf * xf, axis=-1, keepdims=True) + EPS)
    return (y * g.astype(jnp.float32)).astype(x.dtype)


def l2_norm(x):
    return x * lax.rsqrt(jnp.sum(x * x, axis=-1, keepdims=True) + EPS)


def causal_dwconv(x, w):
    k = w.shape[0]
    t = x.shape[1]
    xp = jnp.pad(x, ((0, 0), (k - 1, 0), (0, 0)))
    out = xp[:, 0:t] * w[0]
    for j in range(1, k):
        out = out + xp[:, j:j + t] * w[j]
    return out


def dsa_attention(q, c_kv, iq, ik, iw, kv_norm_g, w_uk, w_uv):
    b, t = q.shape[0], q.shape[1]
    topk = min(TOPK_MAX, t // 4)
    nb = t // Q_BLOCK
    c_kv = rms_norm(c_kv, kv_norm_g)
    q_lat = jnp.einsum('bthd,rhd->bthr', q, w_uk) * (A_HEAD_DIM ** -0.5)
    iw = iw * (IDX_HEADS ** -0.5)
    key_pos = jnp.arange(t)

    def to_blocks(a):
        a = a.reshape((b, nb, Q_BLOCK) + a.shape[2:])
        return jnp.moveaxis(a, 1, 0)

    def block(args):
        qb, iqb, iwb, pos = args
        limit = (pos // CHUNK + 1) * CHUNK
        adm = key_pos[None, :] < limit[:, None]
        rel = jax.nn.relu(jnp.einsum('bqhd,bsd->bqhs', iqb, ik) * (IDX_DIM ** -0.5))
        score = jnp.einsum('bqhs,bqh->bqs', rel, iwb).astype(jnp.float32)
        score = jnp.where(adm[None], score, -jnp.inf)
        _, idx = lax.top_k(score, topk)
        valid = idx < limit[None, :, None]
        c_sel = jax.vmap(lambda c, i: c[i])(c_kv, idx)
        logits = jnp.einsum('bqhr,bqkr->bqhk', qb, c_sel).astype(jnp.float32)
        logits = jnp.where(valid[:, :, None, :], logits, -jnp.inf)
        p = jax.nn.softmax(logits, axis=-1).astype(c_sel.dtype)
        o_lat = jnp.einsum('bqhk,bqkr->bqhr', p, c_sel)
        return jnp.einsum('bqhr,rhd->bqhd', o_lat, w_uv)

    pos_blocks = key_pos.reshape(nb, Q_BLOCK)
    out = lax.map(block, (to_blocks(q_lat), to_blocks(iq), to_blocks(iw), pos_blocks))
    return jnp.moveaxis(out, 0, 1).reshape(b, t, A_WIDTH)


def _complex_affine_combine(e1, e2):
    a1r, a1i, b1r, b1i = e1
    a2r, a2i, b2r, b2i = e2
    return (a1r * a2r - a1i * a2i,
            a1r * a2i + a1i * a2r,
            a2r * b1r - a2i * b1i + b2r,
            a2r * b1i + a2i * b1r + b2i)


def s5_branch(u, a_re, a_im, log_dt, b_re, b_im, c_re, c_im, d, w_glu):
    bsz, t = u.shape[0], u.shape[1]
    f32 = jnp.float32
    uf = u.astype(f32).reshape(bsz, t, S5_GROUPS, S5_GROUP)
    a_re, a_im = a_re.astype(f32), a_im.astype(f32)
    b_re, b_im = b_re.astype(f32), b_im.astype(f32)
    c_re, c_im = c_re.astype(f32), c_im.astype(f32)
    dt = jnp.exp(log_dt.astype(f32))[:, None]
    mag = jnp.exp(dt * a_re)
    ang = dt * a_im
    ab_re = mag * jnp.cos(ang)
    ab_im = mag * jnp.sin(ang)
    den = a_re * a_re + a_im * a_im
    n_re = ab_re - 1.0
    f_re = (n_re * a_re + ab_im * a_im) / den
    f_im = (ab_im * a_re - n_re * a_im) / den
    bb_re = f_re[..., None] * b_re - f_im[..., None] * b_im
    bb_im = f_re[..., None] * b_im + f_im[..., None] * b_re
    x_re = jnp.einsum('btgm,gpm->btgp', uf, bb_re)
    x_im = jnp.einsum('btgm,gpm->btgp', uf, bb_im)
    a_shape = (1, t) + ab_re.shape
    elems = (jnp.broadcast_to(ab_re, a_shape), jnp.broadcast_to(ab_im, a_shape), x_re, x_im)
    _, _, h_re, h_im = lax.associative_scan(_complex_affine_combine, elems, axis=1)
    y = (jnp.einsum('btgp,gmp->btgm', h_re, c_re) - jnp.einsum('btgp,gmp->btgm', h_im, c_im)
         + d.astype(f32).reshape(S5_GROUPS, S5_GROUP) * uf)
    y = jax.nn.gelu(y.reshape(bsz, t, S5_WIDTH).astype(u.dtype))
    return y * jax.nn.sigmoid(y @ w_glu)


def gated_delta_rule(q, k, v, g, beta):
    bsz, t, h, dk = q.shape
    dv = v.shape[-1]
    n = t // CHUNK

    def chunks(a):
        a = jnp.moveaxis(a, 2, 1)
        return a.reshape((bsz, h, n, CHUNK) + a.shape[3:])

    q = chunks(q) * (dk ** -0.5)
    k, v, g, beta = chunks(k), chunks(v), chunks(g), chunks(beta)
    gam = jnp.cumsum(g, axis=-1)
    i = jnp.arange(CHUNK)
    lower_incl = i[:, None] >= i[None, :]
    strict = i[:, None] > i[None, :]
    decay = jnp.exp(jnp.where(lower_incl, gam[..., :, None] - gam[..., None, :], -jnp.inf))
    kb = k * beta[..., None]
    m = jnp.where(strict, jnp.einsum('bhncd,bhnsd->bhncs', kb, k) * decay, 0.0)
    eye = jnp.eye(CHUNK, dtype=m.dtype)
    rhs = jnp.concatenate([v * beta[..., None], kb * jnp.exp(gam)[..., None]], axis=-1)
    sol = lax.linalg.triangular_solve(m + eye, rhs, left_side=True, lower=True, unit_diagonal=True)
    u, w = sol[..., :dv], sol[..., dv:]
    attn = jnp.einsum('bhncd,bhnsd->bhncs', q, k) * decay
    q_dec = q * jnp.exp(gam)[..., None]
    k_dec = k * jnp.exp(gam[..., -1:] - gam)[..., None]
    last = jnp.exp(gam[..., -1])

    def step(s, xs):
        u_c, w_c, a_c, qd_c, kd_c, l_c = xs
        v_new = u_c - jnp.einsum('bhcd,bhde->bhce', w_c, s)
        o = jnp.einsum('bhcd,bhde->bhce', qd_c, s) + jnp.einsum('bhcs,bhse->bhce', a_c, v_new)
        s = s * l_c[..., None, None] + jnp.einsum('bhcd,bhce->bhde', kd_c, v_new)
        return s, o

    xs = tuple(jnp.moveaxis(a, 2, 0) for a in (u, w, attn, q_dec, k_dec, last))
    s0 = jnp.zeros((bsz, h, dk, dv), q.dtype)
    _, o = lax.scan(step, s0, xs)
    o = jnp.moveaxis(o, 0, 2).reshape(bsz, h, t, dv)
    return jnp.moveaxis(o, 1, 2)


def gdn_branch(qkv, z, a, bgate, conv_w, a_log, dt_bias, norm_g):
    bsz, t = qkv.shape[0], qkv.shape[1]
    dtype = qkv.dtype
    f32 = jnp.float32
    qkv = jax.nn.silu(causal_dwconv(qkv, conv_w)).astype(f32)
    q, k, v = jnp.split(qkv, 3, axis=-1)
    shp = (bsz, t, C_HEADS, C_HEAD_DIM)
    q = l2_norm(q.reshape(shp))
    k = l2_norm(k.reshape(shp))
    v = v.reshape(shp)
    beta = jax.nn.sigmoid(bgate.astype(f32))
    g = -jnp.exp(a_log.astype(f32)) * jax.nn.softplus(a.astype(f32) + dt_bias.astype(f32))
    o = gated_delta_rule(q, k, v, g, beta)
    o = rms_norm(o, norm_g) * jax.nn.silu(z.astype(f32).reshape(shp))
    return o.reshape(bsz, t, C_WIDTH).astype(dtype)


def conv_glu_ffn(h, w_up, conv_w, w_down):
    hid = causal_dwconv(h @ w_up, conv_w)
    gate, val = jnp.split(hid, 2, axis=-1)
    return (jax.nn.silu(gate) * val) @ w_down


def setup_inputs(seed: int = 0) -> dict:
    key = jax.random.key(seed)
    ks = iter(jax.random.split(key, 32))
    f32 = jnp.float32

    def nrm(shape, scale):
        return jax.random.normal(next(ks), shape, f32) * scale

    L, D = DEPTH, D_MODEL
    G, P, M = S5_GROUPS, S5_STATE, S5_GROUP
    x = nrm((BATCH, SEQ, D), 1.0)
    attn_norm_g = 1.0 + nrm((L, D), 0.01)
    w_in = nrm((L, D, N_IN), D ** -0.5)
    kv_norm_g = 1.0 + nrm((L, KV_RANK), 0.01)
    w_uk = nrm((L, KV_RANK, A_HEADS, A_HEAD_DIM), KV_RANK ** -0.5)
    w_uv = nrm((L, KV_RANK, A_HEADS, A_HEAD_DIM), KV_RANK ** -0.5)
    w_proj_a = nrm((L, A_WIDTH, D), A_WIDTH ** -0.5)
    s5_a_re = -0.5 + nrm((L, G, P), 0.01)
    s5_a_im = math.pi * jnp.arange(P, dtype=f32) + nrm((L, G, P), 0.01)
    s5_log_dt = jax.random.uniform(next(ks), (L, G), f32, math.log(DT_MIN), math.log(DT_MAX))
    s5_b_re = nrm((L, G, P, M), (2 * M) ** -0.5)
    s5_b_im = nrm((L, G, P, M), (2 * M) ** -0.5)
    s5_c_re = nrm((L, G, M, P), 0.5)
    s5_c_im = nrm((L, G, M, P), 0.5)
    s5_d = nrm((L, S5_WIDTH), 1.0)
    w_glu = nrm((L, S5_WIDTH, S5_WIDTH), S5_WIDTH ** -0.5)
    w_proj_b = nrm((L, S5_WIDTH, D), S5_WIDTH ** -0.5)
    gdn_conv_w = nrm((L, C_CONV, 3 * C_WIDTH), C_CONV ** -0.5)
    gdn_a_log = jnp.log(jax.random.uniform(next(ks), (L, C_HEADS), f32, 1.0, 16.0))
    dt = jnp.exp(jax.random.uniform(next(ks), (L, C_HEADS), f32, math.log(DT_MIN), math.log(DT_MAX)))
    gdn_dt_bias = dt + jnp.log(-jnp.expm1(-dt))
    gdn_norm_g = 1.0 + nrm((L, C_HEAD_DIM), 0.01)
    w_proj_c = nrm((L, C_WIDTH, D), C_WIDTH ** -0.5)
    w_out = nrm((L, D, D), D ** -0.5)
    ffn_norm_g = 1.0 + nrm((L, D), 0.01)
    w_up = nrm((L, D, 2 * D_FF), D ** -0.5)
    ffn_conv_w = nrm((L, FFN_CONV, 2 * D_FF), FFN_CONV ** -0.5)
    w_down = nrm((L, D_FF, D), D_FF ** -0.5)
    final_norm_g = 1.0 + nrm((D,), 0.01)
    return {'x': x, 'attn_norm_g': attn_norm_g, 'w_in': w_in,
            'kv_norm_g': kv_norm_g, 'w_uk': w_uk, 'w_uv': w_uv, 'w_proj_a': w_proj_a,
            's5_a_re': s5_a_re, 's5_a_im': s5_a_im, 's5_log_dt': s5_log_dt,
            's5_b_re': s5_b_re, 's5_b_im': s5_b_im, 's5_c_re': s5_c_re, 's5_c_im': s5_c_im,
            's5_d': s5_d, 'w_glu': w_glu, 'w_proj_b': w_proj_b,
            'gdn_conv_w': gdn_conv_w, 'gdn_a_log': gdn_a_log, 'gdn_dt_bias': gdn_dt_bias,
            'gdn_norm_g': gdn_norm_g, 'w_proj_c': w_proj_c,
            'w_out': w_out, 'ffn_norm_g': ffn_norm_g, 'w_up': w_up, 'ffn_conv_w': ffn_conv_w,
            'w_down': w_down, 'final_norm_g': final_norm_g}


def reference(x, attn_norm_g, w_in, kv_norm_g, w_uk, w_uv, w_proj_a,
              s5_a_re, s5_a_im, s5_log_dt, s5_b_re, s5_b_im, s5_c_re, s5_c_im, s5_d, w_glu, w_proj_b,
              gdn_conv_w, gdn_a_log, gdn_dt_bias, gdn_norm_g, w_proj_c,
              w_out, ffn_norm_g, w_up, ffn_conv_w, w_down, final_norm_g):
    bsz, t = x.shape[0], x.shape[1]
    split_points = [int(s) for s in np.cumsum(IN_SPLITS)[:-1]]
    for l in range(DEPTH):
        h = rms_norm(x, attn_norm_g[l])
        (a_q, a_ckv, a_iq, a_ik, a_iw, s5_u, c_qkv, c_z, c_a, c_b,
         gates) = jnp.split(h @ w_in[l], split_points, axis=-1)
        y_a = dsa_attention(a_q.reshape(bsz, t, A_HEADS, A_HEAD_DIM), a_ckv,
                            a_iq.reshape(bsz, t, IDX_HEADS, IDX_DIM), a_ik, a_iw,
                            kv_norm_g[l], w_uk[l], w_uv[l]) @ w_proj_a[l]
        y_b = s5_branch(s5_u, s5_a_re[l], s5_a_im[l], s5_log_dt[l], s5_b_re[l], s5_b_im[l],
                        s5_c_re[l], s5_c_im[l], s5_d[l], w_glu[l]) @ w_proj_b[l]
        y_c = gdn_branch(c_qkv, c_z, c_a, c_b, gdn_conv_w[l], gdn_a_log[l], gdn_dt_bias[l],
                         gdn_norm_g[l]) @ w_proj_c[l]
        g_a, g_b, g_c = jnp.split(jax.nn.sigmoid(gates), N_BRANCH, axis=-1)
        x = x + (g_a * y_a + g_b * y_b + g_c * y_c) @ w_out[l]
        x = x + conv_glu_ffn(rms_norm(x, ffn_norm_g[l]), w_up[l], ffn_conv_w[l], w_down[l])
    return rms_norm(x, final_norm_g)
```

```cpp
#include <hip/hip_runtime.h>
#include <cstdio>
#include <cstdint>

#ifndef MK_ONE_LAUNCH
#define MK_ONE_LAUNCH 1
#endif

#define LAS __attribute__((address_space(3)))
#define GAS __attribute__((address_space(1)))
typedef unsigned short bf16_t;
typedef short bf16x8 __attribute__((ext_vector_type(8)));
typedef float f32x4 __attribute__((ext_vector_type(4)));
typedef float f32x2 __attribute__((ext_vector_type(2)));
typedef unsigned u32x4 __attribute__((ext_vector_type(4)));
typedef unsigned u32x2 __attribute__((ext_vector_type(2)));
typedef GAS unsigned gu32;

constexpr int NB = 8, T = 4096, D = 1024, M = NB * T, NHALF = 2, MH = M / NHALF, BH = NB / NHALF;
constexpr int NIN = 6604, DFF = 2816, NLAYER = 2;
constexpr float EPS = 1e-6f;
constexpr int P1W = 4096;
constexpr int C_QL = 0, C_CKV = 1024, C_IQ = 1152, C_IK = 1408, C_IW = 1472, C_CA = 1476, C_CB = 1480, C_S5U = 1536, C_QKV = 2048, C_Z = 3584;
constexpr int GW = 3072;
constexpr int BRW = 2048;
constexpr int S5LD = 384;
constexpr int GDN_CH = 36864;

constexpr size_t MiB = 1u << 20;
constexpr size_t WS_CTL = 0, CTL_ZERO_BYTES = 1 * MiB;
constexpr size_t WS_WIN1 = 1 * MiB, WS_WIN2 = 9 * MiB, WS_WMRG = 15 * MiB, WS_WOUT = 19 * MiB, WS_WUP = 21 * MiB, WS_WDN = 32 * MiB, WS_WGLU = 38 * MiB;
constexpr size_t WS_S5W1 = 39 * MiB, WS_S5T = 43 * MiB, WS_SS = 49 * MiB, WS_S5P = 51 * MiB  ;
constexpr size_t WS_XB = 52 * MiB, WS_P1 = 116 * MiB, WS_BR = 244 * MiB, WS_MG = 308 * MiB, WS_GO = 308 * MiB;
constexpr size_t WS_IDX = 340 * MiB, WS_NV = 348 * MiB, WS_GLAST = 348 * MiB + 512 * 1024, WS_CN = 349 * MiB, WS_S5A = 353 * MiB, WS_S5S = 377 * MiB, WS_YG = 393 * MiB, WS_GDN = 409 * MiB;
constexpr size_t WS_RAW = 116 * MiB  , WS_ACT = 292 * MiB;
constexpr size_t WS_FHALO = 468 * MiB, WS_FFIRST = 472 * MiB;
constexpr size_t WS_IKC = 490 * MiB;
constexpr size_t WS_END = 492 * MiB;
static_assert(WS_GDN + (size_t)1024 * GDN_CH * 2 <= WS_END, "ws map");
static_assert(WS_ACT + (size_t)M * DFF * 2 <= WS_END, "ws map");
constexpr int CW_BAR = 4096;
constexpr int CW_Q = 16384;

constexpr int LDS_BYTES = 147456, MISC_OFF = LDS_BYTES - 256;

#define RLX_AGENT __ATOMIC_RELAXED, __HIP_MEMORY_SCOPE_AGENT
typedef __bf16 bf16x2_t __attribute__((ext_vector_type(2)));
__device__ __forceinline__ unsigned cvt_pk_bf16(float lo, float hi) { const f32x2 v = {lo, hi}; const bf16x2_t b = __builtin_convertvector(v, bf16x2_t); return __builtin_bit_cast(unsigned, b); }
__device__ __forceinline__ unsigned f2bf(float f) { return cvt_pk_bf16(f, 0.f) & 0xffffu; }
__device__ __forceinline__ unsigned pk2(float lo, float hi) { return cvt_pk_bf16(lo, hi); }
__device__ __forceinline__ float bf2f(unsigned short b) { return __builtin_bit_cast(float, (unsigned)b << 16); }
__device__ __forceinline__ float bflo(unsigned w) { return __builtin_bit_cast(float, w << 16); }
__device__ __forceinline__ float bfhi(unsigned w) { return __builtin_bit_cast(float, w & 0xffff0000u); }

__device__ __forceinline__ float wave_sum(float v) {
#pragma unroll
    for (int o = 1; o < 64; o <<= 1) v += __shfl_xor(v, o);
    return v;
}
__device__ __forceinline__ float wave_max(float v) {
#pragma unroll
    for (int o = 1; o < 64; o <<= 1) v = fmaxf(v, __shfl_xor(v, o));
    return v;
}
__device__ __forceinline__ float rcp_(float x) { return __builtin_amdgcn_rcpf(x); }
__device__ __forceinline__ float sigmoidf_(float x) { return 1.f / (1.f + __expf(-x)); }
__device__ __forceinline__ float sigmoid_nr(float x) { const float y = 1.f + __expf(-x); float r = __builtin_amdgcn_rcpf(y); r = r * (2.f - y * r); return r; }
__device__ __forceinline__ float siluf_(float x) { return x * rcp_(1.f + __expf(-x)); }
__device__ __forceinline__ float gelu_tanh(float x) { const float u2 = 1.5957691216057308f * (x + 0.044715f * x * x * x); return x / (1.f + __expf(-u2)); }
__device__ __forceinline__ float softplusf_(float x) { const float e = __expf(x); const float sm = e * (1.f - e * (0.5f - e * (1.f / 3.f))); return x > 15.f ? x : (e < 1e-2f ? sm : __logf(1.f + e)); }
#define LDS_WAIT() asm volatile("s_waitcnt lgkmcnt(0)" ::: "memory")
#define WAVE_SYNC() do { asm volatile("s_waitcnt lgkmcnt(0)" ::: "memory"); __builtin_amdgcn_wave_barrier(); } while (0)

#define XB_TMO      128
#define XB_XCNT(j)  (256  + 64 * (j))
#define XB_XSUB(j)  (1280 + 64 * (j))
#define XB_XGEN(j)  (2304 + 64 * (j))
#define XB_TOP      3328
#define XB_TOPGEN   3392
#define XCD_BAR_WORDS 3456
#define XB_SPIN_CAP (1u << 22)
__device__ __forceinline__ unsigned xb_ld(unsigned* p)              { return __hip_atomic_load(p, __ATOMIC_RELAXED, __HIP_MEMORY_SCOPE_AGENT); }
__device__ __forceinline__ unsigned xb_add(unsigned* p, unsigned v) { return __hip_atomic_fetch_add(p, v, __ATOMIC_RELAXED, __HIP_MEMORY_SCOPE_AGENT); }
__device__ __forceinline__ unsigned xb_xcc_id() { return (unsigned)__builtin_amdgcn_s_getreg((3 << 11) | 20) & 0xFu; }
#define XB_SPIN(cond, bar) do { unsigned _sp = 0; while (cond) { __builtin_amdgcn_s_sleep(1); \
    if ((++_sp & 255u) == 0u) { if (xb_ld(&(bar)[XB_TMO])) break; if (_sp > XB_SPIN_CAP) { atomicAdd(&(bar)[XB_TMO], 1u); break; } } } } while (0)
struct XcdBarrier { unsigned* bar; unsigned x; volatile LAS unsigned* st; };
__device__ __forceinline__ XcdBarrier xcd_barrier_post(unsigned* bar, volatile LAS unsigned* st) {
    XcdBarrier b; b.bar = bar; b.x = xb_xcc_id(); b.st = st;
    if (threadIdx.x == 0) (void)xb_add(&bar[XB_XCNT(b.x)], 1u);
    return b;
}
__device__ __forceinline__ void xcd_barrier_complete(unsigned* bar, unsigned x, unsigned& nloc, unsigned& nx) {
    const unsigned G = gridDim.x * gridDim.y * gridDim.z;
    unsigned sum, cnt, mine, sp = 0u;
    for (;;) {
        sum = 0u; cnt = 0u; mine = 0u;
#pragma unroll
        for (unsigned j = 0; j < 16; ++j) { const unsigned c = xb_ld(&bar[XB_XCNT(j)]); sum += c; cnt += (c > 0u) ? 1u : 0u; mine = (j == x) ? c : mine; }
        if (sum == G) break;
        __builtin_amdgcn_s_sleep(1);
        if ((++sp & 255u) == 0u) { if (xb_ld(&bar[XB_TMO])) break; if (sp > XB_SPIN_CAP) { atomicAdd(&bar[XB_TMO], 1u); break; } }
    }
    nloc = mine > 0u ? mine : 1u; nx = cnt > 0u ? cnt : 1u;
}
__device__ __forceinline__ void xcd_barrier(const XcdBarrier& b) {
    asm volatile("s_waitcnt vmcnt(0)" ::: "memory");
    __syncthreads();
    if (threadIdx.x == 0) {
        unsigned* bar = b.bar;
        __builtin_amdgcn_s_waitcnt(0);
        unsigned nloc = b.st[0], nx = b.st[1];
        if (nloc == 0u) { xcd_barrier_complete(bar, b.x, nloc, nx); b.st[0] = nloc; b.st[1] = nx; }
        const unsigned old = xb_add(&bar[XB_XSUB(b.x)], 1u);
        const unsigned gen = old / nloc;
        if (old + 1u == (gen + 1u) * nloc) {
            __builtin_amdgcn_fence(__ATOMIC_RELEASE, "agent");
            asm volatile("s_waitcnt vmcnt(0)" ::: "memory");
            const unsigned og = xb_add(&bar[XB_TOP], 1u);
            const unsigned tg = og / nx;
            if (og + 1u == (tg + 1u) * nx) xb_add(&bar[XB_TOPGEN], 1u);
            else XB_SPIN(xb_ld(&bar[XB_TOPGEN]) == tg, bar);
            __builtin_amdgcn_fence(__ATOMIC_ACQUIRE, "agent");
            xb_add(&bar[XB_XGEN(b.x)], 1u);
            asm volatile("s_waitcnt vmcnt(0)" ::: "memory");
        } else {
            XB_SPIN(xb_ld(&bar[XB_XGEN(b.x)]) == gen, bar);
            __builtin_amdgcn_fence(__ATOMIC_ACQUIRE, "agent");
            asm volatile("s_waitcnt vmcnt(0)" ::: "memory");
        }
    }
    __syncthreads();
}

namespace pg8 {
constexpr int BM = 256, BK = 64, HALF = 128, HTB = HALF * BK * 2, NXCD = 8, WGM = 8;
__host__ __device__ __forceinline__ int lds_byte(int r, int c) { const int st = (r >> 4) * 2 + (c >> 5), rr = r & 15, cc = c & 31, ob = rr * 64 + cc * 2; return st * 1024 + (ob ^ (((ob >> 9) & 1) << 5)); }
__host__ __device__ __forceinline__ void stage_rc(int b, int& R, int& C) { const int st = b / 1024, sb = b % 1024, swz = sb ^ (((sb >> 9) & 1) << 5); R = (st >> 1) * 16 + swz / 64; C = (st & 1) * 32 + (swz % 64) / 2; }
__host__ __device__ __forceinline__ int perm32(int rho) { const int n = rho >> 4, i = rho & 15; return 8 * (i >> 2) + 4 * n + (i & 3); }
struct Unit { int pm, pn; };
struct Gemm { const bf16_t* A; const bf16_t* Bt; int lda, ldb, K; };

struct StaticOrder {
    int nM, nN, nwg, G, c;
    __device__ void init(int Mr, int N, int G_, int c_) { nM = Mr / BM; nN = N / BM; nwg = nM * nN; G = G_; c = c_; }
    __device__ bool next(int i, Unit& u) const {
        const long L = (long)i * G + c; if (L >= nwg) return false;
        int wgid = (int)L; { const int q = nwg / NXCD, r = nwg % NXCD, xcd = wgid % NXCD, off = wgid / NXCD; wgid = (xcd < r ? xcd * (q + 1) : r * (q + 1) + (xcd - r) * q) + off; }
        const int nig = WGM * nN, gid = wgid / nig, fm = gid * WGM, gsz = (nM - fm) < WGM ? (nM - fm) : WGM;
        u.pm = fm + ((wgid % nig) % gsz); u.pn = (wgid % nig) / gsz; return true;
    }
};
struct GroupOrder {
    int n, per, G, c;
    __device__ void init(int ngroups, int per_, int G_, int c_) { n = ngroups * per_; per = per_; G = G_; c = c_; }
    __device__ bool next(int i, Unit& u) const { const long L = (long)i * G + c; if (L >= n) return false; u.pm = (int)L; u.pn = (int)L / per; return true; }
};

template <class Epi, class Sched>
__device__ __forceinline__ void gemm_phase(LAS unsigned char* lds, const int tid, const Gemm g, const Sched& S, const Epi& E) {
    const int wid = __builtin_amdgcn_readfirstlane(tid >> 6), lane = tid & 63, wr = wid >> 2, wc = wid & 3, fr = lane & 15, fq = lane >> 4;
    const int K = g.K, nt = K / BK;
    unsigned voffA[2], voffB[2];
#pragma unroll
    for (int i = 0; i < 2; ++i) { int R, C; stage_rc(tid * 16 + i * 8192, R, C); const int Rb = (R & ~31) + perm32(R & 31);
        voffA[i] = (unsigned)(R * g.lda + C) * 2u; voffB[i] = (unsigned)(Rb * g.ldb + C) * 2u; }
    const size_t kstep = (size_t)(BK * 2);
    const size_t hstepA = (size_t)HALF * g.lda * 2, hstepB = (size_t)HALF * g.ldb * 2;
    const size_t tstepA = 2 * hstepA, tstepB = 2 * hstepB;
    const unsigned ldsw = (unsigned)wid * 1024u;
    const int aoff = lds_byte(wr * 64 + fr, fq * 8), boff = lds_byte(wc * 32 + fr, fq * 8);
#define PG8_SA(b, h) (((b) * 2 + (h)) * HTB)
#define PG8_SB(b, h) ((4 + (b) * 2 + (h)) * HTB)
#define PG8_STAGE(bufoff, gbase, voff) do { _Pragma("unroll") for (int _i = 0; _i < 2; ++_i) \
        __builtin_amdgcn_global_load_lds((const unsigned*)((const char*)(gbase) + (voff)[_i]), (LAS unsigned*)(lds + (bufoff) + ldsw + _i * 8192), 16, 0, 0); } while (0)
#define PG8_LDA(dst, b, h) do { _Pragma("unroll") for (int m = 0; m < 4; ++m) _Pragma("unroll") for (int k = 0; k < 2; ++k) dst[m][k] = *(const LAS bf16x8*)(lds + PG8_SA(b, h) + aoff + m * 2048 + k * 1024); } while (0)
#define PG8_LDB(dst, b, h) do { _Pragma("unroll") for (int n = 0; n < 2; ++n) _Pragma("unroll") for (int k = 0; k < 2; ++k) dst[n][k] = *(const LAS bf16x8*)(lds + PG8_SB(b, h) + boff + n * 2048 + k * 1024); } while (0)
#define PG8_MMA(ai, bj, At, Bt) do { __builtin_amdgcn_s_setprio(1); _Pragma("unroll") for (int m = 0; m < 4; ++m) _Pragma("unroll") for (int n = 0; n < 2; ++n) _Pragma("unroll") for (int k = 0; k < 2; ++k) \
        acc[ai][bj][m][n] = __builtin_amdgcn_mfma_f32_16x16x32_bf16(Bt[n][k], At[m][k], acc[ai][bj][m][n], 0, 0, 0); __builtin_amdgcn_s_setprio(0); } while (0)
#define PG8_WAIT_V(n) asm volatile("s_waitcnt vmcnt(" #n ")" ::: "memory")
#define PG8_WAIT_L(n) asm volatile("s_waitcnt lgkmcnt(" #n ")" ::: "memory")
#define PG8_BAR __builtin_amdgcn_s_barrier()
#define PG8_SCHED __builtin_amdgcn_sched_barrier(0)
    Unit cur, nxt; int ui = 0;
    if (!S.next(0, cur)) return;
    f32x4 acc[2][2][4][2];
#pragma unroll
    for (int a = 0; a < 2; ++a)
#pragma unroll
        for (int b = 0; b < 2; ++b)
#pragma unroll
            for (int m = 0; m < 4; ++m)
#pragma unroll
                for (int n = 0; n < 2; ++n) acc[a][b][m][n] = (f32x4){0.f, 0.f, 0.f, 0.f};
    bf16x8 At[4][2], B0[2][2], B1[2][2];
    const char* cA = (const char*)g.A + (size_t)cur.pm * tstepA; const char* cB = (const char*)g.Bt + (size_t)cur.pn * tstepB;
    PG8_STAGE(PG8_SB(0, 0), cB, voffB); PG8_STAGE(PG8_SB(0, 1), cB + hstepB, voffB); PG8_STAGE(PG8_SA(0, 0), cA, voffA); PG8_STAGE(PG8_SA(0, 1), cA + hstepA, voffA);
    if (wr == 1) PG8_BAR;
    PG8_WAIT_V(2); PG8_BAR;
    PG8_STAGE(PG8_SB(1, 0), cB + kstep, voffB); PG8_STAGE(PG8_SA(1, 0), cA + kstep, voffA); PG8_STAGE(PG8_SB(1, 1), cB + hstepB + kstep, voffB);
    PG8_WAIT_V(6); PG8_BAR;
    for (;;) {
        const bool has_next = S.next(ui + 1, nxt);
        const char* nA = has_next ? (const char*)g.A + (size_t)nxt.pm * tstepA : cA; const char* nB = has_next ? (const char*)g.Bt + (size_t)nxt.pn * tstepB : cB;
#pragma unroll 1
        for (int t = 0; t < nt; t += 2) {
            const bool last = (t == nt - 2);
            const char* a1 = cA + (size_t)(t + 1) * kstep;
            const char* a2 = last ? nA : cA + (size_t)(t + 2) * kstep; const char* b2 = last ? nB : cB + (size_t)(t + 2) * kstep;
            const char* a3 = a2 + kstep; const char* b3 = b2 + kstep;
            if constexpr (Epi::HOOK) { if (E.hook_at(t)) E.mid(acc, cur, t, wr, wc, fr, fq); }
            PG8_LDB(B0, 0, 0); PG8_LDB(B1, 0, 1); PG8_SCHED; PG8_LDA(At, 0, 0); PG8_STAGE(PG8_SA(1, 1), a1 + hstepA, voffA);
            PG8_WAIT_V(8); PG8_WAIT_L(0); PG8_BAR; PG8_MMA(0, 0, At, B0); PG8_MMA(0, 1, At, B1); PG8_BAR; PG8_SCHED;
            PG8_LDA(At, 0, 1); PG8_STAGE(PG8_SB(0, 0), b2, voffB); PG8_STAGE(PG8_SB(0, 1), b2 + hstepB, voffB); PG8_STAGE(PG8_SA(0, 0), a2, voffA);
            PG8_WAIT_V(8); PG8_WAIT_L(0); PG8_BAR; PG8_MMA(1, 0, At, B0); PG8_MMA(1, 1, At, B1); PG8_BAR; PG8_SCHED;
            PG8_LDB(B0, 1, 0); PG8_LDB(B1, 1, 1); PG8_SCHED; PG8_LDA(At, 1, 0); PG8_STAGE(PG8_SA(0, 1), a2 + hstepA, voffA);
            PG8_WAIT_V(8); PG8_WAIT_L(0); PG8_BAR; PG8_MMA(0, 0, At, B0); PG8_MMA(0, 1, At, B1); PG8_BAR; PG8_SCHED;
            PG8_LDA(At, 1, 1); PG8_STAGE(PG8_SB(1, 0), b3, voffB); PG8_STAGE(PG8_SB(1, 1), b3 + hstepB, voffB); PG8_STAGE(PG8_SA(1, 0), a3, voffA);
            PG8_WAIT_V(8); PG8_WAIT_L(0); PG8_BAR; PG8_MMA(1, 0, At, B0); PG8_MMA(1, 1, At, B1); PG8_BAR; PG8_SCHED;
        }
        if (wr == 0) PG8_BAR;
        E(acc, cur, ui, wr, wc, fr, fq);
        if (!has_next) break;
#pragma unroll
        for (int a = 0; a < 2; ++a)
#pragma unroll
            for (int b = 0; b < 2; ++b)
#pragma unroll
                for (int m = 0; m < 4; ++m)
#pragma unroll
                    for (int n = 0; n < 2; ++n) acc[a][b][m][n] = (f32x4){0.f, 0.f, 0.f, 0.f};
        cur = nxt; cA = nA; cB = nB; ++ui;
        if (wr == 1) PG8_BAR;
    }
    PG8_WAIT_V(0);
    PG8_BAR;
#undef PG8_SA
#undef PG8_SB
#undef PG8_STAGE
#undef PG8_LDA
#undef PG8_LDB
#undef PG8_MMA
#undef PG8_WAIT_V
#undef PG8_WAIT_L
#undef PG8_BAR
#undef PG8_SCHED
}
}
using pg8::Unit;
typedef f32x4 Acc[2][2][4][2];

__device__ __forceinline__ float row_rstd(const float* SS, int row) {
    const f32x4* p = (const f32x4*)(SS + (size_t)row * 16);
    const f32x4 a = p[0], b = p[1], c = p[2], d = p[3];
    const float s = ((a.x + a.y) + (a.z + a.w)) + ((b.x + b.y) + (b.z + b.w)) + ((c.x + c.y) + (c.z + c.w)) + ((d.x + d.y) + (d.z + d.w));
    return 1.f / sqrtf(s * (1.f / D) + EPS);
}
#define EPI_ROWS_BEGIN int frl_ = fr; asm volatile("" : "+v"(frl_)); const int row0 = u.pm * 256 + wr * 64 + frl_; const int col0 = u.pn * 256 + wc * 32 + 8 * fq; (void)col0; \
    _Pragma("unroll") for (int ai = 0; ai < 2; ++ai) _Pragma("unroll") for (int m = 0; m < 4; ++m) { const int row = row0 + ai * 128 + m * 16;
#define EPI_ROWS_END asm volatile("" ::: "memory"); }
__device__ __forceinline__ u32x4 pack8(const f32x4 v0, const f32x4 v1) { u32x4 w; w.x = cvt_pk_bf16(v0[0], v0[1]); w.y = cvt_pk_bf16(v0[2], v0[3]); w.z = cvt_pk_bf16(v1[0], v1[1]); w.w = cvt_pk_bf16(v1[2], v1[3]); return w; }

template <int ACT> struct EpiNormBf16 {
    static constexpr bool HOOK = false;
    bf16_t* O; int ldo; const LAS float* rsl;
    bf16_t* S5A; bf16_t* IKC;
    __device__ __forceinline__ void operator()(Acc& acc, const Unit& u, int ui, int wr, int wc, int fr, int fq) const {
        EPI_ROWS_BEGIN
            const float rs = rsl[ui * 256 + (row & 255)]; bf16_t* rowp = O + (size_t)row * ldo + col0;
#pragma unroll
            for (int bj = 0; bj < 2; ++bj) { f32x4 v0 = acc[ai][bj][m][0] * rs, v1 = acc[ai][bj][m][1] * rs;
                if (ACT == 1) {
#pragma unroll
                    for (int j = 0; j < 4; ++j) { v0[j] = sigmoid_nr(v0[j]); v1[j] = sigmoid_nr(v1[j]); } }
                const u32x4 w = pack8(v0, v1);
                if (ACT == 2 && (u.pn == 6 || u.pn == 7)) { const int c = col0 + bj * 128 - C_S5U;
                    *(u32x4*)(S5A + ((size_t)(c >> 4) * 1024 + (row >> 4)) * S5LD + (row & 15) * 16 + (c & 15)) = w; }
                else { *(u32x4*)(rowp + bj * 128) = w;
                    if (ACT == 2 && u.pn == 5 && bj == 1 && wc < 2) *(u32x4*)(IKC + (size_t)(row >> 4) * 1024 + ((wc * 4 + fq) * 16 + (row & 15)) * 8) = w; } }
        EPI_ROWS_END
    }
};
struct EpiMerge {
    static constexpr bool HOOK = true;
    bf16_t* O; const bf16_t* Gt;
    __device__ __forceinline__ bool hook_at(int t) const { return t == 16 || t == 24; }
    __device__ __forceinline__ void mid(Acc& acc, const Unit& u, int t, int wr, int wc, int fr, int fq) const {
        const int s0 = (t == 16) ? 0 : 1024;
        int frl_ = fr; asm volatile("" : "+v"(frl_));
        const int row0 = u.pm * 256 + wr * 64 + frl_, col0 = u.pn * 256 + wc * 32 + 8 * fq;
        u32x4 gn[4];
        { const bf16_t* gp = Gt + (size_t)row0 * GW + col0 + s0; gn[0] = *(const u32x4*)gp; gn[1] = *(const u32x4*)(gp + 1024); gn[2] = *(const u32x4*)(gp + 128); gn[3] = *(const u32x4*)(gp + 1152); }
#pragma unroll
        for (int g = 0; g < 8; ++g) { const int ai = g >> 2, m = g & 3; u32x4 gc[4];
#pragma unroll
            for (int q = 0; q < 4; ++q) gc[q] = gn[q];
            if (g < 7) { const int g2 = g + 1; const bf16_t* gp = Gt + (size_t)(row0 + (g2 >> 2) * 128 + (g2 & 3) * 16) * GW + col0 + s0;
                gn[0] = *(const u32x4*)gp; gn[1] = *(const u32x4*)(gp + 1024); gn[2] = *(const u32x4*)(gp + 128); gn[3] = *(const u32x4*)(gp + 1152); }
#pragma unroll
            for (int bj = 0; bj < 2; ++bj) { const u32x4 ga = gc[2 * bj], gb = gc[2 * bj + 1];
#pragma unroll
                for (int q = 0; q < 4; ++q) { const float r0 = bflo(ga[q]) / bflo(gb[q]), r1 = bfhi(ga[q]) / bfhi(gb[q]);
                    acc[ai][bj][m][q >> 1][(q & 1) * 2] *= r0; acc[ai][bj][m][q >> 1][(q & 1) * 2 + 1] *= r1; } } }
    }
    __device__ __forceinline__ void operator()(Acc& acc, const Unit& u, int ui, int wr, int wc, int fr, int fq) const {
        int frl_ = fr; asm volatile("" : "+v"(frl_));
        const int row0 = u.pm * 256 + wr * 64 + frl_, col0 = u.pn * 256 + wc * 32 + 8 * fq;
        u32x4 gn[2];
        { const bf16_t* gp = Gt + (size_t)row0 * GW + 2048 + col0; gn[0] = *(const u32x4*)gp; gn[1] = *(const u32x4*)(gp + 128); }
#pragma unroll
        for (int g = 0; g < 8; ++g) { const int ai = g >> 2, m = g & 3, row = row0 + ai * 128 + m * 16; u32x4 gcur[2]; gcur[0] = gn[0]; gcur[1] = gn[1];
            if (g < 7) { const int g2 = g + 1; const bf16_t* gp = Gt + (size_t)(row0 + (g2 >> 2) * 128 + (g2 & 3) * 16) * GW + 2048 + col0; gn[0] = *(const u32x4*)gp; gn[1] = *(const u32x4*)(gp + 128); }
            bf16_t* rowp = O + (size_t)row * 1024 + col0;
#pragma unroll
            for (int bj = 0; bj < 2; ++bj) { const u32x4 gc = gcur[bj]; f32x4 v0 = acc[ai][bj][m][0], v1 = acc[ai][bj][m][1];
                v0[0] *= bflo(gc[0]); v0[1] *= bfhi(gc[0]); v0[2] *= bflo(gc[1]); v0[3] *= bfhi(gc[1]); v1[0] *= bflo(gc[2]); v1[1] *= bfhi(gc[2]); v1[2] *= bflo(gc[3]); v1[3] *= bfhi(gc[3]);
                *(u32x4*)(rowp + bj * 128) = pack8(v0, v1); } }
    }
};
struct EpiResid {
    static constexpr bool HOOK = false;
    const float* XO; float* XF; bf16_t* XB; float* SS;
    __device__ __forceinline__ void operator()(Acc& acc, const Unit& u, int ui, int wr, int wc, int fr, int fq) const {
        int frl_ = fr; asm volatile("" : "+v"(frl_));
        const int row0 = u.pm * 256 + wr * 64 + frl_, col0 = u.pn * 256 + wc * 32 + 8 * fq;
        f32x4 xn[4];
        { const size_t off = (size_t)row0 * D + col0; xn[0] = *(const f32x4*)(XO + off); xn[1] = *(const f32x4*)(XO + off + 4); xn[2] = *(const f32x4*)(XO + off + 128); xn[3] = *(const f32x4*)(XO + off + 132); }
#pragma unroll
        for (int g = 0; g < 8; ++g) { const int ai = g >> 2, m = g & 3, row = row0 + ai * 128 + m * 16; const size_t off = (size_t)row * D + col0;
            f32x4 xc[4];
#pragma unroll
            for (int q = 0; q < 4; ++q) xc[q] = xn[q];
            if (g < 7) { const int g2 = g + 1; const size_t o2 = (size_t)(row0 + (g2 >> 2) * 128 + (g2 & 3) * 16) * D + col0;
                xn[0] = *(const f32x4*)(XO + o2); xn[1] = *(const f32x4*)(XO + o2 + 4); xn[2] = *(const f32x4*)(XO + o2 + 128); xn[3] = *(const f32x4*)(XO + o2 + 132); }
            float ss = 0.f;
#pragma unroll
            for (int bj = 0; bj < 2; ++bj) { const f32x4 v0 = acc[ai][bj][m][0] + xc[2 * bj], v1 = acc[ai][bj][m][1] + xc[2 * bj + 1];
                *(f32x4*)(XF + off + bj * 128) = v0; *(f32x4*)(XF + off + bj * 128 + 4) = v1; *(u32x4*)(XB + off + bj * 128) = pack8(v0, v1);
                ss += (v0[0] * v0[0] + v0[1] * v0[1]) + (v0[2] * v0[2] + v0[3] * v0[3]) + (v1[0] * v1[0] + v1[1] * v1[1]) + (v1[2] * v1[2] + v1[3] * v1[3]); }
            ss += __shfl_xor(ss, 16); ss += __shfl_xor(ss, 32);
            if (fq == 0) SS[(size_t)row * 16 + u.pn * 4 + wc] = ss; }
    }
};
struct EpiUpConv {
    static constexpr bool HOOK = false;
    bf16_t* ACT; const LAS float* rsl; LAS unsigned char* hal; const float* cw; bf16_t* HALO; bf16_t* FIRST;
    __device__ __forceinline__ void operator()(Acc& acc, const Unit& u, int ui, int wr, int wc, int fr, int fq) const {
        int frl_ = fr, fql_ = fq; asm volatile("" : "+v"(frl_), "+v"(fql_));
        const int f = frl_, cb = wc * 32 + 8 * fql_;
#pragma unroll
        for (int ai = 0; ai < 2; ++ai)
#pragma unroll
            for (int m = 0; m < 4; ++m) { const float rs = rsl[ui * 256 + ai * 128 + wr * 64 + m * 16 + f];
#pragma unroll
                for (int bj = 0; bj < 2; ++bj) { acc[ai][bj][m][0] = acc[ai][bj][m][0] * rs; acc[ai][bj][m][1] = acc[ai][bj][m][1] * rs; } }
        if (f >= 14) {
#pragma unroll
            for (int ai = 0; ai < 2; ++ai)
#pragma unroll
                for (int bj = 0; bj < 2; ++bj) { const u32x4 w = pack8(acc[ai][bj][3][0], acc[ai][bj][3][1]);
                    *(LAS u32x4*)(hal + (((ai * 2 + wr) * 2 + (f - 14)) * 256 + bj * 128 + cb) * 2) = w;
                    if (ai == 1 && wr == 1) *(u32x4*)(HALO + ((size_t)(u.pm * 22 + u.pn) * 2 + (f - 14)) * 256 + bj * 128 + cb) = w; } }
        if (f < 2 && wr == 0) {
#pragma unroll
            for (int bj = 0; bj < 2; ++bj) *(u32x4*)(FIRST + ((size_t)(u.pm * 22 + u.pn) * 2 + f) * 256 + bj * 128 + cb) = pack8(acc[0][bj][0][0], acc[0][bj][0][1]); }
        asm volatile("s_waitcnt lgkmcnt(0)\n\ts_barrier" ::: "memory");
        float wg[3][8], wv[3][8];
        { const float* cp = cw + u.pn * 128 + cb;
#pragma unroll
          for (int k = 0; k < 3; ++k) { const f32x4 a0 = *(const f32x4*)(cp + k * 2 * DFF), a1 = *(const f32x4*)(cp + k * 2 * DFF + 4), b0 = *(const f32x4*)(cp + k * 2 * DFF + DFF), b1 = *(const f32x4*)(cp + k * 2 * DFF + DFF + 4);
#pragma unroll
              for (int x = 0; x < 4; ++x) { wg[k][x] = a0[x]; wg[k][4 + x] = a1[x]; wv[k][x] = b0[x]; wv[k][4 + x] = b1[x]; } } }
#pragma unroll
        for (int ai = 0; ai < 2; ++ai) {
            f32x4 pv[2][2];
            { const bool has = !(ai == 0 && wr == 0); const int ps = (wr == 1) ? ai * 2 : 1;
#pragma unroll
              for (int bj = 0; bj < 2; ++bj) { u32x4 w = {0u, 0u, 0u, 0u}; if (has && f >= 14) w = *(const LAS u32x4*)(hal + ((ps * 2 + (f - 14)) * 256 + bj * 128 + cb) * 2);
                  pv[bj][0] = (f32x4){bflo(w[0]), bfhi(w[0]), bflo(w[1]), bfhi(w[1])}; pv[bj][1] = (f32x4){bflo(w[2]), bfhi(w[2]), bflo(w[3]), bfhi(w[3])}; } }
#pragma unroll
            for (int m = 0; m < 4; ++m) { float hg[8], hv[8];
#pragma unroll
                for (int bj = 0; bj < 2; ++bj)
#pragma unroll
                    for (int n2 = 0; n2 < 2; ++n2)
#pragma unroll
                        for (int x = 0; x < 4; ++x) { const float cur = acc[ai][bj][m][n2][x], prv = (m == 0) ? pv[bj][n2][x] : acc[ai][bj][m - 1][n2][x];
                            const float t1 = (f == 15) ? prv : cur, t2 = (f >= 14) ? prv : cur;
                            const float p1 = __builtin_bit_cast(float, __builtin_amdgcn_update_dpp(0, __builtin_bit_cast(int, t1), 0x121, 0xf, 0xf, false));
                            const float p2 = __builtin_bit_cast(float, __builtin_amdgcn_update_dpp(0, __builtin_bit_cast(int, t2), 0x122, 0xf, 0xf, false)); const int c = 4 * n2 + x;
                            const float hh = (bj == 0 ? wg[0][c] : wv[0][c]) * p2 + (bj == 0 ? wg[1][c] : wv[1][c]) * p1 + (bj == 0 ? wg[2][c] : wv[2][c]) * cur;
                            if (bj == 0) hg[c] = hh; else hv[c] = hh; }
                u32x4 o;
#pragma unroll
                for (int q = 0; q < 4; ++q) o[q] = pk2(siluf_(hg[2 * q]) * hv[2 * q], siluf_(hg[2 * q + 1]) * hv[2 * q + 1]);
                *(u32x4*)(ACT + (size_t)(u.pm * 256 + ai * 128 + wr * 64 + m * 16 + f) * DFF + u.pn * 128 + cb) = o; } }
    }
};
struct EpiS5S {
    static constexpr bool HOOK = false;
    float* S;
    __device__ __forceinline__ void operator()(Acc& acc, const Unit& u, int ui, int wr, int wc, int fr, int fq) const {
        int frl_ = fr; asm volatile("" : "+v"(frl_));
        const int row0 = u.pm * 256 + wr * 64 + frl_, c0 = wc * 32 + 8 * fq;
#pragma unroll
        for (int ai = 0; ai < 2; ++ai)
#pragma unroll
            for (int m = 0; m < 4; ++m) { float* p = S + (size_t)(row0 + ai * 128 + m * 16) * 128 + c0; *(f32x4*)p = acc[ai][0][m][0]; *(f32x4*)(p + 4) = acc[ai][0][m][1]; }
    }
};
struct EpiS5Y {
    static constexpr bool HOOK = false;
    bf16_t* YG;
    __device__ __forceinline__ void operator()(Acc& acc, const Unit& u, int ui, int wr, int wc, int fr, int fq) const {
        int frl_ = fr; asm volatile("" : "+v"(frl_));
        const int g = u.pn, rg0 = (u.pm & 3) * 256 + wr * 64 + frl_;
#pragma unroll
        for (int ai = 0; ai < 2; ++ai)
#pragma unroll
            for (int m = 0; m < 4; ++m) { const int rg = rg0 + ai * 128 + m * 16;
#pragma unroll
                for (int bj = 0; bj < 2; ++bj) { const int c = bj * 128 + wc * 32 + 8 * fq, t = c >> 4, ch = c & 15; f32x4 v0 = acc[ai][bj][m][0], v1 = acc[ai][bj][m][1];
#pragma unroll
                    for (int j = 0; j < 4; ++j) { v0[j] = gelu_tanh(v0[j]); v1[j] = gelu_tanh(v1[j]); }
                    *(u32x4*)(YG + (size_t)(rg * 16 + t) * 512 + g * 16 + ch) = pack8(v0, v1); } asm volatile("" ::: "memory"); }
    }
};
struct EpiS5G {
    static constexpr bool HOOK = false;
    const bf16_t* YG; bf16_t* BR;
    __device__ __forceinline__ void operator()(Acc& acc, const Unit& u, int ui, int wr, int wc, int fr, int fq) const {
        EPI_ROWS_BEGIN
#pragma unroll
            for (int bj = 0; bj < 2; ++bj) { const u32x4 y = *(const u32x4*)(YG + (size_t)row * 512 + col0 + bj * 128); f32x4 v0 = acc[ai][bj][m][0], v1 = acc[ai][bj][m][1];
                v0[0] = bflo(y[0]) * sigmoidf_(v0[0]); v0[1] = bfhi(y[0]) * sigmoidf_(v0[1]); v0[2] = bflo(y[1]) * sigmoidf_(v0[2]); v0[3] = bfhi(y[1]) * sigmoidf_(v0[3]);
                v1[0] = bflo(y[2]) * sigmoidf_(v1[0]); v1[1] = bfhi(y[2]) * sigmoidf_(v1[1]); v1[2] = bflo(y[3]) * sigmoidf_(v1[2]); v1[3] = bfhi(y[3]) * sigmoidf_(v1[3]);
                *(u32x4*)(BR + (size_t)row * BRW + 1024 + col0 + bj * 128) = pack8(v0, v1); }
        EPI_ROWS_END
    }
};

struct Args { const float* in[28]; float* out; unsigned char* ws; int ph_lo, ph_hi; };
typedef const __attribute__((address_space(4))) Args CArgs;
struct Frame {
    LAS unsigned char* lds;
    CArgs* ap;
    unsigned char* ws;
    int tid, lane, wave, G, bid;
};
enum { I_X = 0, I_ANG, I_WIN, I_KVG, I_WUK, I_WUV, I_WPA, I_S5ARE, I_S5AIM, I_S5LDT, I_S5BRE, I_S5BIM, I_S5CRE, I_S5CIM, I_S5D, I_WGLU, I_WPB, I_GCW, I_GALOG, I_GDTB, I_GNG, I_WPC, I_WOUT, I_FNG, I_WUP, I_FCW, I_WDN, I_FING };

template <class Sched> __device__ __forceinline__ const LAS float* rstd_table(Frame& F, const Sched& S, const float* SS) {
    LAS float* rsl = (LAS float*)(F.lds + 131072); Unit u;
    for (int i = 0; S.next(i, u); ++i) for (int r = F.tid; r < 256; r += 512) rsl[i * 256 + r] = row_rstd(SS, u.pm * 256 + r);
    __syncthreads();
    return rsl;
}
__device__ __forceinline__ void ph_x0(Frame& F) {
    const float* x = F.ap->in[I_X]; bf16_t* XB = (bf16_t*)(F.ws + WS_XB); float* SS = (float*)(F.ws + WS_SS);
    const int gw = F.bid * 8 + F.wave, NGW = F.G * 8;
    for (int r = gw; r < M; r += NGW) {
        const f32x4* xr = (const f32x4*)(x + (size_t)r * D) + F.lane; float s = 0.f; f32x4 v[4];
#pragma unroll
        for (int j = 0; j < 4; ++j) { v[j] = xr[64 * j]; s += (v[j].x * v[j].x + v[j].y * v[j].y) + (v[j].z * v[j].z + v[j].w * v[j].w); }
        s = wave_sum(s);
        u32x2* o = (u32x2*)(XB + (size_t)r * D) + F.lane;
#pragma unroll
        for (int j = 0; j < 4; ++j) { u32x2 w; w.x = pk2(v[j].x, v[j].y); w.y = pk2(v[j].z, v[j].w); o[64 * j] = w; }
        if (F.lane < 16) SS[(size_t)r * 16 + F.lane] = (F.lane == 0) ? s : 0.f;
    }
}

__device__ __forceinline__ int win1_col(int n) {
    if (n < 1152) return 512 + (n - 1024);
    if (n < 1408) return 640 + (n - 1152);
    if (n < 1472) return 896 + (n - 1408);
    if (n < 1476) return 960 + (n - 1472);
    if (n < 1480) return 3524 + (n - 1476);
    if (n < 1484) return 3528 + (n - 1480);
    if (n < 1536) return -1;
    if (n < 2048) return 964 + (n - 1536);
    if (n < 3584) return 1476 + (n - 2048);
    return 3012 + (n - 3584);
}
__device__ __forceinline__ int wup_col(int n) { const int j = n >> 8, bj = (n >> 7) & 1, i = n & 127; return bj * DFF + j * 128 + i; }
__device__ __forceinline__ void tr_one(int lane, int it, const float* src, int sld, const float* scale, bf16_t* dst, int dld, int koff, int n0, int nn, int kind, LAS float* scr) {
    const int nblk = nn / 32;
    const int kb = it / nblk, nb = it % nblk, k0 = kb * 64, nbase = n0 + nb * 32, r8 = lane >> 3, c4 = lane & 7, n = nbase + 4 * c4;
    int col = n; if (kind == 1) col = win1_col(n); else if (kind == 2) col = 3532 + n; else if (kind == 3) col = wup_col(n);
    f32x4 v[8]; float sc[8];
    const float* sp = src + (size_t)(k0 + r8) * sld + (col >= 0 ? col : 0);
#pragma unroll
    for (int i = 0; i < 8; ++i) v[i] = *(const f32x4*)(sp + (size_t)(8 * i) * sld);
#pragma unroll
    for (int i = 0; i < 8; ++i) sc[i] = scale ? scale[k0 + 8 * i + r8] : 1.f;
    if (col < 0) {
#pragma unroll
        for (int i = 0; i < 8; ++i) sc[i] = 0.f; }
#pragma unroll
    for (int i = 0; i < 8; ++i) { LAS float* d = scr + (8 * i + r8) * 33 + 4 * c4; d[0] = v[i][0] * sc[i]; d[1] = v[i][1] * sc[i]; d[2] = v[i][2] * sc[i]; d[3] = v[i][3] * sc[i]; }
    WAVE_SYNC();
    const int c = lane & 7;
#pragma unroll
    for (int j = 0; j < 4; ++j) { const int nl = (lane >> 3) + 8 * j; const LAS float* s = scr + (8 * c) * 33 + nl;
        u32x4 o; o.x = pk2(s[0 * 33], s[1 * 33]); o.y = pk2(s[2 * 33], s[3 * 33]); o.z = pk2(s[4 * 33], s[5 * 33]); o.w = pk2(s[6 * 33], s[7 * 33]);
        *(u32x4*)(dst + (size_t)(nbase + nl) * dld + koff + k0 + 8 * c) = o; }
    WAVE_SYNC();
}
__device__ __forceinline__ void ph_wprep(Frame& F, int l) {
    LAS float* L = (LAS float*)F.lds;
    const float* w_in = F.ap->in[I_WIN] + (size_t)l * D * NIN; const float* ang = F.ap->in[I_ANG] + (size_t)l * D;
    bf16_t* WIN1 = (bf16_t*)(F.ws + WS_WIN1); bf16_t* WMRG = (bf16_t*)(F.ws + WS_WMRG);
    for (int pass = 0; pass * F.G < 288; ++pass) {
        int it = F.bid + pass * F.G;
        if (F.G == 256 && pass == 1) it = (F.bid >= 32 && F.bid < 64) ? F.bid + 224 : 288;
        if (it >= 288) continue;
        __syncthreads();
        if (it >= 32 && it < 160) {
            const int j = it - 32, h = j >> 4, k0 = (j & 15) * 64; const float* wuk = F.ap->in[I_WUK] + (size_t)l * 128 * 512;
            LAS float* A = L; LAS float* Bm = L + 64 * 65;
            for (int e = F.tid; e < 64 * 64; e += 512) { const int kk = e >> 6, d = e & 63; A[kk * 65 + d] = w_in[(size_t)(k0 + kk) * NIN + h * 64 + d] * ang[k0 + kk] * 0.125f; }
            for (int e = F.tid; e < 128 * 64; e += 512) { const int r = e >> 6, d = e & 63; Bm[r * 65 + d] = wuk[(size_t)r * 512 + h * 64 + d]; }
            __syncthreads();
            for (int e = F.tid; e < 128 * 64; e += 512) { const int r = e >> 6, kk = e & 63; float s = 0.f;
#pragma unroll 16
                for (int d = 0; d < 64; ++d) s += A[kk * 65 + d] * Bm[r * 65 + d];
                WIN1[(size_t)(h * 128 + r) * D + k0 + kk] = (bf16_t)f2bf(s); }
        } else if (it >= 160) {
            const int j = it - 160, h = j >> 4, n0 = (j & 15) * 64; const float* wuv = F.ap->in[I_WUV] + (size_t)l * 128 * 512; const float* wpa = F.ap->in[I_WPA] + (size_t)l * 512 * D;
            LAS float* A = L; LAS float* Bm = L + 64 * 65;
            for (int e = F.tid; e < 64 * 64; e += 512) { const int d = e >> 6, nn = e & 63; A[d * 65 + nn] = wpa[(size_t)(h * 64 + d) * D + n0 + nn]; }
            for (int e = F.tid; e < 128 * 64; e += 512) { const int r = e >> 6, d = e & 63; Bm[r * 65 + d] = wuv[(size_t)r * 512 + h * 64 + d]; }
            __syncthreads();
            for (int e = F.tid; e < 128 * 64; e += 512) { const int nn = e >> 7, r = e & 127; float s = 0.f;
#pragma unroll 16
                for (int d = 0; d < 64; ++d) s += A[d * 65 + nn] * Bm[r * 65 + d];
                WMRG[(size_t)(n0 + nn) * BRW + h * 128 + r] = (bf16_t)f2bf(s); }
        } else {
            const int g = it;
            const float* are = F.ap->in[I_S5ARE] + (size_t)l * 2048 + g * 64; const float* aim = F.ap->in[I_S5AIM] + (size_t)l * 2048 + g * 64;
            const float dt = __expf(F.ap->in[I_S5LDT][l * 32 + g]);
            const float* bre = F.ap->in[I_S5BRE] + (size_t)l * 32768 + g * 1024; const float* bim = F.ap->in[I_S5BIM] + (size_t)l * 32768 + g * 1024;
            const float* cre = F.ap->in[I_S5CRE] + (size_t)l * 32768 + g * 1024; const float* cim = F.ap->in[I_S5CIM] + (size_t)l * 32768 + g * 1024;
            const float* dd = F.ap->in[I_S5D] + (size_t)l * 512 + g * 16;
            LAS float* PWR = L;
            LAS float* PWI = L + 1088;
            LAS float* BBR = L + 2176;
            LAS float* BBI = BBR + 1024;
            LAS float* CR = BBI + 1024;
            LAS float* CI = CR + 1024;
            LAS float* KT = CI + 1024;
            for (int e = F.tid; e < 17 * 64; e += 512) { const int j = e >> 6, p = e & 63; const float mag = expf(dt * are[p] * (float)j), a = dt * aim[p] * (float)j; PWR[e] = mag * cosf(a); PWI[e] = mag * sinf(a); }
            for (int e = F.tid; e < 1024; e += 512) { const int p = e >> 4; const float ar = are[p], ai = aim[p];
                const float mag = expf(dt * ar), a = dt * ai, abr = mag * cosf(a), abi = mag * sinf(a), den = ar * ar + ai * ai, nr = abr - 1.f;
                const float fre = (nr * ar + abi * ai) / den, fim = (abi * ar - nr * ai) / den;
                BBR[e] = fre * bre[e] - fim * bim[e]; BBI[e] = fre * bim[e] + fim * bre[e]; CR[e] = cre[e]; CI[e] = cim[e]; }
            __syncthreads();
            for (int e = F.tid; e < 4096; e += 512) { const int j = e >> 8, m = (e >> 4) & 15, mp = e & 15; float s = 0.f;
                for (int p = 0; p < 64; ++p) { const float cr = CR[m * 64 + p], ci = CI[m * 64 + p], pr = PWR[j * 64 + p], pi = PWI[j * 64 + p], br = BBR[p * 16 + mp], bi = BBI[p * 16 + mp];
                    const float zr = cr * pr - ci * pi, zi = cr * pi + ci * pr; s += zr * br - zi * bi; }
                KT[e] = s; }
            __syncthreads();
            bf16_t* W1 = (bf16_t*)(F.ws + WS_S5W1) + (size_t)g * 256 * 256; bf16_t* TT = (bf16_t*)(F.ws + WS_S5T) + (size_t)g * 256 * 384;
            for (int e = F.tid; e < 256 * 256; e += 512) { const int n = e >> 8, k = e & 255; float v = 0.f;
                if (n < 128) { const int p = n & 63, s = k >> 4, m = k & 15, j = 15 - s; const float pr = PWR[j * 64 + p], pi = PWI[j * 64 + p], br = BBR[p * 16 + m], bi = BBI[p * 16 + m];
                    v = (n < 64) ? (pr * br - pi * bi) : (pr * bi + pi * br); }
                W1[e] = (bf16_t)f2bf(v); }
            for (int e = F.tid; e < 256 * 384; e += 512) { const int n = e / 384, k = e % 384, t = n >> 4, m = n & 15; float v = 0.f;
                if (k < 256) { const int s = k >> 4, mp = k & 15; if (s <= t) { v = KT[((t - s) * 16 + m) * 16 + mp]; if (s == t && m == mp) v += dd[m]; } }
                else { const int p = (k - 256) & 63; const float cr = CR[m * 64 + p], ci = CI[m * 64 + p], pr = PWR[(t + 1) * 64 + p], pi = PWI[(t + 1) * 64 + p];
                    v = (k < 320) ? (cr * pr - ci * pi) : -(cr * pi + ci * pr); }
                TT[e] = (bf16_t)f2bf(v); }
            float* S5P = (float*)(F.ws + WS_S5P) + (size_t)g * 128;
            for (int e = F.tid; e < 64; e += 512) { S5P[e] = PWR[16 * 64 + e]; S5P[64 + e] = PWI[16 * 64 + e]; }
        }
    }
    __syncthreads();
    LAS float* scr = (LAS float*)(F.lds + F.wave * 16384);
    gu32* ctr = (gu32*)(F.ws + WS_CTL) + CW_Q + (16 + l) * 64;
    constexpr int N0 = 1536, N1 = N0 + 1536, N2 = N1 + 256, N3 = N2 + 256, N4 = N3 + 512, N5 = N4 + 2816, N6 = N5 + 1408, N7 = N6 + 128;
    for (;;) {
        unsigned gi = 0u; if (F.lane == 0) gi = __hip_atomic_fetch_add(ctr, 8u, RLX_AGENT);
        const int it0 = __builtin_amdgcn_readfirstlane((int)gi);
        if (it0 >= N7) break;
#pragma unroll 1
        for (int it = it0; it < it0 + 8 && it < N7; ++it) {
        if (it < N0) tr_one(F.lane, it, w_in, NIN, ang, WIN1, D, 0, 1024, 3072, 1, scr);
        else if (it < N1) tr_one(F.lane, it - N0, w_in, NIN, ang, (bf16_t*)(F.ws + WS_WIN2), D, 0, 0, GW, 2, scr);
        else if (it < N2) tr_one(F.lane, it - N1, F.ap->in[I_WPB] + (size_t)l * 512 * D, D, nullptr, WMRG, BRW, 1024, 0, D, 0, scr);
        else if (it < N3) tr_one(F.lane, it - N2, F.ap->in[I_WPC] + (size_t)l * 512 * D, D, nullptr, WMRG, BRW, 1536, 0, D, 0, scr);
        else if (it < N4) tr_one(F.lane, it - N3, F.ap->in[I_WOUT] + (size_t)l * D * D, D, nullptr, (bf16_t*)(F.ws + WS_WOUT), D, 0, 0, D, 0, scr);
        else if (it < N5) tr_one(F.lane, it - N4, F.ap->in[I_WUP] + (size_t)l * D * 2 * DFF, 2 * DFF, F.ap->in[I_FNG] + (size_t)l * D, (bf16_t*)(F.ws + WS_WUP), D, 0, 0, 2 * DFF, 3, scr);
        else if (it < N6) tr_one(F.lane, it - N5, F.ap->in[I_WDN] + (size_t)l * DFF * D, D, nullptr, (bf16_t*)(F.ws + WS_WDN), DFF, 0, 0, D, 0, scr);
        else tr_one(F.lane, it - N6, F.ap->in[I_WGLU] + (size_t)l * 512 * 512, 512, nullptr, (bf16_t*)(F.ws + WS_WGLU), 512, 0, 0, 512, 0, scr);
        }
    }
}

__device__ __forceinline__ void ph_prep_a(Frame& F, int l) {
    const bf16_t* P1 = (const bf16_t*)(F.ws + WS_P1); bf16_t* CN = (bf16_t*)(F.ws + WS_CN);
    const float* kvg = F.ap->in[I_KVG] + (size_t)l * 128;
    const int gw = F.bid * 8 + F.wave, NGW = F.G * 8;
    for (int r = gw; r < MH; r += NGW) {
        const unsigned w = *((const unsigned*)(P1 + (size_t)r * P1W + C_CKV) + F.lane); const float a = bflo(w), b = bfhi(w);
        const float rs = 1.f / sqrtf(wave_sum(a * a + b * b) * (1.f / 128.f) + EPS);
        *((unsigned*)(CN + (size_t)r * 128) + F.lane) = pk2(a * rs * kvg[2 * F.lane], b * rs * kvg[2 * F.lane + 1]);
    }
}

#ifndef GP_REP_A
#define GP_REP_A 1
#endif
#ifndef GP_REP_B
#define GP_REP_B 1
#endif
#ifndef GP_REP_C
#define GP_REP_C 1
#endif
#ifndef GP_REP_D
#define GP_REP_D 1
#endif
__device__ __forceinline__ int gdn_pos(int r, int x, int rowlen) {
    const int g = x >> 5, y = x & 31;
    const int p = (y < 16) ? (8 * (y >> 2) + (y & 3)) : (8 * ((y - 16) >> 2) + 4 + (y & 3));
    const int P = g * 32 + p, chunk = P >> 3, mask = (rowlen == 128) ? 15 : 7;
    return ((chunk ^ (r & mask)) << 3) + (P & 7);
}
__device__ __forceinline__ void ph_gdn_prep(Frame& F, int l) {
    const bf16_t* P1 = (const bf16_t*)(F.ws + WS_P1); bf16_t* GD = (bf16_t*)(F.ws + WS_GDN); float* GLAST = (float*)(F.ws + WS_GLAST);
    const float* cw = F.ap->in[I_GCW] + (size_t)l * 4 * 1536;
    const bf16_t* zpage = (const bf16_t*)(F.ws + WS_CTL + 786432);
    constexpr int RS = 132, RB = 136, RT_S = 72, MS = 68;
    LAS float* qs = (LAS float*)F.lds; LAS float* ks = qs + 64 * RS;
    LAS float* Mm = (LAS float*)F.lds; LAS float* Tm = Mm + 64 * MS; LAS float* Pt = Tm + 64 * MS; LAS bf16_t* Tb = (LAS bf16_t*)(Pt + 768);
    LAS bf16_t* qb = (LAS bf16_t*)(F.lds + 2 * 64 * RS * 4); LAS bf16_t* kb = qb + 64 * RB; LAS bf16_t* RT = kb + 64 * RB;
    LAS float* gam = (LAS float*)(RT + 256 * RT_S); LAS float* bet = gam + 64; LAS float* egam = bet + 64;
    LAS float* wl = (LAS float*)(F.lds + 49152);
    const int wave = F.wave;
    for (int cu = F.bid; cu < BH * 4 * 64; cu += F.G) {
        int lane_ = F.lane; asm volatile("" : "+v"(lane_));
        const int lane = lane_, tid = wave * 64 + lane, n = lane & 15, qd = lane >> 4;
        const int bl = cu >> 8, h = (cu >> 6) & 3, ch = cu & 63, t0 = ch * 64;
        const size_t rbase = (size_t)bl * T;
        bf16_t* rec = GD + (size_t)cu * GDN_CH;
        __syncthreads();
#pragma unroll 1
        for (int rep_ = 0; rep_ < GP_REP_A; ++rep_) {
        const int r8 = lane >> 3, part = lane & 7, d0 = part * 16, i = 8 * wave + r8, t = t0 + i;
        float wv[3];
#pragma unroll
        for (int m = 0; m < 3; ++m) wv[m] = cw[(tid >> 7) * 1536 + m * 512 + h * 128 + (tid & 127)];
        u32x4 xr[3][4][2];
#pragma unroll
        for (int k = 0; k < 4; ++k) { const int tt = t - 3 + k; const bf16_t* p = (tt < 0) ? zpage : P1 + (rbase + tt) * P1W + C_QKV + h * 128 + d0;
#pragma unroll
            for (int j3 = 0; j3 < 3; ++j3) { xr[j3][k][0] = *(const u32x4*)(p + j3 * 512); xr[j3][k][1] = *(const u32x4*)(p + j3 * 512 + 8); } }
        if (wave == 0) { const bf16_t* rp = P1 + (rbase + t0 + lane) * P1W; const float a = bf2f(rp[C_CA + h]), b = bf2f(rp[C_CB + h]);
            float g = -__expf(F.ap->in[I_GALOG][l * 4 + h]) * softplusf_(a + F.ap->in[I_GDTB][l * 4 + h]);
#pragma unroll
            for (int o = 1; o < 64; o <<= 1) { const float up = __shfl_up(g, o); if (lane >= o) g += up; }
            gam[lane] = g; bet[lane] = sigmoidf_(b); egam[lane] = __expf(g); if (lane == 63) GLAST[cu] = __expf(g); }
#pragma unroll
        for (int m = 0; m < 3; ++m) wl[m * 512 + tid] = wv[m];
        __syncthreads();
        { const float gl = gam[63]; const int rsw = ((wave ^ part) << 3) + r8;
#pragma unroll
          for (int j3 = 0; j3 < 3; ++j3) {
            float y[16];
#pragma unroll
            for (int c = 0; c < 16; ++c) y[c] = 0.f;
#pragma unroll
            for (int k = 0; k < 4; ++k) {                 const LAS f32x4* wp = (const LAS f32x4*)(wl + (j3 * 4 + k) * 128 + d0); const f32x4 w0 = wp[0], w1 = wp[1], w2 = wp[2], w3 = wp[3];
                const u32x4 x0 = xr[j3][k][0], x1 = xr[j3][k][1];
                y[0] += w0[0] * bflo(x0[0]); y[1] += w0[1] * bfhi(x0[0]); y[2] += w0[2] * bflo(x0[1]); y[3] += w0[3] * bfhi(x0[1]);
                y[4] += w1[0] * bflo(x0[2]); y[5] += w1[1] * bfhi(x0[2]); y[6] += w1[2] * bflo(x0[3]); y[7] += w1[3] * bfhi(x0[3]);
                y[8] += w2[0] * bflo(x1[0]); y[9] += w2[1] * bfhi(x1[0]); y[10] += w2[2] * bflo(x1[1]); y[11] += w2[3] * bfhi(x1[1]);
                y[12] += w3[0] * bflo(x1[2]); y[13] += w3[1] * bfhi(x1[2]); y[14] += w3[2] * bflo(x1[3]); y[15] += w3[3] * bfhi(x1[3]); }
#pragma unroll
            for (int c = 0; c < 16; ++c) y[c] = siluf_(y[c]);
            if (j3 == 2) { const float b = bet[i];
#pragma unroll
                for (int c = 0; c < 16; ++c) RT[(d0 + c) * RT_S + rsw] = (bf16_t)f2bf(y[c] * b); }
            else { const bool isq = (j3 == 0); float ss = 0.f;
#pragma unroll
                for (int c = 0; c < 16; ++c) ss += y[c] * y[c];
                ss += __shfl_xor(ss, 1); ss += __shfl_xor(ss, 2); ss += __shfl_xor(ss, 4);
                float rs = 1.f / sqrtf(ss + EPS); if (isq) rs *= 0.08838834764831845f;
                f32x4 v[4];
#pragma unroll
                for (int q = 0; q < 4; ++q) v[q] = (f32x4){y[4 * q] * rs, y[4 * q + 1] * rs, y[4 * q + 2] * rs, y[4 * q + 3] * rs};
                LAS bf16_t* cb = (isq ? qb : kb) + i * RB + d0;
                *(LAS u32x4*)cb = pack8(v[0], v[1]); *(LAS u32x4*)(cb + 8) = pack8(v[2], v[3]);
                if (isq) { const float eq = egam[i];
#pragma unroll
                    for (int q = 0; q < 4; ++q) { u32x2 o; o.x = pk2(v[q][0] * eq, v[q][1] * eq); o.y = pk2(v[q][2] * eq, v[q][3] * eq); *(u32x2*)(rec + 8192 + i * 128 + gdn_pos(i, d0 + 4 * q, 128)) = o; } }
                else { const float be = bet[i] * egam[i], ek = __expf(gl - gam[i]);
#pragma unroll
                    for (int q = 0; q < 4; ++q)
#pragma unroll
                        for (int x = 0; x < 4; ++x) { const int d = d0 + 4 * q + x; RT[(128 + d) * RT_S + rsw] = (bf16_t)f2bf(v[q][x] * be); rec[16384 + d * 64 + gdn_pos(d, i, 64)] = (bf16_t)f2bf(v[q][x] * ek); } } } } }
        __syncthreads();
        }
#pragma unroll 1
        for (int rep_ = 0; rep_ < GP_REP_B; ++rep_) {
        { const int mat = wave >> 2, mi = wave & 3; const LAS bf16_t* Asrc = (mat == 0 ? kb : qb) + (16 * mi + n) * RB + qd * 8;
          bf16x8 af[4];
#pragma unroll
          for (int s2 = 0; s2 < 4; ++s2) af[s2] = *(const LAS bf16x8*)(Asrc + 32 * s2);
          f32x4 cc[4];
#pragma unroll
          for (int mj = 0; mj < 4; ++mj) { cc[mj] = (f32x4){0.f, 0.f, 0.f, 0.f}; const LAS bf16_t* Bsrc = kb + (16 * mj + n) * RB + qd * 8;
#pragma unroll
              for (int s2 = 0; s2 < 4; ++s2) cc[mj] = __builtin_amdgcn_mfma_f32_16x16x32_bf16(af[s2], *(const LAS bf16x8*)(Bsrc + 32 * s2), cc[mj], 0, 0, 0); }
          __syncthreads();
#pragma unroll
          for (int mj = 0; mj < 4; ++mj) { const int j = 16 * mj + n; const float gj = gam[j];
#pragma unroll
              for (int rg = 0; rg < 4; ++rg) { const int i = 16 * mi + 4 * qd + rg; const float dec = (i >= j) ? __expf(gam[i] - gj) : 0.f;
                  if (mat == 0) { Mm[i * MS + j] = (i > j) ? bet[i] * cc[mj][rg] * dec : 0.f; Tm[i * MS + j] = 0.f; }
                  else rec[24576 + i * 64 + gdn_pos(i, j, 64)] = (bf16_t)f2bf(cc[mj][rg] * dec); } } }
        __syncthreads();
        }
#pragma unroll 1
        for (int rep_ = 0; rep_ < GP_REP_C; ++rep_) {
        if (tid < 64) { const int b = tid >> 4, c = tid & 15; float x[16];
#pragma unroll
            for (int r = 0; r < 16; ++r) { float a = (r == c) ? 1.f : 0.f;
#pragma unroll
                for (int j = 0; j < r; ++j) a -= Mm[(16 * b + r) * MS + 16 * b + j] * x[j];
                x[r] = a; }
#pragma unroll
            for (int r = 0; r < 16; ++r) Tm[(16 * b + r) * MS + 16 * b + c] = x[r]; }
        __syncthreads();
#pragma unroll 1
        for (int dl = 1; dl < 4; ++dl) { const int np = 4 - dl;
            for (int e = tid; e < np * 256; e += 512) { const int pr = e >> 8, r = (e >> 4) & 15, c = e & 15, bi = pr + dl, bj = pr; float a = 0.f;
                for (int kb2 = bj; kb2 < bi; ++kb2)
#pragma unroll
                    for (int t = 0; t < 16; ++t) a += Mm[(16 * bi + r) * MS + 16 * kb2 + t] * Tm[(16 * kb2 + t) * MS + 16 * bj + c];
                Pt[e] = a; }
            __syncthreads();
            for (int e = tid; e < np * 256; e += 512) { const int pr = e >> 8, r = (e >> 4) & 15, c = e & 15, bi = pr + dl, bj = pr; float a = 0.f;
#pragma unroll
                for (int t = 0; t < 16; ++t) a += Tm[(16 * bi + r) * MS + 16 * bi + t] * Pt[(pr * 16 + t) * 16 + c];
                Tm[(16 * bi + r) * MS + 16 * bj + c] = -a; }
            __syncthreads(); }
        for (int e = tid; e < 64 * 32; e += 512) { const int i = e >> 5, j2 = (e & 31) * 2; *(LAS unsigned*)(Tb + i * RT_S + j2) = pk2(Tm[i * MS + j2], Tm[i * MS + j2 + 1]); }
        __syncthreads();
        }
#pragma unroll 1
        for (int rep_ = 0; rep_ < GP_REP_D; ++rep_) {
        { bf16x8 tf[4][2];
#pragma unroll
          for (int mi = 0; mi < 4; ++mi)
#pragma unroll
              for (int s2 = 0; s2 < 2; ++s2) tf[mi][s2] = *(const LAS bf16x8*)(Tb + (16 * mi + n) * RT_S + 32 * s2 + qd * 8);
#pragma unroll
          for (int nl = 0; nl < 2; ++nl) { const int c = 16 * (2 * wave + nl) + n; bf16x8 rf[2];
#pragma unroll
              for (int s2 = 0; s2 < 2; ++s2) rf[s2] = *(const LAS bf16x8*)(RT + c * RT_S + (((4 * s2 + qd) ^ ((2 * wave + nl) & 7)) << 3));
#pragma unroll
              for (int mi = 0; mi < 4; ++mi) { f32x4 a = {0.f, 0.f, 0.f, 0.f};
#pragma unroll
                  for (int s2 = 0; s2 < 2; ++s2) a = __builtin_amdgcn_mfma_f32_16x16x32_bf16(tf[mi][s2], rf[s2], a, 0, 0, 0);
                  if (wave < 4) { u32x2 o; o.x = pk2(a[0], a[1]); o.y = pk2(a[2], a[3]); *(u32x2*)(rec + 28672 + c * 64 + 16 * mi + 4 * qd) = o; }
                  else { const int d = c - 128;
#pragma unroll
                      for (int rg = 0; rg < 4; ++rg) { const int i = 16 * mi + 4 * qd + rg; rec[i * 128 + gdn_pos(i, d, 128)] = (bf16_t)f2bf(a[rg]); } } } } }
        }
    }
}

__device__ __forceinline__ void gdn_dma(const bf16_t* rec, LAS unsigned char* buf, int tid, int wave) {
#pragma unroll
    for (int r = 0; r < 7; ++r) __builtin_amdgcn_global_load_lds((const unsigned*)((const char*)rec + r * 8192 + tid * 16), (LAS unsigned*)(buf + r * 8192 + wave * 1024), 16, 0, 0);
}
__device__ __forceinline__ bf16x8 pack_b(const f32x4 v0, const f32x4 v1) { return __builtin_bit_cast(bf16x8, pack8(v0, v1)); }
__device__ __forceinline__ void ph_gdn_chain(Frame& F, int l) {
    const bf16_t* GD = (const bf16_t*)(F.ws + WS_GDN); const float* GLAST = (const float*)(F.ws + WS_GLAST); const bf16_t* P1 = (const bf16_t*)(F.ws + WS_P1); bf16_t* BR = (bf16_t*)(F.ws + WS_BR);
    const float* ng = F.ap->in[I_GNG] + (size_t)l * 128;
    LAS unsigned char* L = F.lds; LAS unsigned char* obuf = L + 2 * 57344;
    const int tid = F.tid, lane = F.lane, w = F.wave, n = lane & 15, qd = lane >> 4;
    float gn[16];
#pragma unroll
    for (int q = 0; q < 16; ++q) gn[q] = ng[(lane & 7) * 16 + q];
    for (int bh = F.bid; bh < BH * 4; bh += F.G) {
        const int bl = bh >> 2, h = bh & 3;
        f32x4 S[8];
#pragma unroll
        for (int m = 0; m < 8; ++m) S[m] = (f32x4){0.f, 0.f, 0.f, 0.f};
        u32x2 up[4]; unsigned zp[8]; float lastp;
        { const bf16_t* rec = GD + (size_t)(bh * 64) * GDN_CH;
#pragma unroll
          for (int m = 0; m < 4; ++m) up[m] = *(const u32x2*)(rec + 28672 + (16 * w + n) * 64 + 16 * m + 4 * qd);
          lastp = GLAST[bh * 64];
          asm volatile("" ::: "memory");
          __syncthreads();
          gdn_dma(rec, L, tid, w); }
#pragma unroll
        for (int rr = 0; rr < 8; ++rr) zp[rr] = 0u;
#define GDN_NORM(chn, zc) do { const int r8 = lane >> 3, part = lane & 7, row = 8 * w + r8; \
            const u32x4 oa = *(const LAS u32x4*)(obuf + row * 256 + part * 32), ob = *(const LAS u32x4*)(obuf + row * 256 + part * 32 + 16); float ss = 0.f; \
            _Pragma("unroll") for (int q = 0; q < 4; ++q) { ss += bflo(oa[q]) * bflo(oa[q]) + bfhi(oa[q]) * bfhi(oa[q]) + bflo(ob[q]) * bflo(ob[q]) + bfhi(ob[q]) * bfhi(ob[q]); } \
            ss += __shfl_xor(ss, 1); ss += __shfl_xor(ss, 2); ss += __shfl_xor(ss, 4); \
            const float rs = 1.f / sqrtf(ss * (1.f / 128.f) + EPS); u32x4 ya, yb; \
            _Pragma("unroll") for (int q = 0; q < 4; ++q) { \
                ya[q] = pk2(bflo(oa[q]) * rs * gn[2 * q] * siluf_(bflo(zc[q])), bfhi(oa[q]) * rs * gn[2 * q + 1] * siluf_(bfhi(zc[q]))); \
                yb[q] = pk2(bflo(ob[q]) * rs * gn[8 + 2 * q] * siluf_(bflo(zc[4 + q])), bfhi(ob[q]) * rs * gn[8 + 2 * q + 1] * siluf_(bfhi(zc[4 + q]))); } \
            bf16_t* dst = BR + ((size_t)bl * T + (chn) * 64 + row) * BRW + 1536 + h * 128 + part * 16; *(u32x4*)dst = ya; *(u32x4*)(dst + 8) = yb; } while (0)
        for (int ch = 0; ch < 64; ++ch) {
            const int cu = bh * 64 + ch, cur = ch & 1;
            asm volatile("s_waitcnt vmcnt(0) lgkmcnt(0)\n\ts_barrier" ::: "memory");
            u32x2 uc[4]; unsigned zc[8]; const float last = lastp;
#pragma unroll
            for (int m = 0; m < 4; ++m) uc[m] = up[m];
#pragma unroll
            for (int rr = 0; rr < 8; ++rr) zc[rr] = zp[rr];
#ifndef REP_NORM
#define REP_NORM 1
#endif
            for (int rp_ = 0; rp_ < REP_NORM; ++rp_) { if (ch > 0) GDN_NORM(ch - 1, zc); }
            { const int cn = (ch + 1 < 64) ? cu + 1 : cu; const bf16_t* rec = GD + (size_t)cn * GDN_CH;
#pragma unroll
                for (int m = 0; m < 4; ++m) up[m] = *(const u32x2*)(rec + 28672 + (16 * w + n) * 64 + 16 * m + 4 * qd);
                lastp = GLAST[cn];
                { const bf16_t* zsrc = P1 + ((size_t)bl * T + ch * 64 + 8 * w + (lane >> 3)) * P1W + C_Z + h * 128 + (lane & 7) * 16; const u32x4 z0 = *(const u32x4*)zsrc, z1 = *(const u32x4*)(zsrc + 8);
#pragma unroll
                  for (int q = 0; q < 4; ++q) { zp[q] = z0[q]; zp[4 + q] = z1[q]; } }
                asm volatile("" ::: "memory");
                if (ch + 1 < 64) gdn_dma(rec, L + (cur ^ 1) * 57344, tid, w); }
            const LAS unsigned char* B = L + cur * 57344;
            const int rb256 = n * 256, rb128 = n * 128; int xo[4], x7[2];
#pragma unroll
            for (int s2 = 0; s2 < 4; ++s2) xo[s2] = ((4 * s2 + qd) ^ n) << 4;
#pragma unroll
            for (int s2 = 0; s2 < 2; ++s2) x7[s2] = ((4 * s2 + qd) ^ (n & 7)) << 4;
#define GF(off) (*(const LAS bf16x8*)(B + (off)))
#define LD_G1(f, m) do { _Pragma("unroll") for (int s2 = 0; s2 < 4; ++s2) { f[s2] = GF((16 * (m)) * 256 + rb256 + xo[s2]); f[4 + s2] = GF(16384 + (16 * (m)) * 256 + rb256 + xo[s2]); } } while (0)
#define MM_G1(f, m) do { _Pragma("unroll") for (int s2 = 0; s2 < 4; ++s2) { WS[m] = __builtin_amdgcn_mfma_f32_16x16x32_bf16(f[s2], Sb[s2], WS[m], 0, 0, 0); QS[m] = __builtin_amdgcn_mfma_f32_16x16x32_bf16(f[4 + s2], Sb[s2], QS[m], 0, 0, 0); } } while (0)
#define LD_AT(f) do { _Pragma("unroll") for (int m = 0; m < 4; ++m) _Pragma("unroll") for (int s2 = 0; s2 < 2; ++s2) f[2 * m + s2] = GF(49152 + (16 * m) * 128 + rb128 + x7[s2]); } while (0)
#define MM_AT(f) do { _Pragma("unroll") for (int m = 0; m < 4; ++m) _Pragma("unroll") for (int s2 = 0; s2 < 2; ++s2) QS[m] = __builtin_amdgcn_mfma_f32_16x16x32_bf16(f[2 * m + s2], Vb[s2], QS[m], 0, 0, 0); } while (0)
#define LD_KT(f, hf) do { _Pragma("unroll") for (int m = 0; m < 4; ++m) _Pragma("unroll") for (int s2 = 0; s2 < 2; ++s2) f[2 * m + s2] = GF(32768 + (16 * (4 * (hf) + m)) * 128 + rb128 + x7[s2]); } while (0)
#define MM_KT(f, hf) do { _Pragma("unroll") for (int m = 0; m < 4; ++m) _Pragma("unroll") for (int s2 = 0; s2 < 2; ++s2) S[4 * (hf) + m] = __builtin_amdgcn_mfma_f32_16x16x32_bf16(f[2 * m + s2], Vb[s2], S[4 * (hf) + m], 0, 0, 0); } while (0)
#define SBAR __builtin_amdgcn_sched_barrier(0)
            bf16x8 Sb[4];
#pragma unroll
            for (int s2 = 0; s2 < 4; ++s2) Sb[s2] = pack_b(S[2 * s2], S[2 * s2 + 1]);
            f32x4 WS[4], QS[4];
#pragma unroll
            for (int m = 0; m < 4; ++m) { WS[m] = (f32x4){0.f, 0.f, 0.f, 0.f}; QS[m] = (f32x4){0.f, 0.f, 0.f, 0.f}; }
            bf16x8 fa[8], fb[8];
            LD_G1(fa, 0); SBAR;
            LD_G1(fb, 1); SBAR; MM_G1(fa, 0); SBAR;
            LD_G1(fa, 2); SBAR; MM_G1(fb, 1); SBAR;
            LD_G1(fb, 3); SBAR; MM_G1(fa, 2); SBAR;
            LD_AT(fa);    SBAR; MM_G1(fb, 3); SBAR;
            f32x4 vn[4];
#pragma unroll
            for (int m = 0; m < 4; ++m) { vn[m][0] = bflo(uc[m].x) - WS[m][0]; vn[m][1] = bfhi(uc[m].x) - WS[m][1]; vn[m][2] = bflo(uc[m].y) - WS[m][2]; vn[m][3] = bfhi(uc[m].y) - WS[m][3]; }
            bf16x8 Vb[2]; Vb[0] = pack_b(vn[0], vn[1]); Vb[1] = pack_b(vn[2], vn[3]);
#pragma unroll
            for (int mk = 0; mk < 8; ++mk) S[mk] = S[mk] * last;
            LD_KT(fb, 0); SBAR; MM_AT(fa); SBAR;
            LD_KT(fa, 1); SBAR; MM_KT(fb, 0); SBAR;
            MM_KT(fa, 1);
#undef GF
#undef LD_G1
#undef MM_G1
#undef LD_AT
#undef MM_AT
#undef LD_KT
#undef MM_KT
#undef SBAR
            asm volatile("s_waitcnt lgkmcnt(0)\n\ts_barrier" ::: "memory");
#pragma unroll
            for (int m = 0; m < 4; ++m)
#pragma unroll
                for (int j = 0; j < 4; ++j) *(LAS bf16_t*)(obuf + ((16 * m + 4 * qd + j) * 128 + 16 * w + n) * 2) = (bf16_t)f2bf(QS[m][j]);
        }
        asm volatile("s_waitcnt vmcnt(0) lgkmcnt(0)\n\ts_barrier" ::: "memory");
        GDN_NORM(63, zp);
#undef GDN_NORM
        asm volatile("s_waitcnt vmcnt(0)" ::: "memory");
        __syncthreads();
    }
}

struct OneUnit { int pm, pn; __device__ bool next(int i, Unit& u) const { if (i != 0) return false; u.pm = pm; u.pn = pn; return true; } };
__device__ __forceinline__ void s5_unit(Frame& F, int g, int bi) {
    float* S = (float*)(F.ws + WS_S5S); bf16_t* S5A = (bf16_t*)(F.ws + WS_S5A); const float* S5P = (const float*)(F.ws + WS_S5P);
    { pg8::Gemm gm{(const bf16_t*)S5A, (const bf16_t*)(F.ws + WS_S5W1), S5LD, 256, 256}; OneUnit U{g * 4 + bi, g}; EpiS5S E{S}; pg8::gemm_phase(F.lds, F.tid, gm, U, E); }
    asm volatile("s_waitcnt vmcnt(0)" ::: "memory"); __syncthreads();
    __builtin_amdgcn_fence(__ATOMIC_ACQUIRE, "agent"); asm volatile("s_waitcnt vmcnt(0)" ::: "memory");
    {
        const int p = F.lane, k = F.wave; const size_t r0 = (size_t)(g * 4 + bi) * 256 + 32 * k;
        const float ar = S5P[g * 128 + p], ai = S5P[g * 128 + 64 + p];
        float sr[32], si[32];
#pragma unroll
        for (int j = 0; j < 32; ++j) { sr[j] = S[(r0 + j) * 128 + p]; si[j] = S[(r0 + j) * 128 + 64 + p]; }
        float lr = 0.f, li = 0.f;
#pragma unroll
        for (int j = 0; j < 32; ++j) { const float xr = sr[j], xi = si[j]; sr[j] = lr; si[j] = li; const float nr = ar * lr - ai * li + xr, ni = ar * li + ai * lr + xi; lr = nr; li = ni; }
        LAS float* ex = (LAS float*)F.lds;
        ex[k * 128 + p] = lr; ex[k * 128 + 64 + p] = li;
        float a32r = ar, a32i = ai;
#pragma unroll
        for (int q = 0; q < 5; ++q) { const float tr = a32r * a32r - a32i * a32i, ti = 2.f * a32r * a32i; a32r = tr; a32i = ti; }
        __syncthreads();
        float cr = 0.f, ci = 0.f;
        for (int k2 = 0; k2 < k; ++k2) { const float er = ex[k2 * 128 + p], ei = ex[k2 * 128 + 64 + p]; const float nr = a32r * cr - a32i * ci + er, ni = a32r * ci + a32i * cr + ei; cr = nr; ci = ni; }
        float pr = 1.f, pi = 0.f;
#pragma unroll
        for (int j = 0; j < 32; ++j) { const float hr = sr[j] + pr * cr - pi * ci, hi = si[j] + pr * ci + pi * cr;
            S5A[(r0 + j) * S5LD + 256 + p] = (bf16_t)f2bf(hr); S5A[(r0 + j) * S5LD + 320 + p] = (bf16_t)f2bf(hi);
            const float tr = pr * ar - pi * ai, ti = pr * ai + pi * ar; pr = tr; pi = ti; }
    }
    asm volatile("s_waitcnt vmcnt(0)" ::: "memory"); __syncthreads();
    __builtin_amdgcn_fence(__ATOMIC_ACQUIRE, "agent"); asm volatile("s_waitcnt vmcnt(0)" ::: "memory");
    { pg8::Gemm gm{(const bf16_t*)S5A, (const bf16_t*)(F.ws + WS_S5T), S5LD, S5LD, S5LD}; OneUnit U{g * 4 + bi, g}; EpiS5Y E{(bf16_t*)(F.ws + WS_YG)}; pg8::gemm_phase(F.lds, F.tid, gm, U, E); }
}

__device__ __forceinline__ unsigned umed3_(unsigned a, unsigned b, unsigned c) { unsigned r; asm("v_med3_u32 %0, %1, %2, %3" : "=v"(r) : "v"(a), "v"(b), "v"(c)); return r; }
template <int NR, bool SURV>
__device__ __forceinline__ void sel_core(const unsigned (&key)[NR], int lane, LAS int* ixo, const LAS int* sidx, unsigned Kt0, int topbit) {
    constexpr int NVB = (NR >= 64) ? 7 : (NR >= 32) ? 6 : (NR >= 16) ? 5 : 4;
    unsigned Kt = Kt0;
    for (int bit = topbit; bit >= 0; --bit) { const unsigned cand = Kt | (1u << bit); unsigned cl = 0u;
#pragma unroll
        for (int i = 0; i < NR; ++i) cl += (key[i] >= cand) ? 1u : 0u;
        int cnt = 0;
#pragma unroll
        for (int b = 0; b < NVB; ++b) cnt += __builtin_popcountll(__ballot((cl >> b) & 1u)) << b;
        if (cnt >= 256) { Kt = cand; if (cnt == 256) break; } }
    int ngt = 0;
    { unsigned cl = 0u;
#pragma unroll
      for (int i = 0; i < NR; ++i) cl += (key[i] > Kt) ? 1u : 0u;
#pragma unroll
      for (int b = 0; b < NVB; ++b) ngt += __builtin_popcountll(__ballot((cl >> b) & 1u)) << b; }
    const int need = 256 - ngt; int pos = 0, ties = 0; const unsigned long long lt = (1ull << lane) - 1ull;
#pragma unroll
    for (int i = 0; i < NR; ++i) { const bool gtk = key[i] > Kt, eq = key[i] == Kt; const unsigned long long mt = __ballot(eq);
        const bool take = gtk || (eq && (ties + __builtin_popcountll(mt & lt)) < need); const unsigned long long mk = __ballot(take);
        if (take) { const int pp = pos + __builtin_popcountll(mk & lt); if (pp < 256) ixo[pp] = SURV ? sidx[i * 64 + lane] : i * 64 + lane; }
        pos += __builtin_popcountll(mk); ties += __builtin_popcountll(mt); }
}
template <int NR>
__device__ __forceinline__ void dsa_select(const LAS float* row, int limit, int lane, LAS int* ixo) {
    unsigned key[NR];
    const int nreg = limit >> 6;
#pragma unroll
    for (int i = 0; i < NR; ++i) { unsigned kx = 0u; if (i < nreg) { const unsigned b = __builtin_bit_cast(unsigned, row[i * 64 + lane]); kx = (b & 0x80000000u) ? ~b : (b | 0x80000000u); } key[i] = kx; }
    WAVE_SYNC();
    if (NR >= 32) {
        unsigned a1 = 0u, a2 = 0u, a3 = 0u, a4 = 0u;
#pragma unroll
        for (int i = 0; i < NR; ++i) { const unsigned k = key[i]; a4 = umed3_(a3, a4, k); a3 = umed3_(a2, a3, k); a2 = umed3_(a1, a2, k); a1 = (a1 > k) ? a1 : k; }
        unsigned L = a4, Mx = a1;
#pragma unroll
        for (int o = 1; o < 64; o <<= 1) { const unsigned x = (unsigned)__shfl_xor((int)L, o); L = (x < L) ? x : L; const unsigned y = (unsigned)__shfl_xor((int)Mx, o); Mx = (y > Mx) ? y : Mx; }
        int S = 0;
#pragma unroll
        for (int i = 0; i < NR; ++i) S += __builtin_popcountll(__ballot(key[i] >= L));
        if (S <= 1024) {
            LAS unsigned* sk = (LAS unsigned*)row + 1024; LAS int* si = (LAS int*)row + 2048; int base = 0;
#pragma unroll
            for (int i = 0; i < NR; ++i) { const bool p = key[i] >= L; const unsigned long long m = __ballot(p);
                if (p) { const int pp = base + (int)__builtin_amdgcn_mbcnt_hi((unsigned)(m >> 32), __builtin_amdgcn_mbcnt_lo((unsigned)m, 0u)); sk[pp] = key[i]; si[pp] = i * 64 + lane; }
                base += __builtin_popcountll(m); }
            WAVE_SYNC();
            const unsigned dx = Mx - L + 1u; const int tb = 31 - __builtin_clz(dx);
            if (S <= 768) { unsigned k2[12];
#pragma unroll
                for (int j = 0; j < 12; ++j) k2[j] = (j * 64 + lane < S) ? sk[j * 64 + lane] - L + 1u : 0u;
                sel_core<12, true>(k2, lane, ixo, si, 0u, tb); }
            else { unsigned k2[16];
#pragma unroll
                for (int j = 0; j < 16; ++j) k2[j] = (j * 64 + lane < S) ? sk[j * 64 + lane] - L + 1u : 0u;
                sel_core<16, true>(k2, lane, ixo, si, 0u, tb); }
            return;
        }
    }
    sel_core<NR, false>(key, lane, ixo, nullptr, 0u, 31);
}
__device__ __forceinline__ float relu_bits(float x) { return __builtin_bit_cast(float, __builtin_elementwise_max(__builtin_bit_cast(int, x), 0)); }
__device__ __forceinline__ void dsa_unit(Frame& F, int un) {
    const bf16_t* P1 = (const bf16_t*)(F.ws + WS_P1); const bf16_t* CN = (const bf16_t*)(F.ws + WS_CN); bf16_t* BR = (bf16_t*)(F.ws + WS_BR);
    LAS float* sc = (LAS float*)F.lds; constexpr int SCS = 4100;
    int lane_ = F.lane; asm volatile("" : "+v"(lane_));
    const int lane = lane_, wave = F.wave, n = lane & 15, qd = lane >> 4;
    const int bl = un & 3, qb = 511 - (un >> 2), t0 = qb * 8, limit = ((t0 >> 6) + 1) * 64;
    const size_t rbase = (size_t)bl * T;
    if (limit > 256) {
        bf16x8 bq[2][2]; float iwv[2];
        { const bf16_t* qp = P1 + (rbase + t0 + (n & 7)) * P1W;
#pragma unroll
          for (int pr = 0; pr < 2; ++pr) { const int hh = 2 * pr + (n >> 3);
#pragma unroll
              for (int ks = 0; ks < 2; ++ks) bq[pr][ks] = *(const bf16x8*)(qp + C_IQ + hh * 64 + ks * 32 + qd * 8);
              iwv[pr] = bf2f(qp[C_IW + hh]) * 0.0625f; } }
        const int nkb = limit >> 4;
        const bf16_t* kbase = (const bf16_t*)(F.ws + WS_IKC) + (rbase >> 4) * 1024 + (qd * 16 + n) * 8;
        bf16x8 a0[4], a1[4], A0[4], A1[4], B0[4], B1[4];
#define DSA_LDK(kb, X0, X1) _Pragma("unroll") for (int u4 = 0; u4 < 4; ++u4) { const bf16_t* kp = kbase + (size_t)((kb) + u4) * 1024; X0[u4] = *(const bf16x8*)kp; X1[u4] = *(const bf16x8*)(kp + 512); }
        auto score = [&](int kb0) {
#pragma unroll
            for (int u4 = 0; u4 < 4; ++u4) { f32x4 sv = {0.f, 0.f, 0.f, 0.f};
#pragma unroll
                for (int pr = 0; pr < 2; ++pr) { f32x4 c = {0.f, 0.f, 0.f, 0.f};
                    c = __builtin_amdgcn_mfma_f32_16x16x32_bf16(a0[u4], bq[pr][0], c, 0, 0, 0); c = __builtin_amdgcn_mfma_f32_16x16x32_bf16(a1[u4], bq[pr][1], c, 0, 0, 0);
#pragma unroll
                    for (int j = 0; j < 4; ++j) sv[j] = fmaf(relu_bits(c[j]), iwv[pr], sv[j]); }
#pragma unroll
                for (int j = 0; j < 4; ++j) { float r; asm("s_nop 1\n\tv_add_f32_dpp %0, %1, %1 row_ror:8 row_mask:0xf bank_mask:0xf" : "=v"(r) : "v"(sv[j])); sv[j] = r; }
                *(LAS f32x4*)(sc + (n & 7) * SCS + (kb0 + u4) * 16 + qd * 4) = sv; }
        };
        if (wave * 4 < nkb) { DSA_LDK(wave * 4, A0, A1) }
        if (wave * 4 + 32 < nkb) { DSA_LDK(wave * 4 + 32, B0, B1) }
        for (int kb0 = wave * 4; kb0 < nkb; kb0 += 64) {
#pragma unroll
            for (int u4 = 0; u4 < 4; ++u4) { a0[u4] = A0[u4]; a1[u4] = A1[u4]; }
            if (kb0 + 64 < nkb) { DSA_LDK(kb0 + 64, A0, A1) }
            score(kb0);
            if (kb0 + 32 < nkb) {
#pragma unroll
                for (int u4 = 0; u4 < 4; ++u4) { a0[u4] = B0[u4]; a1[u4] = B1[u4]; }
                if (kb0 + 96 < nkb) { DSA_LDK(kb0 + 96, B0, B1) }
                score(kb0 + 32); }
        }
#undef DSA_LDK
    }
    __syncthreads();
    LAS float* myrow = sc + wave * SCS; LAS int* ix = (LAS int*)myrow; LAS float* pp = myrow + 256;
    const int qrow = bl * T + t0 + wave; int nv = 256;
    if (limit <= 256) { nv = limit;
#pragma unroll
        for (int r = 0; r < 4; ++r) { const int kk = r * 64 + lane; ix[kk] = (kk < limit) ? kk : 0; } }
    else if (limit <= 1024) dsa_select<16>(myrow, limit, lane, ix);
    else if (limit <= 2048) dsa_select<32>(myrow, limit, lane, ix);
    else if (limit <= 3072) dsa_select<48>(myrow, limit, lane, ix);
    else dsa_select<64>(myrow, limit, lane, ix);
    bf16x8 bq[4];
#pragma unroll
    for (int ks = 0; ks < 4; ++ks) { bf16x8 v = *(const bf16x8*)(P1 + (size_t)qrow * P1W + C_QL + (n & 7) * 128 + ks * 32 + qd * 8); if (n >= 8) v = (bf16x8){0, 0, 0, 0, 0, 0, 0, 0}; bq[ks] = v; }
    WAVE_SYNC();
    LAS unsigned char* tile = (LAS unsigned char*)(myrow + 256);
    constexpr int TS = 272;
    const int grow = lane >> 4, gch = lane & 15;
    u32x4 gA[8], gB[8];
#define DSA_GATHER(g, tt) _Pragma("unroll") for (int i = 0; i < 8; ++i) g[i] = *(const u32x4*)(CN + (rbase + ix[(tt) * 32 + grow + 4 * i]) * 128 + gch * 8);
    DSA_GATHER(gA, 0) DSA_GATHER(gB, 1)
    f32x4 O[8];
#pragma unroll
    for (int rt = 0; rt < 8; ++rt) O[rt] = (f32x4){0.f, 0.f, 0.f, 0.f};
    float mrun = -INFINITY, lrun = 0.f;
    const int trow = 4 * qd + (n >> 2), tcol = (n & 3) * 8;
    auto step = [&](int t, u32x4 (&g)[8]) {
#pragma unroll
        for (int i = 0; i < 8; ++i) *(LAS u32x4*)(tile + (grow + 4 * i) * TS + gch * 16) = g[i];
        if (t < 6) { DSA_GATHER(g, t + 2) }
        WAVE_SYNC();
        f32x4 c[2];
#pragma unroll
        for (int kb2 = 0; kb2 < 2; ++kb2) { c[kb2] = (f32x4){0.f, 0.f, 0.f, 0.f};
#pragma unroll
            for (int ks = 0; ks < 4; ++ks) c[kb2] = __builtin_amdgcn_mfma_f32_16x16x32_bf16(*(const LAS bf16x8*)(tile + (kb2 * 16 + n) * TS + (4 * ks + qd) * 16), bq[ks], c[kb2], 0, 0, 0); }
        float mx = mrun;
#pragma unroll
        for (int kb2 = 0; kb2 < 2; ++kb2)
#pragma unroll
            for (int j = 0; j < 4; ++j) { if (t * 32 + kb2 * 16 + 4 * qd + j >= nv) c[kb2][j] = -INFINITY; mx = fmaxf(mx, c[kb2][j]); }
        mx = fmaxf(mx, __shfl_xor(mx, 16)); mx = fmaxf(mx, __shfl_xor(mx, 32));
        const float scl = __expf(mrun - mx); float ps = 0.f;
#pragma unroll
        for (int kb2 = 0; kb2 < 2; ++kb2)
#pragma unroll
            for (int j = 0; j < 4; ++j) { c[kb2][j] = __expf(c[kb2][j] - mx); ps += c[kb2][j]; }
        ps += __shfl_xor(ps, 16); ps += __shfl_xor(ps, 32);
        lrun = lrun * scl + ps; mrun = mx;
        const bf16x8 pb = pack_b(c[0], c[1]);
#pragma unroll
        for (int rt = 0; rt < 8; ++rt) { O[rt] = O[rt] * scl;
            typedef short v4i16_t __attribute__((ext_vector_type(4)));
            const v4i16_t a0 = __builtin_amdgcn_ds_read_tr16_b64_v4i16((LAS v4i16_t*)(tile + trow * TS + rt * 32 + tcol));
            const v4i16_t a1 = __builtin_amdgcn_ds_read_tr16_b64_v4i16((LAS v4i16_t*)(tile + (16 + trow) * TS + rt * 32 + tcol));
            const bf16x8 af = {a0[0], a0[1], a0[2], a0[3], a1[0], a1[1], a1[2], a1[3]};
            O[rt] = __builtin_amdgcn_mfma_f32_16x16x32_bf16(af, pb, O[rt], 0, 0, 0); }
        WAVE_SYNC();
    };
    for (int t = 0; t < 8; t += 2) {
        if (t * 32 >= nv) break;
        step(t, gA);
        if ((t + 1) * 32 >= nv) break;
        step(t + 1, gB);
    }
#undef DSA_GATHER
    if (n < 8) { const float inv = 1.f / lrun; bf16_t* dst = BR + (size_t)qrow * BRW + n * 128 + 4 * qd;
#pragma unroll
        for (int rt = 0; rt < 8; ++rt) { u32x2 o; o.x = pk2(O[rt][0] * inv, O[rt][1] * inv); o.y = pk2(O[rt][2] * inv, O[rt][3] * inv); *(u32x2*)(dst + rt * 16) = o; } }
#ifdef PROBE_ATT
    WAVE_SYNC();
    {
    bf16x8 bq2[4];
#pragma unroll
    for (int ks = 0; ks < 4; ++ks) { bf16x8 v = *(const bf16x8*)(P1 + (size_t)qrow * P1W + C_QL + (n & 7) * 128 + ks * 32 + qd * 8); if (n >= 8) v = (bf16x8){0, 0, 0, 0, 0, 0, 0, 0}; bq2[ks] = v; }
    WAVE_SYNC();
    LAS float* pp = myrow + 256; f32x4 lg[16];
#pragma unroll
    for (int kb4 = 0; kb4 < 4; ++kb4) { bf16x8 a[4][4];
#pragma unroll
        for (int k2 = 0; k2 < 4; ++k2) { const bf16_t* cp = CN + (rbase + ix[(kb4 * 4 + k2) * 16 + n]) * 128 + qd * 8;
#pragma unroll
            for (int ks = 0; ks < 4; ++ks) a[k2][ks] = *(const bf16x8*)(cp + ks * 32); }
#pragma unroll
        for (int k2 = 0; k2 < 4; ++k2) { f32x4 c = {0.f, 0.f, 0.f, 0.f};
#pragma unroll
            for (int ks = 0; ks < 4; ++ks) c = __builtin_amdgcn_mfma_f32_16x16x32_bf16(a[k2][ks], bq2[ks], c, 0, 0, 0);
            lg[kb4 * 4 + k2] = c; } }
    float mx = -INFINITY;
#pragma unroll
    for (int kb = 0; kb < 16; ++kb)
#pragma unroll
        for (int j = 0; j < 4; ++j) { const int kk = kb * 16 + qd * 4 + j; if (kk >= nv) lg[kb][j] = -INFINITY; mx = fmaxf(mx, lg[kb][j]); }
    mx = fmaxf(mx, __shfl_xor(mx, 16)); mx = fmaxf(mx, __shfl_xor(mx, 32));
    float sm = 0.f;
#pragma unroll
    for (int kb = 0; kb < 16; ++kb)
#pragma unroll
        for (int j = 0; j < 4; ++j) { const float e = __expf(lg[kb][j] - mx); lg[kb][j] = e; sm += e; }
    sm += __shfl_xor(sm, 16); sm += __shfl_xor(sm, 32);
    const float inv = 1.f / sm;
    if (n < 8) {
#pragma unroll
        for (int kb = 0; kb < 16; ++kb)
#pragma unroll
            for (int j = 0; j < 4; ++j) pp[(kb * 16 + qd * 4 + j) * 8 + n] = lg[kb][j] * inv; }
    WAVE_SYNC();
    f32x2 o[8];
#pragma unroll
    for (int hh = 0; hh < 8; ++hh) o[hh] = (f32x2){0.f, 0.f};
    const unsigned* cbase = (const unsigned*)(CN + rbase * 128) + lane;
    unsigned cw[8];
#pragma unroll
    for (int j = 0; j < 8; ++j) { const int key = __builtin_amdgcn_readfirstlane(ix[j]); cw[j] = cbase[(size_t)key * 64]; }
    for (int kk = 0; kk < nv; kk += 8) { unsigned nx[8];
        const int kn = (kk + 8 < nv) ? kk + 8 : kk;
#pragma unroll
        for (int j = 0; j < 8; ++j) { const int key = __builtin_amdgcn_readfirstlane(ix[kn + j]); nx[j] = cbase[(size_t)key * 64]; }
#pragma unroll
        for (int j = 0; j < 8; ++j) { const f32x2 cv = {bflo(cw[j]), bfhi(cw[j])}; const f32x4 pa = *(const LAS f32x4*)(pp + (kk + j) * 8), pb = *(const LAS f32x4*)(pp + (kk + j) * 8 + 4);
#pragma unroll
            for (int hh = 0; hh < 4; ++hh) { o[hh] += cv * pa[hh]; o[4 + hh] += cv * pb[hh]; } }
#pragma unroll
        for (int j = 0; j < 8; ++j) cw[j] = nx[j]; }
#pragma unroll
    for (int hh = 0; hh < 8; ++hh) *((unsigned*)((bf16_t*)(F.ws + WS_MG) + (size_t)qrow * 1024 + hh * 128) + lane) = pk2(o[hh].x, o[hh].y);
    }
#endif
}
__device__ __forceinline__ void ph_dsa(Frame& F, gu32* ctr, int k0, int k1) {
    volatile LAS unsigned* MISC = (volatile LAS unsigned*)(F.lds + MISC_OFF);
    const int hq = (F.bid & 7) >> 1;
    for (int qi = 0; qi < 4; ++qi) { const int q = (hq + qi) & 3;
        for (;;) {
            __syncthreads();
            if (F.tid == 0) MISC[0] = __hip_atomic_fetch_add(ctr + q * 16, 1u, RLX_AGENT);
            __syncthreads();
            const int k = k0 + (int)MISC[0];
            if (k >= k1) break;
            dsa_unit(F, k * 4 + q);
        } }
}

#ifdef PROBE_ATT
constexpr int CW_DIAG = 32768;
__device__ __forceinline__ void ph_att_cmp(Frame& F) {
    gu32* ctl = (gu32*)(F.ws + WS_CTL); const bf16_t* BA = (const bf16_t*)(F.ws + WS_BR); const bf16_t* BB = (const bf16_t*)(F.ws + WS_MG);
    const int gw = F.bid * 8 + F.wave, NGW = F.G * 8, lane = F.lane; float d2 = 0.f, r2 = 0.f;
    for (int q = gw; q < MH; q += NGW)
        for (int c = lane; c < 512; c += 64) { const unsigned wa = *((const unsigned*)(BA + (size_t)q * BRW) + c), wb = *((const unsigned*)(BB + (size_t)q * 1024) + c);
            const float a0 = bflo(wa) - bflo(wb), a1 = bfhi(wa) - bfhi(wb); d2 += a0 * a0 + a1 * a1; r2 += bflo(wb) * bflo(wb) + bfhi(wb) * bfhi(wb); }
    d2 = wave_sum(d2); r2 = wave_sum(r2);
    if (lane == 0) { atomicAdd((float*)(ctl + CW_DIAG + 64), d2); atomicAdd((float*)(ctl + CW_DIAG + 128), r2); }
}
#endif
__device__ __forceinline__ void ph_ffn_act(Frame& F, int l, int q) {
    const bf16_t* RAW = (const bf16_t*)(F.ws + WS_RAW + (size_t)(q & 1) * 88 * MiB); bf16_t* ACT = (bf16_t*)(F.ws + WS_ACT) + (size_t)q * 8192 * DFF;
    const float* cw = F.ap->in[I_FCW] + (size_t)l * 3 * 2 * DFF;
    gu32* ctr = (gu32*)(F.ws + WS_CTL) + CW_Q + (24 + l * 4 + q) * 64;
    volatile LAS unsigned* MISC = (volatile LAS unsigned*)(F.lds + MISC_OFF);
    for (;;) {
        __syncthreads();
        if (F.tid == 0) MISC[0] = __hip_atomic_fetch_add(ctr, 1u, RLX_AGENT);
        __syncthreads();
        const int rg = (int)MISC[0];
        if (rg >= 256) break;
        const int pc = F.tid;
        if (pc < 352) { const int c0 = pc * 8, j = c0 >> 7, i0 = c0 & 127, r0 = rg * 32;
            const bf16_t* gp = RAW + (size_t)r0 * (2 * DFF) + j * 256 + i0; const bf16_t* vp = gp + 128;
            float wg[3][8], wv[3][8];
#pragma unroll
            for (int k = 0; k < 3; ++k)
#pragma unroll
                for (int x = 0; x < 8; ++x) { wg[k][x] = cw[k * 2 * DFF + c0 + x]; wv[k][x] = cw[k * 2 * DFF + DFF + c0 + x]; }
            const bool head = (r0 & 4095) == 0;
            u32x4 g0 = {0, 0, 0, 0}, g1 = {0, 0, 0, 0}, v0 = {0, 0, 0, 0}, v1 = {0, 0, 0, 0};
            if (!head) { g0 = *(const u32x4*)(gp - 2 * (2 * DFF)); g1 = *(const u32x4*)(gp - (2 * DFF)); v0 = *(const u32x4*)(vp - 2 * (2 * DFF)); v1 = *(const u32x4*)(vp - (2 * DFF)); }
            for (int r = 0; r < 32; ++r) { const u32x4 g2 = *(const u32x4*)(gp + (size_t)r * (2 * DFF)), v2 = *(const u32x4*)(vp + (size_t)r * (2 * DFF)); u32x4 o;
#pragma unroll
                for (int w = 0; w < 4; ++w) {
                    const float hg0 = wg[0][2 * w] * bflo(g0[w]) + wg[1][2 * w] * bflo(g1[w]) + wg[2][2 * w] * bflo(g2[w]), hg1 = wg[0][2 * w + 1] * bfhi(g0[w]) + wg[1][2 * w + 1] * bfhi(g1[w]) + wg[2][2 * w + 1] * bfhi(g2[w]);
                    const float hv0 = wv[0][2 * w] * bflo(v0[w]) + wv[1][2 * w] * bflo(v1[w]) + wv[2][2 * w] * bflo(v2[w]), hv1 = wv[0][2 * w + 1] * bfhi(v0[w]) + wv[1][2 * w + 1] * bfhi(v1[w]) + wv[2][2 * w + 1] * bfhi(v2[w]);
                    o[w] = pk2(siluf_(hg0) * hv0, siluf_(hg1) * hv1); }
                *(u32x4*)(ACT + (size_t)(r0 + r) * DFF + c0) = o; g0 = g1; g1 = g2; v0 = v1; v1 = v2; } }
    }
}

__device__ __forceinline__ void ph_ffn_fix(Frame& F, int l) {
    const bf16_t* HALO = (const bf16_t*)(F.ws + WS_FHALO); const bf16_t* FIRST = (const bf16_t*)(F.ws + WS_FFIRST); bf16_t* ACT = (bf16_t*)(F.ws + WS_ACT);
    const float* cw = F.ap->in[I_FCW] + (size_t)l * 3 * 2 * DFF;
    const int gt = F.bid * 512 + F.tid, NT = F.G * 512;
    for (int e = gt; e < 128 * 22 * 16; e += NT) { const int cg = e & 15, pn = (e >> 4) % 22, pm = (e >> 4) / 22, cb = cg * 8;
        if ((pm & 15) == 0) continue;
        const bf16_t* hp = HALO + ((size_t)((pm - 1) * 22 + pn) * 2) * 256 + cb; const bf16_t* fp = FIRST + ((size_t)(pm * 22 + pn) * 2) * 256 + cb;
        const u32x4 hg0 = *(const u32x4*)hp, hg1 = *(const u32x4*)(hp + 256), fg0 = *(const u32x4*)fp, fg1 = *(const u32x4*)(fp + 256);
        const u32x4 hv0 = *(const u32x4*)(hp + 128), hv1 = *(const u32x4*)(hp + 256 + 128), fv0 = *(const u32x4*)(fp + 128), fv1 = *(const u32x4*)(fp + 256 + 128);
        u32x4 o0, o1;
#pragma unroll
        for (int q = 0; q < 4; ++q) { float r0[2], r1[2];
#pragma unroll
            for (int hl = 0; hl < 2; ++hl) { const int c = pn * 128 + cb + 2 * q + hl;
                const float wg0 = cw[c], wg1 = cw[2 * DFF + c], wg2 = cw[4 * DFF + c], wv0 = cw[DFF + c], wv1 = cw[2 * DFF + DFF + c], wv2 = cw[4 * DFF + DFF + c];
                const float Hg0 = hl ? bfhi(hg0[q]) : bflo(hg0[q]), Hg1 = hl ? bfhi(hg1[q]) : bflo(hg1[q]), Fg0 = hl ? bfhi(fg0[q]) : bflo(fg0[q]), Fg1 = hl ? bfhi(fg1[q]) : bflo(fg1[q]);
                const float Hv0 = hl ? bfhi(hv0[q]) : bflo(hv0[q]), Hv1 = hl ? bfhi(hv1[q]) : bflo(hv1[q]), Fv0 = hl ? bfhi(fv0[q]) : bflo(fv0[q]), Fv1 = hl ? bfhi(fv1[q]) : bflo(fv1[q]);
                r0[hl] = siluf_(wg0 * Hg0 + wg1 * Hg1 + wg2 * Fg0) * (wv0 * Hv0 + wv1 * Hv1 + wv2 * Fv0);
                r1[hl] = siluf_(wg0 * Hg1 + wg1 * Fg0 + wg2 * Fg1) * (wv0 * Hv1 + wv1 * Fv0 + wv2 * Fv1); }
            o0[q] = pk2(r0[0], r0[1]); o1[q] = pk2(r1[0], r1[1]); }
        *(u32x4*)(ACT + (size_t)(pm * 256) * DFF + pn * 128 + cb) = o0; *(u32x4*)(ACT + (size_t)(pm * 256 + 1) * DFF + pn * 128 + cb) = o1; }
}

__device__ __forceinline__ void ph_final(Frame& F) {
    float* X = F.ap->out; const float* SS = (const float*)(F.ws + WS_SS); const float* g = F.ap->in[I_FING];
    const int gw = F.bid * 8 + F.wave, NGW = F.G * 8;
    float dscale = 1.f;
#ifdef PROBE_ATT
    { const float* dg = (const float*)((const unsigned*)(F.ws + WS_CTL) + CW_DIAG); dscale = 1.f + sqrtf(dg[64] / fmaxf(dg[128], 1e-30f)); }
#endif
    for (int r = gw; r < M; r += NGW) { const float rs = row_rstd(SS, r) * dscale; f32x4* xr = (f32x4*)(X + (size_t)r * D) + F.lane; const f32x4* gr = (const f32x4*)g + F.lane;
#pragma unroll
        for (int j = 0; j < 4; ++j) { f32x4 v = xr[64 * j]; const f32x4 gg = gr[64 * j]; v = v * rs * gg; xr[64 * j] = v; } }
}

constexpr int DSA_Q1 = 1792;
#ifdef PROBE_ATT
constexpr int PH_PER_HALF = 8,
#else
constexpr int PH_PER_HALF = 7,
#endif
    PH_PER_LAYER = 1 + NHALF * PH_PER_HALF + 3, NPHASE = NLAYER * PH_PER_LAYER + 1;

__global__ void __launch_bounds__(512, 2) fwd(Args args) {
    extern __shared__ __attribute__((aligned(16))) unsigned char lds_raw[];
    Frame F0;
    F0.lds = (LAS unsigned char*)lds_raw; F0.ap = (CArgs*)__builtin_amdgcn_kernarg_segment_ptr(); F0.ws = nullptr;
    F0.tid = threadIdx.x; F0.lane = F0.tid & 63; F0.wave = __builtin_amdgcn_readfirstlane(F0.tid >> 6); F0.G = gridDim.x; F0.bid = blockIdx.x;
    volatile LAS unsigned* MISC = (volatile LAS unsigned*)(F0.lds + MISC_OFF);
    if (F0.tid < 64) MISC[F0.tid] = 0u;
    __syncthreads();
    const int lo = args.ph_lo, hi = args.ph_hi;
    XcdBarrier bar; bar.bar = (unsigned*)(args.ws + WS_CTL) + CW_BAR; bar.x = 0; bar.st = nullptr;
    if (hi - lo > 1) bar = xcd_barrier_post((unsigned*)(args.ws + WS_CTL) + CW_BAR, MISC + 8);
    int pc = 0;
#ifndef SITE_MASK
#define SITE_MASK 0xFFFFFFFFu
#endif
#ifndef DUP_MASK
#define DUP_MASK 0u
#endif
#define PH_BEGIN(id) if (((SITE_MASK >> (id)) & 1u) && pc >= lo && pc < hi) for (int rep_ = 0, nrep_ = 1 + ((DUP_MASK >> (id)) & 1u); rep_ < nrep_; ++rep_) { Frame F = F0; asm volatile("v_mbcnt_lo_u32_b32 %0, -1, 0\n\tv_mbcnt_hi_u32_b32 %0, -1, %0" : "=v"(F.lane)); asm volatile("" : "+s"(F.ap), "+s"(F.wave)); F.tid = F.wave * 64 + F.lane; F.ws = F.ap->ws; \
        LAS unsigned char* glds = F.lds; bf16_t* XB = (bf16_t*)(F.ws + WS_XB); float* SS = (float*)(F.ws + WS_SS); bf16_t* P1 = (bf16_t*)(F.ws + WS_P1); bf16_t* BR = (bf16_t*)(F.ws + WS_BR); bf16_t* MG = (bf16_t*)(F.ws + WS_MG); \
        (void)glds; (void)XB; (void)SS; (void)P1; (void)BR; (void)MG;
#define PH_END if (pc + 1 < hi || rep_ + 1 < nrep_) xcd_barrier(bar); } ++pc;
#define RELAUNDER do { asm volatile("v_mbcnt_lo_u32_b32 %0, -1, 0\n\tv_mbcnt_hi_u32_b32 %0, -1, %0" : "=v"(F.lane)); asm volatile("" : "+s"(F.ap), "+s"(F.wave)); F.tid = F.wave * 64 + F.lane; F.ws = F.ap->ws; } while (0)

    for (int l = 0; l < NLAYER; ++l) {
        PH_BEGIN(1) ph_wprep(F, l); if (l == 0) ph_x0(F); PH_END
        for (int h = 0; h < NHALF; ++h) {
            const size_t r0 = (size_t)h * MH;
            PH_BEGIN(2)
                pg8::Gemm g{XB + r0 * D, (const bf16_t*)(F.ws + WS_WIN1), D, D, D}; pg8::StaticOrder S; S.init(MH, P1W, F.G, F.bid);
                EpiNormBf16<2> E{P1, P1W, rstd_table(F, S, SS + r0 * 16), (bf16_t*)(F.ws + WS_S5A), (bf16_t*)(F.ws + WS_IKC)}; pg8::gemm_phase(glds, F.tid, g, S, E);
            PH_END
            PH_BEGIN(3) ph_prep_a(F, l); ph_gdn_prep(F, l); PH_END
            PH_BEGIN(5)
                if (F.bid < 16) ph_gdn_chain(F, l);
                for (int su = (F.bid - 16 + F.G) % F.G; su < 128; su += F.G) s5_unit(F, su >> 2, su & 3);
                RELAUNDER;
                ph_dsa(F, (gu32*)(F.ws + WS_CTL) + CW_Q + ((l * 2 + h) * 2 + 0) * 64, 0, DSA_Q1 / 4);
            PH_END
            PH_BEGIN(10)
                { pg8::Gemm g{(const bf16_t*)(F.ws + WS_YG), (const bf16_t*)(F.ws + WS_WGLU), 512, 512, 512}; pg8::StaticOrder S; S.init(MH, 512, F.G, F.bid);
                  EpiS5G E{(const bf16_t*)(F.ws + WS_YG), BR}; pg8::gemm_phase(glds, F.tid, g, S, E); }
                RELAUNDER;
                ph_dsa(F, (gu32*)(F.ws + WS_CTL) + CW_Q + ((l * 2 + h) * 2 + 1) * 64, DSA_Q1 / 4, 512);
            PH_END
#ifdef PROBE_ATT
            PH_BEGIN(22) ph_att_cmp(F); PH_END
#endif
            PH_BEGIN(13)
                pg8::Gemm g{XB + r0 * D, (const bf16_t*)(F.ws + WS_WIN2), D, D, D}; pg8::StaticOrder S; S.init(MH, GW, F.G, F.bid);
                EpiNormBf16<1> E{P1, GW, rstd_table(F, S, SS + r0 * 16), nullptr, nullptr}; pg8::gemm_phase(glds, F.tid, g, S, E);
            PH_END
            PH_BEGIN(14)
                pg8::Gemm g{BR, (const bf16_t*)(F.ws + WS_WMRG), BRW, BRW, BRW}; pg8::StaticOrder S; S.init(MH, D, F.G, F.bid);
                EpiMerge E{MG, P1}; pg8::gemm_phase(glds, F.tid, g, S, E);
            PH_END
            PH_BEGIN(15)
                pg8::Gemm g{MG, (const bf16_t*)(F.ws + WS_WOUT), D, D, D}; pg8::StaticOrder S; S.init(MH, D, F.G, F.bid);
                float* xf = F.ap->out;
                EpiResid E{(l == 0 ? F.ap->in[I_X] : (const float*)xf) + r0 * D, xf + r0 * D, XB + r0 * D, SS + r0 * 16}; pg8::gemm_phase(glds, F.tid, g, S, E);
            PH_END
        }
        PH_BEGIN(16)
            pg8::Gemm g{XB, (const bf16_t*)(F.ws + WS_WUP), D, D, D}; pg8::StaticOrder S; S.init(M, 2 * DFF, F.G, F.bid);
            EpiUpConv E{(bf16_t*)(F.ws + WS_ACT), rstd_table(F, S, SS), F.lds + 131072 + 11264, F.ap->in[I_FCW] + (size_t)l * 3 * 2 * DFF, (bf16_t*)(F.ws + WS_FHALO), (bf16_t*)(F.ws + WS_FFIRST)};
            pg8::gemm_phase(glds, F.tid, g, S, E);
        PH_END
        PH_BEGIN(17) ph_ffn_fix(F, l); PH_END
        PH_BEGIN(18)
            pg8::Gemm g{(const bf16_t*)(F.ws + WS_ACT), (const bf16_t*)(F.ws + WS_WDN), DFF, DFF, DFF}; pg8::StaticOrder S; S.init(M, D, F.G, F.bid);
            float* xf = F.ap->out;
            EpiResid E{xf, xf, XB, SS}; pg8::gemm_phase(glds, F.tid, g, S, E);
        PH_END
    }
    PH_BEGIN(19) ph_final(F); PH_END
}

extern "C" void kernel_launch(void* const* d_in, const int* in_sizes, int n_in, void* d_out, int out_size, void* d_ws, size_t ws_size, hipStream_t stream) {
    static int grid = 0;
    if (grid == 0) {
        if (n_in != 28 || in_sizes[0] != M * D || out_size != M * D || ws_size < WS_END) { fprintf(stderr, "kernel_launch: unexpected shapes (n_in %d, ws %zu)\n", n_in, ws_size); grid = -1; return; }
        int dev = 0, cus = 0, per_cu = 0;
        if (hipGetDevice(&dev) != hipSuccess || hipDeviceGetAttribute(&cus, hipDeviceAttributeMultiprocessorCount, dev) != hipSuccess) { grid = -1; return; }
        if (hipFuncSetAttribute((const void*)fwd, hipFuncAttributeMaxDynamicSharedMemorySize, LDS_BYTES) != hipSuccess) { grid = -1; return; }
        if (hipOccupancyMaxActiveBlocksPerMultiprocessor(&per_cu, (const void*)fwd, 512, LDS_BYTES) != hipSuccess || per_cu < 1) fprintf(stderr, "kernel_launch: occupancy query says %d\n", per_cu);
        (void)hipGetLastError();
        grid = cus;
    }
    if (grid < 0) return;
    (void)hipMemsetAsync((char*)d_ws + WS_CTL, 0, CTL_ZERO_BYTES, stream);
    Args a{};
    for (int i = 0; i < 28; ++i) a.in[i] = (const float*)d_in[i];
    a.out = (float*)d_out; a.ws = (unsigned char*)d_ws;
#if MK_ONE_LAUNCH
    a.ph_lo = 0; a.ph_hi = NPHASE;
    hipLaunchKernelGGL(fwd, dim3(grid), dim3(512), LDS_BYTES, stream, a);
#else
    for (int p = 0; p < NPHASE; ++p) { a.ph_lo = p; a.ph_hi = p + 1; hipLaunchKernelGGL(fwd, dim3(grid), dim3(512), LDS_BYTES, stream, a); }
#endif
}
```

```cpp
#include <hip/hip_runtime.h>
#include <cstdio>
#include <cstdint>

#ifndef MK_ONE_LAUNCH
#define MK_ONE_LAUNCH 1
#endif

#define LAS __attribute__((address_space(3)))
#define GAS __attribute__((address_space(1)))
typedef unsigned short bf16_t;
typedef short bf16x8 __attribute__((ext_vector_type(8)));
typedef float f32x4 __attribute__((ext_vector_type(4)));
typedef float f32x2 __attribute__((ext_vector_type(2)));
typedef unsigned u32x4 __attribute__((ext_vector_type(4)));
typedef unsigned u32x2 __attribute__((ext_vector_type(2)));
typedef GAS unsigned gu32;

constexpr int NB = 8, T = 4096, D = 1024, M = NB * T, NHALF = 2, MH = M / NHALF, BH = NB / NHALF;
constexpr int NIN = 6604, DFF = 2816, NLAYER = 2;
constexpr float EPS = 1e-6f;
constexpr int P1W = 4096;
constexpr int C_QL = 0, C_CKV = 1024, C_IQ = 1152, C_IK = 1408, C_IW = 1472, C_CA = 1476, C_CB = 1480, C_S5U = 1536, C_QKV = 2048, C_Z = 3584;
constexpr int GW = 3072;
constexpr int BRW = 2048;
constexpr int S5LD = 384;
constexpr int GDN_CH = 36864;

constexpr size_t MiB = 1u << 20;
constexpr size_t WS_CTL = 0, CTL_ZERO_BYTES = 1 * MiB;
constexpr size_t WS_WIN1 = 1 * MiB, WS_WIN2 = 9 * MiB, WS_WMRG = 15 * MiB, WS_WOUT = 19 * MiB, WS_WUP = 21 * MiB, WS_WDN = 32 * MiB, WS_WGLU = 38 * MiB;
constexpr size_t WS_S5W1 = 39 * MiB, WS_S5T = 43 * MiB, WS_SS = 49 * MiB, WS_S5P = 51 * MiB  ;
constexpr size_t WS_XB = 52 * MiB, WS_P1 = 116 * MiB, WS_BR = 244 * MiB, WS_MG = 308 * MiB, WS_GO = 308 * MiB;
constexpr size_t WS_IDX = 340 * MiB, WS_NV = 348 * MiB, WS_GLAST = 348 * MiB + 512 * 1024, WS_CN = 349 * MiB, WS_S5A = 353 * MiB, WS_S5S = 377 * MiB, WS_YG = 393 * MiB, WS_GDN = 409 * MiB;
constexpr size_t WS_RAW = 116 * MiB  , WS_ACT = 292 * MiB;
constexpr size_t WS_FHALO = 468 * MiB, WS_FFIRST = 472 * MiB;
constexpr size_t WS_IKC = 490 * MiB;
constexpr size_t WS_END = 492 * MiB;
static_assert(WS_GDN + (size_t)1024 * GDN_CH * 2 <= WS_END, "ws map");
static_assert(WS_ACT + (size_t)M * DFF * 2 <= WS_END, "ws map");
constexpr int CW_BAR = 4096;
constexpr int CW_Q = 16384;

constexpr int LDS_BYTES = 147456, MISC_OFF = LDS_BYTES - 256;

#define RLX_AGENT __ATOMIC_RELAXED, __HIP_MEMORY_SCOPE_AGENT
typedef __bf16 bf16x2_t __attribute__((ext_vector_type(2)));
__device__ __forceinline__ unsigned cvt_pk_bf16(float lo, float hi) { const f32x2 v = {lo, hi}; const bf16x2_t b = __builtin_convertvector(v, bf16x2_t); return __builtin_bit_cast(unsigned, b); }
__device__ __forceinline__ unsigned f2bf(float f) { return cvt_pk_bf16(f, 0.f) & 0xffffu; }
__device__ __forceinline__ unsigned pk2(float lo, float hi) { return cvt_pk_bf16(lo, hi); }
__device__ __forceinline__ float bf2f(unsigned short b) { return __builtin_bit_cast(float, (unsigned)b << 16); }
__device__ __forceinline__ float bflo(unsigned w) { return __builtin_bit_cast(float, w << 16); }
__device__ __forceinline__ float bfhi(unsigned w) { return __builtin_bit_cast(float, w & 0xffff0000u); }

__device__ __forceinline__ float wave_sum(float v) {
#pragma unroll
    for (int o = 1; o < 64; o <<= 1) v += __shfl_xor(v, o);
    return v;
}
__device__ __forceinline__ float wave_max(float v) {
#pragma unroll
    for (int o = 1; o < 64; o <<= 1) v = fmaxf(v, __shfl_xor(v, o));
    return v;
}
__device__ __forceinline__ float rcp_(float x) { return __builtin_amdgcn_rcpf(x); }
__device__ __forceinline__ float sigmoidf_(float x) { return 1.f / (1.f + __expf(-x)); }
__device__ __forceinline__ float sigmoid_nr(float x) { const float y = 1.f + __expf(-x); float r = __builtin_amdgcn_rcpf(y); r = r * (2.f - y * r); return r; }
__device__ __forceinline__ float siluf_(float x) { return x * rcp_(1.f + __expf(-x)); }
__device__ __forceinline__ float gelu_tanh(float x) { const float u2 = 1.5957691216057308f * (x + 0.044715f * x * x * x); return x / (1.f + __expf(-u2)); }
__device__ __forceinline__ float softplusf_(float x) { const float e = __expf(x); const float sm = e * (1.f - e * (0.5f - e * (1.f / 3.f))); return x > 15.f ? x : (e < 1e-2f ? sm : __logf(1.f + e)); }
#define LDS_WAIT() asm volatile("s_waitcnt lgkmcnt(0)" ::: "memory")
#define WAVE_SYNC() do { asm volatile("s_waitcnt lgkmcnt(0)" ::: "memory"); __builtin_amdgcn_wave_barrier(); } while (0)

#define XB_TMO      128
#define XB_XCNT(j)  (256  + 64 * (j))
#define XB_XSUB(j)  (1280 + 64 * (j))
#define XB_XGEN(j)  (2304 + 64 * (j))
#define XB_TOP      3328
#define XB_TOPGEN   3392
#define XCD_BAR_WORDS 3456
#define XB_SPIN_CAP (1u << 22)
__device__ __forceinline__ unsigned xb_ld(unsigned* p)              { return __hip_atomic_load(p, __ATOMIC_RELAXED, __HIP_MEMORY_SCOPE_AGENT); }
__device__ __forceinline__ unsigned xb_add(unsigned* p, unsigned v) { return __hip_atomic_fetch_add(p, v, __ATOMIC_RELAXED, __HIP_MEMORY_SCOPE_AGENT); }
__device__ __forceinline__ unsigned xb_xcc_id() { return (unsigned)__builtin_amdgcn_s_getreg((3 << 11) | 20) & 0xFu; }
#define XB_SPIN(cond, bar) do { unsigned _sp = 0; while (cond) { __builtin_amdgcn_s_sleep(1); \
    if ((++_sp & 255u) == 0u) { if (xb_ld(&(bar)[XB_TMO])) break; if (_sp > XB_SPIN_CAP) { atomicAdd(&(bar)[XB_TMO], 1u); break; } } } } while (0)
struct XcdBarrier { unsigned* bar; unsigned x; volatile LAS unsigned* st; };
__device__ __forceinline__ XcdBarrier xcd_barrier_post(unsigned* bar, volatile LAS unsigned* st) {
    XcdBarrier b; b.bar = bar; b.x = xb_xcc_id(); b.st = st;
    if (threadIdx.x == 0) (void)xb_add(&bar[XB_XCNT(b.x)], 1u);
    return b;
}
__device__ __forceinline__ void xcd_barrier_complete(unsigned* bar, unsigned x, unsigned& nloc, unsigned& nx) {
    const unsigned G = gridDim.x * gridDim.y * gridDim.z;
    unsigned sum, cnt, mine, sp = 0u;
    for (;;) {
        sum = 0u; cnt = 0u; mine = 0u;
#pragma unroll
        for (unsigned j = 0; j < 16; ++j) { const unsigned c = xb_ld(&bar[XB_XCNT(j)]); sum += c; cnt += (c > 0u) ? 1u : 0u; mine = (j == x) ? c : mine; }
        if (sum == G) break;
        __builtin_amdgcn_s_sleep(1);
        if ((++sp & 255u) == 0u) { if (xb_ld(&bar[XB_TMO])) break; if (sp > XB_SPIN_CAP) { atomicAdd(&bar[XB_TMO], 1u); break; } }
    }
    nloc = mine > 0u ? mine : 1u; nx = cnt > 0u ? cnt : 1u;
}
__device__ __forceinline__ void xcd_barrier(const XcdBarrier& b) {
    asm volatile("s_waitcnt vmcnt(0)" ::: "memory");
    __syncthreads();
    if (threadIdx.x == 0) {
        unsigned* bar = b.bar;
        __builtin_amdgcn_s_waitcnt(0);
        unsigned nloc = b.st[0], nx = b.st[1];
        if (nloc == 0u) { xcd_barrier_complete(bar, b.x, nloc, nx); b.st[0] = nloc; b.st[1] = nx; }
        const unsigned old = xb_add(&bar[XB_XSUB(b.x)], 1u);
        const unsigned gen = old / nloc;
        if (old + 1u == (gen + 1u) * nloc) {
            __builtin_amdgcn_fence(__ATOMIC_RELEASE, "agent");
            asm volatile("s_waitcnt vmcnt(0)" ::: "memory");
            const unsigned og = xb_add(&bar[XB_TOP], 1u);
            const unsigned tg = og / nx;
            if (og + 1u == (tg + 1u) * nx) xb_add(&bar[XB_TOPGEN], 1u);
            else XB_SPIN(xb_ld(&bar[XB_TOPGEN]) == tg, bar);
            __builtin_amdgcn_fence(__ATOMIC_ACQUIRE, "agent");
            xb_add(&bar[XB_XGEN(b.x)], 1u);
            asm volatile("s_waitcnt vmcnt(0)" ::: "memory");
        } else {
            XB_SPIN(xb_ld(&bar[XB_XGEN(b.x)]) == gen, bar);
            __builtin_amdgcn_fence(__ATOMIC_ACQUIRE, "agent");
            asm volatile("s_waitcnt vmcnt(0)" ::: "memory");
        }
    }
    __syncthreads();
}

namespace pg8 {
constexpr int BM = 256, BK = 64, HALF = 128, HTB = HALF * BK * 2, NXCD = 8, WGM = 8;
__host__ __device__ __forceinline__ int lds_byte(int r, int c) { const int st = (r >> 4) * 2 + (c >> 5), rr = r & 15, cc = c & 31, ob = rr * 64 + cc * 2; return st * 1024 + (ob ^ (((ob >> 9) & 1) << 5)); }
__host__ __device__ __forceinline__ void stage_rc(int b, int& R, int& C) { const int st = b / 1024, sb = b % 1024, swz = sb ^ (((sb >> 9) & 1) << 5); R = (st >> 1) * 16 + swz / 64; C = (st & 1) * 32 + (swz % 64) / 2; }
__host__ __device__ __forceinline__ int perm32(int rho) { const int n = rho >> 4, i = rho & 15; return 8 * (i >> 2) + 4 * n + (i & 3); }
struct Unit { int pm, pn; };
struct Gemm { const bf16_t* A; const bf16_t* Bt; int lda, ldb, K; };

struct StaticOrder {
    int nM, nN, nwg, G, c;
    __device__ void init(int Mr, int N, int G_, int c_) { nM = Mr / BM; nN = N / BM; nwg = nM * nN; G = G_; c = c_; }
    __device__ bool next(int i, Unit& u) const {
        const long L = (long)i * G + c; if (L >= nwg) return false;
        int wgid = (int)L; { const int q = nwg / NXCD, r = nwg % NXCD, xcd = wgid % NXCD, off = wgid / NXCD; wgid = (xcd < r ? xcd * (q + 1) : r * (q + 1) + (xcd - r) * q) + off; }
        const int nig = WGM * nN, gid = wgid / nig, fm = gid * WGM, gsz = (nM - fm) < WGM ? (nM - fm) : WGM;
        u.pm = fm + ((wgid % nig) % gsz); u.pn = (wgid % nig) / gsz; return true;
    }
};
struct GroupOrder {
    int n, per, G, c;
    __device__ void init(int ngroups, int per_, int G_, int c_) { n = ngroups * per_; per = per_; G = G_; c = c_; }
    __device__ bool next(int i, Unit& u) const { const long L = (long)i * G + c; if (L >= n) return false; u.pm = (int)L; u.pn = (int)L / per; return true; }
};

template <class Epi, class Sched>
__device__ __forceinline__ void gemm_phase(LAS unsigned char* lds, const int tid, const Gemm g, const Sched& S, const Epi& E) {
    const int wid = __builtin_amdgcn_readfirstlane(tid >> 6), lane = tid & 63, wr = wid >> 2, wc = wid & 3, fr = lane & 15, fq = lane >> 4;
    const int K = g.K, nt = K / BK;
    unsigned voffA[2], voffB[2];
#pragma unroll
    for (int i = 0; i < 2; ++i) { int R, C; stage_rc(tid * 16 + i * 8192, R, C); const int Rb = (R & ~31) + perm32(R & 31);
        voffA[i] = (unsigned)(R * g.lda + C) * 2u; voffB[i] = (unsigned)(Rb * g.ldb + C) * 2u; }
    const size_t kstep = (size_t)(BK * 2);
    const size_t hstepA = (size_t)HALF * g.lda * 2, hstepB = (size_t)HALF * g.ldb * 2;
    const size_t tstepA = 2 * hstepA, tstepB = 2 * hstepB;
    const unsigned ldsw = (unsigned)wid * 1024u;
    const int aoff = lds_byte(wr * 64 + fr, fq * 8), boff = lds_byte(wc * 32 + fr, fq * 8);
#define PG8_SA(b, h) (((b) * 2 + (h)) * HTB)
#define PG8_SB(b, h) ((4 + (b) * 2 + (h)) * HTB)
#define PG8_STAGE(bufoff, gbase, voff) do { _Pragma("unroll") for (int _i = 0; _i < 2; ++_i) \
        __builtin_amdgcn_global_load_lds((const unsigned*)((const char*)(gbase) + (voff)[_i]), (LAS unsigned*)(lds + (bufoff) + ldsw + _i * 8192), 16, 0, 0); } while (0)
#define PG8_LDA(dst, b, h) do { _Pragma("unroll") for (int m = 0; m < 4; ++m) _Pragma("unroll") for (int k = 0; k < 2; ++k) dst[m][k] = *(const LAS bf16x8*)(lds + PG8_SA(b, h) + aoff + m * 2048 + k * 1024); } while (0)
#define PG8_LDB(dst, b, h) do { _Pragma("unroll") for (int n = 0; n < 2; ++n) _Pragma("unroll") for (int k = 0; k < 2; ++k) dst[n][k] = *(const LAS bf16x8*)(lds + PG8_SB(b, h) + boff + n * 2048 + k * 1024); } while (0)
#define PG8_MMA(ai, bj, At, Bt) do { __builtin_amdgcn_s_setprio(1); _Pragma("unroll") for (int m = 0; m < 4; ++m) _Pragma("unroll") for (int n = 0; n < 2; ++n) _Pragma("unroll") for (int k = 0; k < 2; ++k) \
        acc[ai][bj][m][n] = __builtin_amdgcn_mfma_f32_16x16x32_bf16(Bt[n][k], At[m][k], acc[ai][bj][m][n], 0, 0, 0); __builtin_amdgcn_s_setprio(0); } while (0)
#define PG8_WAIT_V(n) asm volatile("s_waitcnt vmcnt(" #n ")" ::: "memory")
#define PG8_WAIT_L(n) asm volatile("s_waitcnt lgkmcnt(" #n ")" ::: "memory")
#define PG8_BAR __builtin_amdgcn_s_barrier()
#define PG8_SCHED __builtin_amdgcn_sched_barrier(0)
    Unit cur, nxt; int ui = 0;
    if (!S.next(0, cur)) return;
    f32x4 acc[2][2][4][2];
#pragma unroll
    for (int a = 0; a < 2; ++a)
#pragma unroll
        for (int b = 0; b < 2; ++b)
#pragma unroll
            for (int m = 0; m < 4; ++m)
#pragma unroll
                for (int n = 0; n < 2; ++n) acc[a][b][m][n] = (f32x4){0.f, 0.f, 0.f, 0.f};
    bf16x8 At[4][2], B0[2][2], B1[2][2];
    const char* cA = (const char*)g.A + (size_t)cur.pm * tstepA; const char* cB = (const char*)g.Bt + (size_t)cur.pn * tstepB;
    PG8_STAGE(PG8_SB(0, 0), cB, voffB); PG8_STAGE(PG8_SB(0, 1), cB + hstepB, voffB); PG8_STAGE(PG8_SA(0, 0), cA, voffA); PG8_STAGE(PG8_SA(0, 1), cA + hstepA, voffA);
    if (wr == 1) PG8_BAR;
    PG8_WAIT_V(2); PG8_BAR;
    PG8_STAGE(PG8_SB(1, 0), cB + kstep, voffB); PG8_STAGE(PG8_SA(1, 0), cA + kstep, voffA); PG8_STAGE(PG8_SB(1, 1), cB + hstepB + kstep, voffB);
    PG8_WAIT_V(6); PG8_BAR;
    for (;;) {
        const bool has_next = S.next(ui + 1, nxt);
        const char* nA = has_next ? (const char*)g.A + (size_t)nxt.pm * tstepA : cA; const char* nB = has_next ? (const char*)g.Bt + (size_t)nxt.pn * tstepB : cB;
#pragma unroll 1
        for (int t = 0; t < nt; t += 2) {
            const bool last = (t == nt - 2);
            const char* a1 = cA + (size_t)(t + 1) * kstep;
            const char* a2 = last ? nA : cA + (size_t)(t + 2) * kstep; const char* b2 = last ? nB : cB + (size_t)(t + 2) * kstep;
            const char* a3 = a2 + kstep; const char* b3 = b2 + kstep;
            if constexpr (Epi::HOOK) { if (E.hook_at(t)) E.mid(acc, cur, t, wr, wc, fr, fq); }
            PG8_LDB(B0, 0, 0); PG8_LDB(B1, 0, 1); PG8_SCHED; PG8_LDA(At, 0, 0); PG8_STAGE(PG8_SA(1, 1), a1 + hstepA, voffA);
            PG8_WAIT_V(8); PG8_WAIT_L(0); PG8_BAR; PG8_MMA(0, 0, At, B0); PG8_MMA(0, 1, At, B1); PG8_BAR; PG8_SCHED;
            PG8_LDA(At, 0, 1); PG8_STAGE(PG8_SB(0, 0), b2, voffB); PG8_STAGE(PG8_SB(0, 1), b2 + hstepB, voffB); PG8_STAGE(PG8_SA(0, 0), a2, voffA);
            PG8_WAIT_V(8); PG8_WAIT_L(0); PG8_BAR; PG8_MMA(1, 0, At, B0); PG8_MMA(1, 1, At, B1); PG8_BAR; PG8_SCHED;
            PG8_LDB(B0, 1, 0); PG8_LDB(B1, 1, 1); PG8_SCHED; PG8_LDA(At, 1, 0); PG8_STAGE(PG8_SA(0, 1), a2 + hstepA, voffA);
            PG8_WAIT_V(8); PG8_WAIT_L(0); PG8_BAR; PG8_MMA(0, 0, At, B0); PG8_MMA(0, 1, At, B1); PG8_BAR; PG8_SCHED;
            PG8_LDA(At, 1, 1); PG8_STAGE(PG8_SB(1, 0), b3, voffB); PG8_STAGE(PG8_SB(1, 1), b3 + hstepB, voffB); PG8_STAGE(PG8_SA(1, 0), a3, voffA);
            PG8_WAIT_V(8); PG8_WAIT_L(0); PG8_BAR; PG8_MMA(1, 0, At, B0); PG8_MMA(1, 1, At, B1); PG8_BAR; PG8_SCHED;
        }
        if (wr == 0) PG8_BAR;
        E(acc, cur, ui, wr, wc, fr, fq);
        if (!has_next) break;
#pragma unroll
        for (int a = 0; a < 2; ++a)
#pragma unroll
            for (int b = 0; b < 2; ++b)
#pragma unroll
                for (int m = 0; m < 4; ++m)
#pragma unroll
                    for (int n = 0; n < 2; ++n) acc[a][b][m][n] = (f32x4){0.f, 0.f, 0.f, 0.f};
        cur = nxt; cA = nA; cB = nB; ++ui;
        if (wr == 1) PG8_BAR;
    }
    PG8_WAIT_V(0);
    PG8_BAR;
#undef PG8_SA
#undef PG8_SB
#undef PG8_STAGE
#undef PG8_LDA
#undef PG8_LDB
#undef PG8_MMA
#undef PG8_WAIT_V
#undef PG8_WAIT_L
#undef PG8_BAR
#undef PG8_SCHED
}
}
using pg8::Unit;
typedef f32x4 Acc[2][2][4][2];

__device__ __forceinline__ float row_rstd(const float* SS, int row) {
    const f32x4* p = (const f32x4*)(SS + (size_t)row * 16);
    const f32x4 a = p[0], b = p[1], c = p[2], d = p[3];
    const float s = ((a.x + a.y) + (a.z + a.w)) + ((b.x + b.y) + (b.z + b.w)) + ((c.x + c.y) + (c.z + c.w)) + ((d.x + d.y) + (d.z + d.w));
    return 1.f / sqrtf(s * (1.f / D) + EPS);
}
#define EPI_ROWS_BEGIN int frl_ = fr; asm volatile("" : "+v"(frl_)); const int row0 = u.pm * 256 + wr * 64 + frl_; const int col0 = u.pn * 256 + wc * 32 + 8 * fq; (void)col0; \
    _Pragma("unroll") for (int ai = 0; ai < 2; ++ai) _Pragma("unroll") for (int m = 0; m < 4; ++m) { const int row = row0 + ai * 128 + m * 16;
#define EPI_ROWS_END asm volatile("" ::: "memory"); }
__device__ __forceinline__ u32x4 pack8(const f32x4 v0, const f32x4 v1) { u32x4 w; w.x = cvt_pk_bf16(v0[0], v0[1]); w.y = cvt_pk_bf16(v0[2], v0[3]); w.z = cvt_pk_bf16(v1[0], v1[1]); w.w = cvt_pk_bf16(v1[2], v1[3]); return w; }

template <int ACT> struct EpiNormBf16 {
    static constexpr bool HOOK = false;
    bf16_t* O; int ldo; const LAS float* rsl;
    bf16_t* S5A; bf16_t* IKC;
    __device__ __forceinline__ void operator()(Acc& acc, const Unit& u, int ui, int wr, int wc, int fr, int fq) const {
        EPI_ROWS_BEGIN
            const float rs = rsl[ui * 256 + (row & 255)]; bf16_t* rowp = O + (size_t)row * ldo + col0;
#pragma unroll
            for (int bj = 0; bj < 2; ++bj) { f32x4 v0 = acc[ai][bj][m][0] * rs, v1 = acc[ai][bj][m][1] * rs;
                if (ACT == 1) {
#pragma unroll
                    for (int j = 0; j < 4; ++j) { v0[j] = sigmoid_nr(v0[j]); v1[j] = sigmoid_nr(v1[j]); } }
                const u32x4 w = pack8(v0, v1);
                if (ACT == 2 && (u.pn == 6 || u.pn == 7)) { const int c = col0 + bj * 128 - C_S5U;
                    *(u32x4*)(S5A + ((size_t)(c >> 4) * 1024 + (row >> 4)) * S5LD + (row & 15) * 16 + (c & 15)) = w; }
                else { *(u32x4*)(rowp + bj * 128) = w;
                    if (ACT == 2 && u.pn == 5 && bj == 1 && wc < 2) *(u32x4*)(IKC + (size_t)(row >> 4) * 1024 + ((wc * 4 + fq) * 16 + (row & 15)) * 8) = w; } }
        EPI_ROWS_END
    }
};
struct EpiMerge {
    static constexpr bool HOOK = true;
    bf16_t* O; const bf16_t* Gt;
    __device__ __forceinline__ bool hook_at(int t) const { return t == 16 || t == 24; }
    __device__ __forceinline__ void mid(Acc& acc, const Unit& u, int t, int wr, int wc, int fr, int fq) const {
        const int s0 = (t == 16) ? 0 : 1024;
        int frl_ = fr; asm volatile("" : "+v"(frl_));
        const int row0 = u.pm * 256 + wr * 64 + frl_, col0 = u.pn * 256 + wc * 32 + 8 * fq;
        u32x4 gn[4];
        { const bf16_t* gp = Gt + (size_t)row0 * GW + col0 + s0; gn[0] = *(const u32x4*)gp; gn[1] = *(const u32x4*)(gp + 1024); gn[2] = *(const u32x4*)(gp + 128); gn[3] = *(const u32x4*)(gp + 1152); }
#pragma unroll
        for (int g = 0; g < 8; ++g) { const int ai = g >> 2, m = g & 3; u32x4 gc[4];
#pragma unroll
            for (int q = 0; q < 4; ++q) gc[q] = gn[q];
            if (g < 7) { const int g2 = g + 1; const bf16_t* gp = Gt + (size_t)(row0 + (g2 >> 2) * 128 + (g2 & 3) * 16) * GW + col0 + s0;
                gn[0] = *(const u32x4*)gp; gn[1] = *(const u32x4*)(gp + 1024); gn[2] = *(const u32x4*)(gp + 128); gn[3] = *(const u32x4*)(gp + 1152); }
#pragma unroll
            for (int bj = 0; bj < 2; ++bj) { const u32x4 ga = gc[2 * bj], gb = gc[2 * bj + 1];
#pragma unroll
                for (int q = 0; q < 4; ++q) { const float r0 = bflo(ga[q]) / bflo(gb[q]), r1 = bfhi(ga[q]) / bfhi(gb[q]);
                    acc[ai][bj][m][q >> 1][(q & 1) * 2] *= r0; acc[ai][bj][m][q >> 1][(q & 1) * 2 + 1] *= r1; } } }
    }
    __device__ __forceinline__ void operator()(Acc& acc, const Unit& u, int ui, int wr, int wc, int fr, int fq) const {
        int frl_ = fr; asm volatile("" : "+v"(frl_));
        const int row0 = u.pm * 256 + wr * 64 + frl_, col0 = u.pn * 256 + wc * 32 + 8 * fq;
        u32x4 gn[2];
        { const bf16_t* gp = Gt + (size_t)row0 * GW + 2048 + col0; gn[0] = *(const u32x4*)gp; gn[1] = *(const u32x4*)(gp + 128); }
#pragma unroll
        for (int g = 0; g < 8; ++g) { const int ai = g >> 2, m = g & 3, row = row0 + ai * 128 + m * 16; u32x4 gcur[2]; gcur[0] = gn[0]; gcur[1] = gn[1];
            if (g < 7) { const int g2 = g + 1; const bf16_t* gp = Gt + (size_t)(row0 + (g2 >> 2) * 128 + (g2 & 3) * 16) * GW + 2048 + col0; gn[0] = *(const u32x4*)gp; gn[1] = *(const u32x4*)(gp + 128); }
            bf16_t* rowp = O + (size_t)row * 1024 + col0;
#pragma unroll
            for (int bj = 0; bj < 2; ++bj) { const u32x4 gc = gcur[bj]; f32x4 v0 = acc[ai][bj][m][0], v1 = acc[ai][bj][m][1];
                v0[0] *= bflo(gc[0]); v0[1] *= bfhi(gc[0]); v0[2] *= bflo(gc[1]); v0[3] *= bfhi(gc[1]); v1[0] *= bflo(gc[2]); v1[1] *= bfhi(gc[2]); v1[2] *= bflo(gc[3]); v1[3] *= bfhi(gc[3]);
                *(u32x4*)(rowp + bj * 128) = pack8(v0, v1); } }
    }
};
struct EpiResid {
    static constexpr bool HOOK = false;
    const float* XO; float* XF; bf16_t* XB; float* SS;
    __device__ __forceinline__ void operator()(Acc& acc, const Unit& u, int ui, int wr, int wc, int fr, int fq) const {
        int frl_ = fr; asm volatile("" : "+v"(frl_));
        const int row0 = u.pm * 256 + wr * 64 + frl_, col0 = u.pn * 256 + wc * 32 + 8 * fq;
        f32x4 xn[4];
        { const size_t off = (size_t)row0 * D + col0; xn[0] = *(const f32x4*)(XO + off); xn[1] = *(const f32x4*)(XO + off + 4); xn[2] = *(const f32x4*)(XO + off + 128); xn[3] = *(const f32x4*)(XO + off + 132); }
#pragma unroll
        for (int g = 0; g < 8; ++g) { const int ai = g >> 2, m = g & 3, row = row0 + ai * 128 + m * 16; const size_t off = (size_t)row * D + col0;
            f32x4 xc[4];
#pragma unroll
            for (int q = 0; q < 4; ++q) xc[q] = xn[q];
            if (g < 7) { const int g2 = g + 1; const size_t o2 = (size_t)(row0 + (g2 >> 2) * 128 + (g2 & 3) * 16) * D + col0;
                xn[0] = *(const f32x4*)(XO + o2); xn[1] = *(const f32x4*)(XO + o2 + 4); xn[2] = *(const f32x4*)(XO + o2 + 128); xn[3] = *(const f32x4*)(XO + o2 + 132); }
            float ss = 0.f;
#pragma unroll
            for (int bj = 0; bj < 2; ++bj) { const f32x4 v0 = acc[ai][bj][m][0] + xc[2 * bj], v1 = acc[ai][bj][m][1] + xc[2 * bj + 1];
                *(f32x4*)(XF + off + bj * 128) = v0; *(f32x4*)(XF + off + bj * 128 + 4) = v1; *(u32x4*)(XB + off + bj * 128) = pack8(v0, v1);
                ss += (v0[0] * v0[0] + v0[1] * v0[1]) + (v0[2] * v0[2] + v0[3] * v0[3]) + (v1[0] * v1[0] + v1[1] * v1[1]) + (v1[2] * v1[2] + v1[3] * v1[3]); }
            ss += __shfl_xor(ss, 16); ss += __shfl_xor(ss, 32);
            if (fq == 0) SS[(size_t)row * 16 + u.pn * 4 + wc] = ss; }
    }
};
struct EpiUpConv {
    static constexpr bool HOOK = false;
    bf16_t* ACT; const LAS float* rsl; LAS unsigned char* hal; const float* cw; bf16_t* HALO; bf16_t* FIRST;
    __device__ __forceinline__ void operator()(Acc& acc, const Unit& u, int ui, int wr, int wc, int fr, int fq) const {
        int frl_ = fr, fql_ = fq; asm volatile("" : "+v"(frl_), "+v"(fql_));
        const int f = frl_, cb = wc * 32 + 8 * fql_;
#pragma unroll
        for (int ai = 0; ai < 2; ++ai)
#pragma unroll
            for (int m = 0; m < 4; ++m) { const float rs = rsl[ui * 256 + ai * 128 + wr * 64 + m * 16 + f];
#pragma unroll
                for (int bj = 0; bj < 2; ++bj) { acc[ai][bj][m][0] = acc[ai][bj][m][0] * rs; acc[ai][bj][m][1] = acc[ai][bj][m][1] * rs; } }
        if (f >= 14) {
#pragma unroll
            for (int ai = 0; ai < 2; ++ai)
#pragma unroll
                for (int bj = 0; bj < 2; ++bj) { const u32x4 w = pack8(acc[ai][bj][3][0], acc[ai][bj][3][1]);
                    *(LAS u32x4*)(hal + (((ai * 2 + wr) * 2 + (f - 14)) * 256 + bj * 128 + cb) * 2) = w;
                    if (ai == 1 && wr == 1) *(u32x4*)(HALO + ((size_t)(u.pm * 22 + u.pn) * 2 + (f - 14)) * 256 + bj * 128 + cb) = w; } }
        if (f < 2 && wr == 0) {
#pragma unroll
            for (int bj = 0; bj < 2; ++bj) *(u32x4*)(FIRST + ((size_t)(u.pm * 22 + u.pn) * 2 + f) * 256 + bj * 128 + cb) = pack8(acc[0][bj][0][0], acc[0][bj][0][1]); }
        asm volatile("s_waitcnt lgkmcnt(0)\n\ts_barrier" ::: "memory");
        float wg[3][8], wv[3][8];
        { const float* cp = cw + u.pn * 128 + cb;
#pragma unroll
          for (int k = 0; k < 3; ++k) { const f32x4 a0 = *(const f32x4*)(cp + k * 2 * DFF), a1 = *(const f32x4*)(cp + k * 2 * DFF + 4), b0 = *(const f32x4*)(cp + k * 2 * DFF + DFF), b1 = *(const f32x4*)(cp + k * 2 * DFF + DFF + 4);
#pragma unroll
              for (int x = 0; x < 4; ++x) { wg[k][x] = a0[x]; wg[k][4 + x] = a1[x]; wv[k][x] = b0[x]; wv[k][4 + x] = b1[x]; } } }
#pragma unroll
        for (int ai = 0; ai < 2; ++ai) {
            f32x4 pv[2][2];
            { const bool has = !(ai == 0 && wr == 0); const int ps = (wr == 1) ? ai * 2 : 1;
#pragma unroll
              for (int bj = 0; bj < 2; ++bj) { u32x4 w = {0u, 0u, 0u, 0u}; if (has && f >= 14) w = *(const LAS u32x4*)(hal + ((ps * 2 + (f - 14)) * 256 + bj * 128 + cb) * 2);
                  pv[bj][0] = (f32x4){bflo(w[0]), bfhi(w[0]), bflo(w[1]), bfhi(w[1])}; pv[bj][1] = (f32x4){bflo(w[2]), bfhi(w[2]), bflo(w[3]), bfhi(w[3])}; } }
#pragma unroll
            for (int m = 0; m < 4; ++m) { float hg[8], hv[8];
#pragma unroll
                for (int bj = 0; bj < 2; ++bj)
#pragma unroll
                    for (int n2 = 0; n2 < 2; ++n2)
#pragma unroll
                        for (int x = 0; x < 4; ++x) { const float cur = acc[ai][bj][m][n2][x], prv = (m == 0) ? pv[bj][n2][x] : acc[ai][bj][m - 1][n2][x];
                            const float t1 = (f == 15) ? prv : cur, t2 = (f >= 14) ? prv : cur;
                            const float p1 = __builtin_bit_cast(float, __builtin_amdgcn_update_dpp(0, __builtin_bit_cast(int, t1), 0x121, 0xf, 0xf, false));
                            const float p2 = __builtin_bit_cast(float, __builtin_amdgcn_update_dpp(0, __builtin_bit_cast(int, t2), 0x122, 0xf, 0xf, false)); const int c = 4 * n2 + x;
                            const float hh = (bj == 0 ? wg[0][c] : wv[0][c]) * p2 + (bj == 0 ? wg[1][c] : wv[1][c]) * p1 + (bj == 0 ? wg[2][c] : wv[2][c]) * cur;
                            if (bj == 0) hg[c] = hh; else hv[c] = hh; }
                u32x4 o;
#pragma unroll
                for (int q = 0; q < 4; ++q) o[q] = pk2(siluf_(hg[2 * q]) * hv[2 * q], siluf_(hg[2 * q + 1]) * hv[2 * q + 1]);
                *(u32x4*)(ACT + (size_t)(u.pm * 256 + ai * 128 + wr * 64 + m * 16 + f) * DFF + u.pn * 128 + cb) = o; } }
    }
};
struct EpiS5S {
    static constexpr bool HOOK = false;
    float* S;
    __device__ __forceinline__ void operator()(Acc& acc, const Unit& u, int ui, int wr, int wc, int fr, int fq) const {
        int frl_ = fr; asm volatile("" : "+v"(frl_));
        const int row0 = u.pm * 256 + wr * 64 + frl_, c0 = wc * 32 + 8 * fq;
#pragma unroll
        for (int ai = 0; ai < 2; ++ai)
#pragma unroll
            for (int m = 0; m < 4; ++m) { float* p = S + (size_t)(row0 + ai * 128 + m * 16) * 128 + c0; *(f32x4*)p = acc[ai][0][m][0]; *(f32x4*)(p + 4) = acc[ai][0][m][1]; }
    }
};
struct EpiS5Y {
    static constexpr bool HOOK = false;
    bf16_t* YG;
    __device__ __forceinline__ void operator()(Acc& acc, const Unit& u, int ui, int wr, int wc, int fr, int fq) const {
        int frl_ = fr; asm volatile("" : "+v"(frl_));
        const int g = u.pn, rg0 = (u.pm & 3) * 256 + wr * 64 + frl_;
#pragma unroll
        for (int ai = 0; ai < 2; ++ai)
#pragma unroll
            for (int m = 0; m < 4; ++m) { const int rg = rg0 + ai * 128 + m * 16;
#pragma unroll
                for (int bj = 0; bj < 2; ++bj) { const int c = bj * 128 + wc * 32 + 8 * fq, t = c >> 4, ch = c & 15; f32x4 v0 = acc[ai][bj][m][0], v1 = acc[ai][bj][m][1];
#pragma unroll
                    for (int j = 0; j < 4; ++j) { v0[j] = gelu_tanh(v0[j]); v1[j] = gelu_tanh(v1[j]); }
                    *(u32x4*)(YG + (size_t)(rg * 16 + t) * 512 + g * 16 + ch) = pack8(v0, v1); } asm volatile("" ::: "memory"); }
    }
};
struct EpiS5G {
    static constexpr bool HOOK = false;
    const bf16_t* YG; bf16_t* BR;
    __device__ __forceinline__ void operator()(Acc& acc, const Unit& u, int ui, int wr, int wc, int fr, int fq) const {
        EPI_ROWS_BEGIN
#pragma unroll
            for (int bj = 0; bj < 2; ++bj) { const u32x4 y = *(const u32x4*)(YG + (size_t)row * 512 + col0 + bj * 128); f32x4 v0 = acc[ai][bj][m][0], v1 = acc[ai][bj][m][1];
                v0[0] = bflo(y[0]) * sigmoidf_(v0[0]); v0[1] = bfhi(y[0]) * sigmoidf_(v0[1]); v0[2] = bflo(y[1]) * sigmoidf_(v0[2]); v0[3] = bfhi(y[1]) * sigmoidf_(v0[3]);
                v1[0] = bflo(y[2]) * sigmoidf_(v1[0]); v1[1] = bfhi(y[2]) * sigmoidf_(v1[1]); v1[2] = bflo(y[3]) * sigmoidf_(v1[2]); v1[3] = bfhi(y[3]) * sigmoidf_(v1[3]);
                *(u32x4*)(BR + (size_t)row * BRW + 1024 + col0 + bj * 128) = pack8(v0, v1); }
        EPI_ROWS_END
    }
};

struct Args { const float* in[28]; float* out; unsigned char* ws; int ph_lo, ph_hi; };
typedef const __attribute__((address_space(4))) Args CArgs;
struct Frame {
    LAS unsigned char* lds;
    CArgs* ap;
    unsigned char* ws;
    int tid, lane, wave, G, bid;
};
enum { I_X = 0, I_ANG, I_WIN, I_KVG, I_WUK, I_WUV, I_WPA, I_S5ARE, I_S5AIM, I_S5LDT, I_S5BRE, I_S5BIM, I_S5CRE, I_S5CIM, I_S5D, I_WGLU, I_WPB, I_GCW, I_GALOG, I_GDTB, I_GNG, I_WPC, I_WOUT, I_FNG, I_WUP, I_FCW, I_WDN, I_FING };

template <class Sched> __device__ __forceinline__ const LAS float* rstd_table(Frame& F, const Sched& S, const float* SS) {
    LAS float* rsl = (LAS float*)(F.lds + 131072); Unit u;
    for (int i = 0; S.next(i, u); ++i) for (int r = F.tid; r < 256; r += 512) rsl[i * 256 + r] = row_rstd(SS, u.pm * 256 + r);
    __syncthreads();
    return rsl;
}
__device__ __forceinline__ void ph_x0(Frame& F) {
    const float* x = F.ap->in[I_X]; bf16_t* XB = (bf16_t*)(F.ws + WS_XB); float* SS = (float*)(F.ws + WS_SS);
    const int gw = F.bid * 8 + F.wave, NGW = F.G * 8;
    for (int r = gw; r < M; r += NGW) {
        const f32x4* xr = (const f32x4*)(x + (size_t)r * D) + F.lane; float s = 0.f; f32x4 v[4];
#pragma unroll
        for (int j = 0; j < 4; ++j) { v[j] = xr[64 * j]; s += (v[j].x * v[j].x + v[j].y * v[j].y) + (v[j].z * v[j].z + v[j].w * v[j].w); }
        s = wave_sum(s);
        u32x2* o = (u32x2*)(XB + (size_t)r * D) + F.lane;
#pragma unroll
        for (int j = 0; j < 4; ++j) { u32x2 w; w.x = pk2(v[j].x, v[j].y); w.y = pk2(v[j].z, v[j].w); o[64 * j] = w; }
        if (F.lane < 16) SS[(size_t)r * 16 + F.lane] = (F.lane == 0) ? s : 0.f;
    }
}

__device__ __forceinline__ int win1_col(int n) {
    if (n < 1152) return 512 + (n - 1024);
    if (n < 1408) return 640 + (n - 1152);
    if (n < 1472) return 896 + (n - 1408);
    if (n < 1476) return 960 + (n - 1472);
    if (n < 1480) return 3524 + (n - 1476);
    if (n < 1484) return 3528 + (n - 1480);
    if (n < 1536) return -1;
    if (n < 2048) return 964 + (n - 1536);
    if (n < 3584) return 1476 + (n - 2048);
    return 3012 + (n - 3584);
}
__device__ __forceinline__ int wup_col(int n) { const int j = n >> 8, bj = (n >> 7) & 1, i = n & 127; return bj * DFF + j * 128 + i; }
__device__ __forceinline__ void tr_one(int lane, int it, const float* src, int sld, const float* scale, bf16_t* dst, int dld, int koff, int n0, int nn, int kind, LAS float* scr) {
    const int nblk = nn / 32;
    const int kb = it / nblk, nb = it % nblk, k0 = kb * 64, nbase = n0 + nb * 32, r8 = lane >> 3, c4 = lane & 7, n = nbase + 4 * c4;
    int col = n; if (kind == 1) col = win1_col(n); else if (kind == 2) col = 3532 + n; else if (kind == 3) col = wup_col(n);
    f32x4 v[8]; float sc[8];
    const float* sp = src + (size_t)(k0 + r8) * sld + (col >= 0 ? col : 0);
#pragma unroll
    for (int i = 0; i < 8; ++i) v[i] = *(const f32x4*)(sp + (size_t)(8 * i) * sld);
#pragma unroll
    for (int i = 0; i < 8; ++i) sc[i] = scale ? scale[k0 + 8 * i + r8] : 1.f;
    if (col < 0) {
#pragma unroll
        for (int i = 0; i < 8; ++i) sc[i] = 0.f; }
#pragma unroll
    for (int i = 0; i < 8; ++i) { LAS float* d = scr + (8 * i + r8) * 33 + 4 * c4; d[0] = v[i][0] * sc[i]; d[1] = v[i][1] * sc[i]; d[2] = v[i][2] * sc[i]; d[3] = v[i][3] * sc[i]; }
    WAVE_SYNC();
    const int c = lane & 7;
#pragma unroll
    for (int j = 0; j < 4; ++j) { const int nl = (lane >> 3) + 8 * j; const LAS float* s = scr + (8 * c) * 33 + nl;
        u32x4 o; o.x = pk2(s[0 * 33], s[1 * 33]); o.y = pk2(s[2 * 33], s[3 * 33]); o.z = pk2(s[4 * 33], s[5 * 33]); o.w = pk2(s[6 * 33], s[7 * 33]);
        *(u32x4*)(dst + (size_t)(nbase + nl) * dld + koff + k0 + 8 * c) = o; }
    WAVE_SYNC();
}
__device__ __forceinline__ void ph_wprep(Frame& F, int l) {
    LAS float* L = (LAS float*)F.lds;
    const float* w_in = F.ap->in[I_WIN] + (size_t)l * D * NIN; const float* ang = F.ap->in[I_ANG] + (size_t)l * D;
    bf16_t* WIN1 = (bf16_t*)(F.ws + WS_WIN1); bf16_t* WMRG = (bf16_t*)(F.ws + WS_WMRG);
    for (int pass = 0; pass * F.G < 320; ++pass) {
        int it = F.bid + pass * F.G;
        if (F.G == 256 && pass == 1) it = (F.bid >= 64 && F.bid < 128) ? F.bid + 192 : 320;
        if (it >= 320) continue;
        __syncthreads();
        if (it >= 64 && it < 192) {
            const int j = it - 64, h = j >> 4, k0 = (j & 15) * 64; const float* wuk = F.ap->in[I_WUK] + (size_t)l * 128 * 512;
            LAS float* A = L; LAS float* Bm = L + 64 * 65;
            for (int e = F.tid; e < 64 * 64; e += 512) { const int kk = e >> 6, d = e & 63; A[kk * 65 + d] = w_in[(size_t)(k0 + kk) * NIN + h * 64 + d] * ang[k0 + kk] * 0.125f; }
            for (int e = F.tid; e < 128 * 64; e += 512) { const int r = e >> 6, d = e & 63; Bm[r * 65 + d] = wuk[(size_t)r * 512 + h * 64 + d]; }
            __syncthreads();
            for (int e = F.tid; e < 128 * 64; e += 512) { const int r = e >> 6, kk = e & 63; float s = 0.f;
#pragma unroll 16
                for (int d = 0; d < 64; ++d) s += A[kk * 65 + d] * Bm[r * 65 + d];
                WIN1[(size_t)(h * 128 + r) * D + k0 + kk] = (bf16_t)f2bf(s); }
        } else if (it >= 192) {
            const int j = it - 192, h = j >> 4, n0 = (j & 15) * 64; const float* wuv = F.ap->in[I_WUV] + (size_t)l * 128 * 512; const float* wpa = F.ap->in[I_WPA] + (size_t)l * 512 * D;
            LAS float* A = L; LAS float* Bm = L + 64 * 65;
            for (int e = F.tid; e < 64 * 64; e += 512) { const int d = e >> 6, nn = e & 63; A[d * 65 + nn] = wpa[(size_t)(h * 64 + d) * D + n0 + nn]; }
            for (int e = F.tid; e < 128 * 64; e += 512) { const int r = e >> 6, d = e & 63; Bm[r * 65 + d] = wuv[(size_t)r * 512 + h * 64 + d]; }
            __syncthreads();
            for (int e = F.tid; e < 128 * 64; e += 512) { const int nn = e >> 7, r = e & 127; float s = 0.f;
#pragma unroll 16
                for (int d = 0; d < 64; ++d) s += A[d * 65 + nn] * Bm[r * 65 + d];
                WMRG[(size_t)(n0 + nn) * BRW + h * 128 + r] = (bf16_t)f2bf(s); }
        } else {
            const int g = it >> 1, hf = it & 1;
            const float* are = F.ap->in[I_S5ARE] + (size_t)l * 2048 + g * 64; const float* aim = F.ap->in[I_S5AIM] + (size_t)l * 2048 + g * 64;
            const float dt = __expf(F.ap->in[I_S5LDT][l * 32 + g]);
            const float* bre = F.ap->in[I_S5BRE] + (size_t)l * 32768 + g * 1024; const float* bim = F.ap->in[I_S5BIM] + (size_t)l * 32768 + g * 1024;
            const float* cre = F.ap->in[I_S5CRE] + (size_t)l * 32768 + g * 1024; const float* cim = F.ap->in[I_S5CIM] + (size_t)l * 32768 + g * 1024;
            const float* dd = F.ap->in[I_S5D] + (size_t)l * 512 + g * 16;
            LAS float* PWR = L;
            LAS float* PWI = L + 1088;
            LAS float* BBR = L + 2176;
            LAS float* BBI = BBR + 1024;
            LAS float* CR = BBI + 1024;
            LAS float* CI = CR + 1024;
            LAS float* KT = CI + 1024;
            for (int e = F.tid; e < 17 * 64; e += 512) { const int j = e >> 6, p = e & 63; const float mag = expf(dt * are[p] * (float)j), a = dt * aim[p] * (float)j; PWR[e] = mag * cosf(a); PWI[e] = mag * sinf(a); }
            for (int e = F.tid; e < 1024; e += 512) { const int p = e >> 4; const float ar = are[p], ai = aim[p];
                const float mag = expf(dt * ar), a = dt * ai, abr = mag * cosf(a), abi = mag * sinf(a), den = ar * ar + ai * ai, nr = abr - 1.f;
                const float fre = (nr * ar + abi * ai) / den, fim = (abi * ar - nr * ai) / den;
                BBR[e] = fre * bre[e] - fim * bim[e]; BBI[e] = fre * bim[e] + fim * bre[e]; CR[e] = cre[e]; CI[e] = cim[e]; }
            __syncthreads();
            for (int e = F.tid; e < 4096; e += 512) { const int j = e >> 8, m = (e >> 4) & 15, mp = e & 15; float s = 0.f;
                for (int p = 0; p < 64; ++p) { const float cr = CR[m * 64 + p], ci = CI[m * 64 + p], pr = PWR[j * 64 + p], pi = PWI[j * 64 + p], br = BBR[p * 16 + mp], bi = BBI[p * 16 + mp];
                    const float zr = cr * pr - ci * pi, zi = cr * pi + ci * pr; s += zr * br - zi * bi; }
                KT[e] = s; }
            __syncthreads();
            bf16_t* W1 = (bf16_t*)(F.ws + WS_S5W1) + (size_t)g * 256 * 256; bf16_t* TT = (bf16_t*)(F.ws + WS_S5T) + (size_t)g * 256 * 384;
            for (int e = hf * 32768 + F.tid; e < (hf + 1) * 32768; e += 512) { const int n = e >> 8, k = e & 255; float v = 0.f;
                if (n < 128) { const int p = n & 63, s = k >> 4, m = k & 15, j = 15 - s; const float pr = PWR[j * 64 + p], pi = PWI[j * 64 + p], br = BBR[p * 16 + m], bi = BBI[p * 16 + m];
                    v = (n < 64) ? (pr * br - pi * bi) : (pr * bi + pi * br); }
                W1[e] = (bf16_t)f2bf(v); }
            for (int e = hf * 49152 + F.tid; e < (hf + 1) * 49152; e += 512) { const int n = e / 384, k = e % 384, t = n >> 4, m = n & 15; float v = 0.f;
                if (k < 256) { const int s = k >> 4, mp = k & 15; if (s <= t) { v = KT[((t - s) * 16 + m) * 16 + mp]; if (s == t && m == mp) v += dd[m]; } }
                else { const int p = (k - 256) & 63; const float cr = CR[m * 64 + p], ci = CI[m * 64 + p], pr = PWR[(t + 1) * 64 + p], pi = PWI[(t + 1) * 64 + p];
                    v = (k < 320) ? (cr * pr - ci * pi) : -(cr * pi + ci * pr); }
                TT[e] = (bf16_t)f2bf(v); }
            float* S5P = (float*)(F.ws + WS_S5P) + (size_t)g * 128;
            if (hf == 0) for (int e = F.tid; e < 64; e += 512) { S5P[e] = PWR[16 * 64 + e]; S5P[64 + e] = PWI[16 * 64 + e]; }
        }
    }
    __syncthreads();
    LAS float* scr = (LAS float*)(F.lds + F.wave * 16384);
    gu32* ctr = (gu32*)(F.ws + WS_CTL) + CW_Q + (16 + l) * 64;
    constexpr int N0 = 1536, N1 = N0 + 1536, N2 = N1 + 256, N3 = N2 + 256, N4 = N3 + 512, N5 = N4 + 2816, N6 = N5 + 1408, N7 = N6 + 128;
    for (;;) {
        unsigned gi = 0u; if (F.lane == 0) gi = __hip_atomic_fetch_add(ctr, 8u, RLX_AGENT);
        const int it0 = __builtin_amdgcn_readfirstlane((int)gi);
        if (it0 >= N7) break;
#pragma unroll 1
        for (int it = it0; it < it0 + 8 && it < N7; ++it) {
        if (it < N0) tr_one(F.lane, it, w_in, NIN, ang, WIN1, D, 0, 1024, 3072, 1, scr);
        else if (it < N1) tr_one(F.lane, it - N0, w_in, NIN, ang, (bf16_t*)(F.ws + WS_WIN2), D, 0, 0, GW, 2, scr);
        else if (it < N2) tr_one(F.lane, it - N1, F.ap->in[I_WPB] + (size_t)l * 512 * D, D, nullptr, WMRG, BRW, 1024, 0, D, 0, scr);
        else if (it < N3) tr_one(F.lane, it - N2, F.ap->in[I_WPC] + (size_t)l * 512 * D, D, nullptr, WMRG, BRW, 1536, 0, D, 0, scr);
        else if (it < N4) tr_one(F.lane, it - N3, F.ap->in[I_WOUT] + (size_t)l * D * D, D, nullptr, (bf16_t*)(F.ws + WS_WOUT), D, 0, 0, D, 0, scr);
        else if (it < N5) tr_one(F.lane, it - N4, F.ap->in[I_WUP] + (size_t)l * D * 2 * DFF, 2 * DFF, F.ap->in[I_FNG] + (size_t)l * D, (bf16_t*)(F.ws + WS_WUP), D, 0, 0, 2 * DFF, 3, scr);
        else if (it < N6) tr_one(F.lane, it - N5, F.ap->in[I_WDN] + (size_t)l * DFF * D, D, nullptr, (bf16_t*)(F.ws + WS_WDN), DFF, 0, 0, D, 0, scr);
        else tr_one(F.lane, it - N6, F.ap->in[I_WGLU] + (size_t)l * 512 * 512, 512, nullptr, (bf16_t*)(F.ws + WS_WGLU), 512, 0, 0, 512, 0, scr);
        }
    }
}

__device__ __forceinline__ void ph_prep_a(Frame& F, int l) {
    const bf16_t* P1 = (const bf16_t*)(F.ws + WS_P1); bf16_t* CN = (bf16_t*)(F.ws + WS_CN);
    const float* kvg = F.ap->in[I_KVG] + (size_t)l * 128;
    const int gw = F.bid * 8 + F.wave, NGW = F.G * 8;
    for (int r = gw; r < MH; r += NGW) {
        const unsigned w = *((const unsigned*)(P1 + (size_t)r * P1W + C_CKV) + F.lane); const float a = bflo(w), b = bfhi(w);
        const float rs = 1.f / sqrtf(wave_sum(a * a + b * b) * (1.f / 128.f) + EPS);
        *((unsigned*)(CN + (size_t)r * 128) + F.lane) = pk2(a * rs * kvg[2 * F.lane], b * rs * kvg[2 * F.lane + 1]);
    }
}

#ifndef GP_REP_A
#define GP_REP_A 1
#endif
#ifndef GP_REP_B
#define GP_REP_B 1
#endif
#ifndef GP_REP_C
#define GP_REP_C 1
#endif
#ifndef GP_REP_D
#define GP_REP_D 1
#endif
__device__ __forceinline__ int gdn_pos(int r, int x, int rowlen) {
    const int g = x >> 5, y = x & 31;
    const int p = (y < 16) ? (8 * (y >> 2) + (y & 3)) : (8 * ((y - 16) >> 2) + 4 + (y & 3));
    const int P = g * 32 + p, chunk = P >> 3, mask = (rowlen == 128) ? 15 : 7;
    return ((chunk ^ (r & mask)) << 3) + (P & 7);
}
__device__ __forceinline__ void ph_gdn_prep(Frame& F, int l) {
    const bf16_t* P1 = (const bf16_t*)(F.ws + WS_P1); bf16_t* GD = (bf16_t*)(F.ws + WS_GDN); float* GLAST = (float*)(F.ws + WS_GLAST);
    const float* cw = F.ap->in[I_GCW] + (size_t)l * 4 * 1536;
    const bf16_t* zpage = (const bf16_t*)(F.ws + WS_CTL + 786432);
    constexpr int RS = 132, RB = 136, RT_S = 72, MS = 68;
    LAS float* qs = (LAS float*)F.lds; LAS float* ks = qs + 64 * RS;
    LAS float* Mm = (LAS float*)F.lds; LAS float* Tm = Mm + 64 * MS; LAS float* Pt = Tm + 64 * MS; LAS bf16_t* Tb = (LAS bf16_t*)(Pt + 768);
    LAS bf16_t* qb = (LAS bf16_t*)(F.lds + 2 * 64 * RS * 4); LAS bf16_t* kb = qb + 64 * RB; LAS bf16_t* RT = kb + 64 * RB;
    LAS float* gam = (LAS float*)(RT + 256 * RT_S); LAS float* bet = gam + 64; LAS float* egam = bet + 64;
    LAS float* wl = (LAS float*)(F.lds + 49152);
    const int wave = F.wave;
    for (int cu = F.bid; cu < BH * 4 * 64; cu += F.G) {
        int lane_ = F.lane; asm volatile("" : "+v"(lane_));
        const int lane = lane_, tid = wave * 64 + lane, n = lane & 15, qd = lane >> 4;
        const int bl = cu >> 8, h = (cu >> 6) & 3, ch = cu & 63, t0 = ch * 64;
        const size_t rbase = (size_t)bl * T;
        bf16_t* rec = GD + (size_t)cu * GDN_CH;
        __syncthreads();
#pragma unroll 1
        for (int rep_ = 0; rep_ < GP_REP_A; ++rep_) {
        const int r8 = lane >> 3, part = lane & 7, d0 = part * 16, i = 8 * wave + r8, t = t0 + i;
        float wv[3];
#pragma unroll
        for (int m = 0; m < 3; ++m) wv[m] = cw[(tid >> 7) * 1536 + m * 512 + h * 128 + (tid & 127)];
        u32x4 xr[3][4][2];
#pragma unroll
        for (int k = 0; k < 4; ++k) { const int tt = t - 3 + k; const bf16_t* p = (tt < 0) ? zpage : P1 + (rbase + tt) * P1W + C_QKV + h * 128 + d0;
#pragma unroll
            for (int j3 = 0; j3 < 3; ++j3) { xr[j3][k][0] = *(const u32x4*)(p + j3 * 512); xr[j3][k][1] = *(const u32x4*)(p + j3 * 512 + 8); } }
        if (wave == 0) { const bf16_t* rp = P1 + (rbase + t0 + lane) * P1W; const float a = bf2f(rp[C_CA + h]), b = bf2f(rp[C_CB + h]);
            float g = -__expf(F.ap->in[I_GALOG][l * 4 + h]) * softplusf_(a + F.ap->in[I_GDTB][l * 4 + h]);
#pragma unroll
            for (int o = 1; o < 64; o <<= 1) { const float up = __shfl_up(g, o); if (lane >= o) g += up; }
            gam[lane] = g; bet[lane] = sigmoidf_(b); egam[lane] = __expf(g); if (lane == 63) GLAST[cu] = __expf(g); }
#pragma unroll
        for (int m = 0; m < 3; ++m) wl[m * 512 + tid] = wv[m];
        __syncthreads();
        { const float gl = gam[63]; const int rsw = ((wave ^ part) << 3) + r8;
#pragma unroll
          for (int j3 = 0; j3 < 3; ++j3) {
            float y[16];
#pragma unroll
            for (int c = 0; c < 16; ++c) y[c] = 0.f;
#pragma unroll
            for (int k = 0; k < 4; ++k) {                 const LAS f32x4* wp = (const LAS f32x4*)(wl + (j3 * 4 + k) * 128 + d0); const f32x4 w0 = wp[0], w1 = wp[1], w2 = wp[2], w3 = wp[3];
                const u32x4 x0 = xr[j3][k][0], x1 = xr[j3][k][1];
                y[0] += w0[0] * bflo(x0[0]); y[1] += w0[1] * bfhi(x0[0]); y[2] += w0[2] * bflo(x0[1]); y[3] += w0[3] * bfhi(x0[1]);
                y[4] += w1[0] * bflo(x0[2]); y[5] += w1[1] * bfhi(x0[2]); y[6] += w1[2] * bflo(x0[3]); y[7] += w1[3] * bfhi(x0[3]);
                y[8] += w2[0] * bflo(x1[0]); y[9] += w2[1] * bfhi(x1[0]); y[10] += w2[2] * bflo(x1[1]); y[11] += w2[3] * bfhi(x1[1]);
                y[12] += w3[0] * bflo(x1[2]); y[13] += w3[1] * bfhi(x1[2]); y[14] += w3[2] * bflo(x1[3]); y[15] += w3[3] * bfhi(x1[3]); }
#pragma unroll
            for (int c = 0; c < 16; ++c) y[c] = siluf_(y[c]);
            if (j3 == 2) { const float b = bet[i];
#pragma unroll
                for (int c = 0; c < 16; ++c) RT[(d0 + c) * RT_S + rsw] = (bf16_t)f2bf(y[c] * b); }
            else { const bool isq = (j3 == 0); float ss = 0.f;
#pragma unroll
                for (int c = 0; c < 16; ++c) ss += y[c] * y[c];
                ss += __shfl_xor(ss, 1); ss += __shfl_xor(ss, 2); ss += __shfl_xor(ss, 4);
                float rs = 1.f / sqrtf(ss + EPS); if (isq) rs *= 0.08838834764831845f;
                f32x4 v[4];
#pragma unroll
                for (int q = 0; q < 4; ++q) v[q] = (f32x4){y[4 * q] * rs, y[4 * q + 1] * rs, y[4 * q + 2] * rs, y[4 * q + 3] * rs};
                LAS bf16_t* cb = (isq ? qb : kb) + i * RB + d0;
                *(LAS u32x4*)cb = pack8(v[0], v[1]); *(LAS u32x4*)(cb + 8) = pack8(v[2], v[3]);
                if (isq) { const float eq = egam[i];
#pragma unroll
                    for (int q = 0; q < 4; ++q) { u32x2 o; o.x = pk2(v[q][0] * eq, v[q][1] * eq); o.y = pk2(v[q][2] * eq, v[q][3] * eq); *(u32x2*)(rec + 8192 + i * 128 + gdn_pos(i, d0 + 4 * q, 128)) = o; } }
                else { const float be = bet[i] * egam[i], ek = __expf(gl - gam[i]);
#pragma unroll
                    for (int q = 0; q < 4; ++q)
#pragma unroll
                        for (int x = 0; x < 4; ++x) { const int d = d0 + 4 * q + x; RT[(128 + d) * RT_S + rsw] = (bf16_t)f2bf(v[q][x] * be); rec[16384 + d * 64 + gdn_pos(d, i, 64)] = (bf16_t)f2bf(v[q][x] * ek); } } } } }
        __syncthreads();
        }
#pragma unroll 1
        for (int rep_ = 0; rep_ < GP_REP_B; ++rep_) {
        { const int mat = wave >> 2, mi = wave & 3; const LAS bf16_t* Asrc = (mat == 0 ? kb : qb) + (16 * mi + n) * RB + qd * 8;
          bf16x8 af[4];
#pragma unroll
          for (int s2 = 0; s2 < 4; ++s2) af[s2] = *(const LAS bf16x8*)(Asrc + 32 * s2);
          f32x4 cc[4];
#pragma unroll
          for (int mj = 0; mj < 4; ++mj) { cc[mj] = (f32x4){0.f, 0.f, 0.f, 0.f}; const LAS bf16_t* Bsrc = kb + (16 * mj + n) * RB + qd * 8;
#pragma unroll
              for (int s2 = 0; s2 < 4; ++s2) cc[mj] = __builtin_amdgcn_mfma_f32_16x16x32_bf16(af[s2], *(const LAS bf16x8*)(Bsrc + 32 * s2), cc[mj], 0, 0, 0); }
          __syncthreads();
#pragma unroll
          for (int mj = 0; mj < 4; ++mj) { const int j = 16 * mj + n; const float gj = gam[j];
#pragma unroll
              for (int rg = 0; rg < 4; ++rg) { const int i = 16 * mi + 4 * qd + rg; const float dec = (i >= j) ? __expf(gam[i] - gj) : 0.f;
                  if (mat == 0) { Mm[i * MS + j] = (i > j) ? bet[i] * cc[mj][rg] * dec : 0.f; Tm[i * MS + j] = 0.f; }
                  else rec[24576 + i * 64 + gdn_pos(i, j, 64)] = (bf16_t)f2bf(cc[mj][rg] * dec); } } }
        __syncthreads();
        }
#pragma unroll 1
        for (int rep_ = 0; rep_ < GP_REP_C; ++rep_) {
        if (tid < 64) { const int b = tid >> 4, c = tid & 15; float x[16];
#pragma unroll
            for (int r = 0; r < 16; ++r) { float a = (r == c) ? 1.f : 0.f;
#pragma unroll
                for (int j = 0; j < r; ++j) a -= Mm[(16 * b + r) * MS + 16 * b + j] * x[j];
                x[r] = a; }
#pragma unroll
            for (int r = 0; r < 16; ++r) Tm[(16 * b + r) * MS + 16 * b + c] = x[r]; }
        __syncthreads();
#pragma unroll 1
        for (int dl = 1; dl < 4; ++dl) { const int np = 4 - dl;
            for (int e = tid; e < np * 256; e += 512) { const int pr = e >> 8, r = (e >> 4) & 15, c = e & 15, bi = pr + dl, bj = pr; float a = 0.f;
                for (int kb2 = bj; kb2 < bi; ++kb2)
#pragma unroll
                    for (int t = 0; t < 16; ++t) a += Mm[(16 * bi + r) * MS + 16 * kb2 + t] * Tm[(16 * kb2 + t) * MS + 16 * bj + c];
                Pt[e] = a; }
            __syncthreads();
            for (int e = tid; e < np * 256; e += 512) { const int pr = e >> 8, r = (e >> 4) & 15, c = e & 15, bi = pr + dl, bj = pr; float a = 0.f;
#pragma unroll
                for (int t = 0; t < 16; ++t) a += Tm[(16 * bi + r) * MS + 16 * bi + t] * Pt[(pr * 16 + t) * 16 + c];
                Tm[(16 * bi + r) * MS + 16 * bj + c] = -a; }
            __syncthreads(); }
        for (int e = tid; e < 64 * 32; e += 512) { const int i = e >> 5, j2 = (e & 31) * 2; *(LAS unsigned*)(Tb + i * RT_S + j2) = pk2(Tm[i * MS + j2], Tm[i * MS + j2 + 1]); }
        __syncthreads();
        }
#pragma unroll 1
        for (int rep_ = 0; rep_ < GP_REP_D; ++rep_) {
        { bf16x8 tf[4][2];
#pragma unroll
          for (int mi = 0; mi < 4; ++mi)
#pragma unroll
              for (int s2 = 0; s2 < 2; ++s2) tf[mi][s2] = *(const LAS bf16x8*)(Tb + (16 * mi + n) * RT_S + 32 * s2 + qd * 8);
#pragma unroll
          for (int nl = 0; nl < 2; ++nl) { const int c = 16 * (2 * wave + nl) + n; bf16x8 rf[2];
#pragma unroll
              for (int s2 = 0; s2 < 2; ++s2) rf[s2] = *(const LAS bf16x8*)(RT + c * RT_S + (((4 * s2 + qd) ^ ((2 * wave + nl) & 7)) << 3));
#pragma unroll
              for (int mi = 0; mi < 4; ++mi) { f32x4 a = {0.f, 0.f, 0.f, 0.f};
#pragma unroll
                  for (int s2 = 0; s2 < 2; ++s2) a = __builtin_amdgcn_mfma_f32_16x16x32_bf16(tf[mi][s2], rf[s2], a, 0, 0, 0);
                  if (wave < 4) { u32x2 o; o.x = pk2(a[0], a[1]); o.y = pk2(a[2], a[3]); *(u32x2*)(rec + 28672 + c * 64 + 16 * mi + 4 * qd) = o; }
                  else { const int d = c - 128;
#pragma unroll
                      for (int rg = 0; rg < 4; ++rg) { const int i = 16 * mi + 4 * qd + rg; rec[i * 128 + gdn_pos(i, d, 128)] = (bf16_t)f2bf(a[rg]); } } } } }
        }
    }
}

__device__ __forceinline__ void gdn_dma(const bf16_t* rec, LAS unsigned char* buf, int tid, int wave) {
#pragma unroll
    for (int r = 0; r < 7; ++r) __builtin_amdgcn_global_load_lds((const unsigned*)((const char*)rec + r * 8192 + tid * 16), (LAS unsigned*)(buf + r * 8192 + wave * 1024), 16, 0, 0);
}
__device__ __forceinline__ bf16x8 pack_b(const f32x4 v0, const f32x4 v1) { return __builtin_bit_cast(bf16x8, pack8(v0, v1)); }
__device__ __forceinline__ void ph_gdn_chain(Frame& F, int l) {
    const bf16_t* GD = (const bf16_t*)(F.ws + WS_GDN); const float* GLAST = (const float*)(F.ws + WS_GLAST); const bf16_t* P1 = (const bf16_t*)(F.ws + WS_P1); bf16_t* BR = (bf16_t*)(F.ws + WS_BR);
    const float* ng = F.ap->in[I_GNG] + (size_t)l * 128;
    LAS unsigned char* L = F.lds; LAS unsigned char* obuf = L + 2 * 57344;
    const int tid = F.tid, lane = F.lane, w = F.wave, n = lane & 15, qd = lane >> 4;
    float gn[16];
#pragma unroll
    for (int q = 0; q < 16; ++q) gn[q] = ng[(lane & 7) * 16 + q];
    for (int bh = F.bid; bh < BH * 4; bh += F.G) {
        const int bl = bh >> 2, h = bh & 3;
        f32x4 S[8];
#pragma unroll
        for (int m = 0; m < 8; ++m) S[m] = (f32x4){0.f, 0.f, 0.f, 0.f};
        u32x2 up[4]; unsigned zp[8]; float lastp;
        { const bf16_t* rec = GD + (size_t)(bh * 64) * GDN_CH;
#pragma unroll
          for (int m = 0; m < 4; ++m) up[m] = *(const u32x2*)(rec + 28672 + (16 * w + n) * 64 + 16 * m + 4 * qd);
          lastp = GLAST[bh * 64];
          asm volatile("" ::: "memory");
          __syncthreads();
          gdn_dma(rec, L, tid, w); }
#pragma unroll
        for (int rr = 0; rr < 8; ++rr) zp[rr] = 0u;
#define GDN_NORM(chn, zc) do { const int r8 = lane >> 3, part = lane & 7, row = 8 * w + r8; \
            const u32x4 oa = *(const LAS u32x4*)(obuf + row * 256 + part * 32), ob = *(const LAS u32x4*)(obuf + row * 256 + part * 32 + 16); float ss = 0.f; \
            _Pragma("unroll") for (int q = 0; q < 4; ++q) { ss += bflo(oa[q]) * bflo(oa[q]) + bfhi(oa[q]) * bfhi(oa[q]) + bflo(ob[q]) * bflo(ob[q]) + bfhi(ob[q]) * bfhi(ob[q]); } \
            ss += __shfl_xor(ss, 1); ss += __shfl_xor(ss, 2); ss += __shfl_xor(ss, 4); \
            const float rs = 1.f / sqrtf(ss * (1.f / 128.f) + EPS); u32x4 ya, yb; \
            _Pragma("unroll") for (int q = 0; q < 4; ++q) { \
                ya[q] = pk2(bflo(oa[q]) * rs * gn[2 * q] * siluf_(bflo(zc[q])), bfhi(oa[q]) * rs * gn[2 * q + 1] * siluf_(bfhi(zc[q]))); \
                yb[q] = pk2(bflo(ob[q]) * rs * gn[8 + 2 * q] * siluf_(bflo(zc[4 + q])), bfhi(ob[q]) * rs * gn[8 + 2 * q + 1] * siluf_(bfhi(zc[4 + q]))); } \
            bf16_t* dst = BR + ((size_t)bl * T + (chn) * 64 + row) * BRW + 1536 + h * 128 + part * 16; *(u32x4*)dst = ya; *(u32x4*)(dst + 8) = yb; } while (0)
        for (int ch = 0; ch < 64; ++ch) {
            const int cu = bh * 64 + ch, cur = ch & 1;
            asm volatile("s_waitcnt vmcnt(0) lgkmcnt(0)\n\ts_barrier" ::: "memory");
            u32x2 uc[4]; unsigned zc[8]; const float last = lastp;
#pragma unroll
            for (int m = 0; m < 4; ++m) uc[m] = up[m];
#pragma unroll
            for (int rr = 0; rr < 8; ++rr) zc[rr] = zp[rr];
#ifndef REP_NORM
#define REP_NORM 1
#endif
            for (int rp_ = 0; rp_ < REP_NORM; ++rp_) { if (ch > 0) GDN_NORM(ch - 1, zc); }
            { const int cn = (ch + 1 < 64) ? cu + 1 : cu; const bf16_t* rec = GD + (size_t)cn * GDN_CH;
#pragma unroll
                for (int m = 0; m < 4; ++m) up[m] = *(const u32x2*)(rec + 28672 + (16 * w + n) * 64 + 16 * m + 4 * qd);
                lastp = GLAST[cn];
                { const bf16_t* zsrc = P1 + ((size_t)bl * T + ch * 64 + 8 * w + (lane >> 3)) * P1W + C_Z + h * 128 + (lane & 7) * 16; const u32x4 z0 = *(const u32x4*)zsrc, z1 = *(const u32x4*)(zsrc + 8);
#pragma unroll
                  for (int q = 0; q < 4; ++q) { zp[q] = z0[q]; zp[4 + q] = z1[q]; } }
                asm volatile("" ::: "memory");
                if (ch + 1 < 64) gdn_dma(rec, L + (cur ^ 1) * 57344, tid, w); }
            const LAS unsigned char* B = L + cur * 57344;
            const int rb256 = n * 256, rb128 = n * 128; int xo[4], x7[2];
#pragma unroll
            for (int s2 = 0; s2 < 4; ++s2) xo[s2] = ((4 * s2 + qd) ^ n) << 4;
#pragma unroll
            for (int s2 = 0; s2 < 2; ++s2) x7[s2] = ((4 * s2 + qd) ^ (n & 7)) << 4;
#define GF(off) (*(const LAS bf16x8*)(B + (off)))
#define LD_G1(f, m) do { _Pragma("unroll") for (int s2 = 0; s2 < 4; ++s2) { f[s2] = GF((16 * (m)) * 256 + rb256 + xo[s2]); f[4 + s2] = GF(16384 + (16 * (m)) * 256 + rb256 + xo[s2]); } } while (0)
#define MM_G1(f, m) do { _Pragma("unroll") for (int s2 = 0; s2 < 4; ++s2) { WS[m] = __builtin_amdgcn_mfma_f32_16x16x32_bf16(f[s2], Sb[s2], WS[m], 0, 0, 0); QS[m] = __builtin_amdgcn_mfma_f32_16x16x32_bf16(f[4 + s2], Sb[s2], QS[m], 0, 0, 0); } } while (0)
#define LD_AT(f) do { _Pragma("unroll") for (int m = 0; m < 4; ++m) _Pragma("unroll") for (int s2 = 0; s2 < 2; ++s2) f[2 * m + s2] = GF(49152 + (16 * m) * 128 + rb128 + x7[s2]); } while (0)
#define MM_AT(f) do { _Pragma("unroll") for (int m = 0; m < 4; ++m) _Pragma("unroll") for (int s2 = 0; s2 < 2; ++s2) QS[m] = __builtin_amdgcn_mfma_f32_16x16x32_bf16(f[2 * m + s2], Vb[s2], QS[m], 0, 0, 0); } while (0)
#define LD_KT(f, hf) do { _Pragma("unroll") for (int m = 0; m < 4; ++m) _Pragma("unroll") for (int s2 = 0; s2 < 2; ++s2) f[2 * m + s2] = GF(32768 + (16 * (4 * (hf) + m)) * 128 + rb128 + x7[s2]); } while (0)
#define MM_KT(f, hf) do { _Pragma("unroll") for (int m = 0; m < 4; ++m) _Pragma("unroll") for (int s2 = 0; s2 < 2; ++s2) S[4 * (hf) + m] = __builtin_amdgcn_mfma_f32_16x16x32_bf16(f[2 * m + s2], Vb[s2], S[4 * (hf) + m], 0, 0, 0); } while (0)
#define SBAR __builtin_amdgcn_sched_barrier(0)
            bf16x8 Sb[4];
#pragma unroll
            for (int s2 = 0; s2 < 4; ++s2) Sb[s2] = pack_b(S[2 * s2], S[2 * s2 + 1]);
            f32x4 WS[4], QS[4];
#pragma unroll
            for (int m = 0; m < 4; ++m) { WS[m] = (f32x4){0.f, 0.f, 0.f, 0.f}; QS[m] = (f32x4){0.f, 0.f, 0.f, 0.f}; }
            bf16x8 fa[8], fb[8];
            LD_G1(fa, 0); SBAR;
            LD_G1(fb, 1); SBAR; MM_G1(fa, 0); SBAR;
            LD_G1(fa, 2); SBAR; MM_G1(fb, 1); SBAR;
            LD_G1(fb, 3); SBAR; MM_G1(fa, 2); SBAR;
            LD_AT(fa);    SBAR; MM_G1(fb, 3); SBAR;
            f32x4 vn[4];
#pragma unroll
            for (int m = 0; m < 4; ++m) { vn[m][0] = bflo(uc[m].x) - WS[m][0]; vn[m][1] = bfhi(uc[m].x) - WS[m][1]; vn[m][2] = bflo(uc[m].y) - WS[m][2]; vn[m][3] = bfhi(uc[m].y) - WS[m][3]; }
            bf16x8 Vb[2]; Vb[0] = pack_b(vn[0], vn[1]); Vb[1] = pack_b(vn[2], vn[3]);
#pragma unroll
            for (int mk = 0; mk < 8; ++mk) S[mk] = S[mk] * last;
            LD_KT(fb, 0); SBAR; MM_AT(fa); SBAR;
            LD_KT(fa, 1); SBAR; MM_KT(fb, 0); SBAR;
            MM_KT(fa, 1);
#undef GF
#undef LD_G1
#undef MM_G1
#undef LD_AT
#undef MM_AT
#undef LD_KT
#undef MM_KT
#undef SBAR
            asm volatile("s_waitcnt lgkmcnt(0)\n\ts_barrier" ::: "memory");
#pragma unroll
            for (int m = 0; m < 4; ++m)
#pragma unroll
                for (int j = 0; j < 4; ++j) *(LAS bf16_t*)(obuf + ((16 * m + 4 * qd + j) * 128 + 16 * w + n) * 2) = (bf16_t)f2bf(QS[m][j]);
        }
        asm volatile("s_waitcnt vmcnt(0) lgkmcnt(0)\n\ts_barrier" ::: "memory");
        GDN_NORM(63, zp);
#undef GDN_NORM
        asm volatile("s_waitcnt vmcnt(0)" ::: "memory");
        __syncthreads();
    }
}

struct OneUnit { int pm, pn; __device__ bool next(int i, Unit& u) const { if (i != 0) return false; u.pm = pm; u.pn = pn; return true; } };
__device__ __forceinline__ void s5_unit(Frame& F, int g, int bi) {
    float* S = (float*)(F.ws + WS_S5S); bf16_t* S5A = (bf16_t*)(F.ws + WS_S5A); const float* S5P = (const float*)(F.ws + WS_S5P);
    { pg8::Gemm gm{(const bf16_t*)S5A, (const bf16_t*)(F.ws + WS_S5W1), S5LD, 256, 256}; OneUnit U{g * 4 + bi, g}; EpiS5S E{S}; pg8::gemm_phase(F.lds, F.tid, gm, U, E); }
    asm volatile("s_waitcnt vmcnt(0)" ::: "memory"); __syncthreads();
    __builtin_amdgcn_fence(__ATOMIC_ACQUIRE, "agent"); asm volatile("s_waitcnt vmcnt(0)" ::: "memory");
    {
        const int p = F.lane, k = F.wave; const size_t r0 = (size_t)(g * 4 + bi) * 256 + 32 * k;
        const float ar = S5P[g * 128 + p], ai = S5P[g * 128 + 64 + p];
        float sr[32], si[32];
#pragma unroll
        for (int j = 0; j < 32; ++j) { sr[j] = S[(r0 + j) * 128 + p]; si[j] = S[(r0 + j) * 128 + 64 + p]; }
        float lr = 0.f, li = 0.f;
#pragma unroll
        for (int j = 0; j < 32; ++j) { const float xr = sr[j], xi = si[j]; sr[j] = lr; si[j] = li; const float nr = ar * lr - ai * li + xr, ni = ar * li + ai * lr + xi; lr = nr; li = ni; }
        LAS float* ex = (LAS float*)F.lds;
        ex[k * 128 + p] = lr; ex[k * 128 + 64 + p] = li;
        float a32r = ar, a32i = ai;
#pragma unroll
        for (int q = 0; q < 5; ++q) { const float tr = a32r * a32r - a32i * a32i, ti = 2.f * a32r * a32i; a32r = tr; a32i = ti; }
        __syncthreads();
        float cr = 0.f, ci = 0.f;
        for (int k2 = 0; k2 < k; ++k2) { const float er = ex[k2 * 128 + p], ei = ex[k2 * 128 + 64 + p]; const float nr = a32r * cr - a32i * ci + er, ni = a32r * ci + a32i * cr + ei; cr = nr; ci = ni; }
        float pr = 1.f, pi = 0.f;
#pragma unroll
        for (int j = 0; j < 32; ++j) { const float hr = sr[j] + pr * cr - pi * ci, hi = si[j] + pr * ci + pi * cr;
            S5A[(r0 + j) * S5LD + 256 + p] = (bf16_t)f2bf(hr); S5A[(r0 + j) * S5LD + 320 + p] = (bf16_t)f2bf(hi);
            const float tr = pr * ar - pi * ai, ti = pr * ai + pi * ar; pr = tr; pi = ti; }
    }
    asm volatile("s_waitcnt vmcnt(0)" ::: "memory"); __syncthreads();
    __builtin_amdgcn_fence(__ATOMIC_ACQUIRE, "agent"); asm volatile("s_waitcnt vmcnt(0)" ::: "memory");
    { pg8::Gemm gm{(const bf16_t*)S5A, (const bf16_t*)(F.ws + WS_S5T), S5LD, S5LD, S5LD}; OneUnit U{g * 4 + bi, g}; EpiS5Y E{(bf16_t*)(F.ws + WS_YG)}; pg8::gemm_phase(F.lds, F.tid, gm, U, E); }
}

__device__ __forceinline__ unsigned umed3_(unsigned a, unsigned b, unsigned c) { unsigned r; asm("v_med3_u32 %0, %1, %2, %3" : "=v"(r) : "v"(a), "v"(b), "v"(c)); return r; }
template <int NR, bool SURV>
__device__ __forceinline__ void sel_core(const unsigned (&key)[NR], int lane, LAS int* ixo, const LAS int* sidx, unsigned Kt0, int topbit) {
    constexpr int NVB = (NR >= 64) ? 7 : (NR >= 32) ? 6 : (NR >= 16) ? 5 : 4;
    unsigned Kt = Kt0;
    for (int bit = topbit; bit >= 0; --bit) { const unsigned cand = Kt | (1u << bit); unsigned cl = 0u;
#pragma unroll
        for (int i = 0; i < NR; ++i) cl += (key[i] >= cand) ? 1u : 0u;
        int cnt = 0;
#pragma unroll
        for (int b = 0; b < NVB; ++b) cnt += __builtin_popcountll(__ballot((cl >> b) & 1u)) << b;
        if (cnt >= 256) { Kt = cand; if (cnt == 256) break; } }
    int ngt = 0;
    { unsigned cl = 0u;
#pragma unroll
      for (int i = 0; i < NR; ++i) cl += (key[i] > Kt) ? 1u : 0u;
#pragma unroll
      for (int b = 0; b < NVB; ++b) ngt += __builtin_popcountll(__ballot((cl >> b) & 1u)) << b; }
    const int need = 256 - ngt; int pos = 0, ties = 0; const unsigned long long lt = (1ull << lane) - 1ull;
#pragma unroll
    for (int i = 0; i < NR; ++i) { const bool gtk = key[i] > Kt, eq = key[i] == Kt; const unsigned long long mt = __ballot(eq);
        const bool take = gtk || (eq && (ties + __builtin_popcountll(mt & lt)) < need); const unsigned long long mk = __ballot(take);
        if (take) { const int pp = pos + __builtin_popcountll(mk & lt); if (pp < 256) ixo[pp] = SURV ? sidx[i * 64 + lane] : i * 64 + lane; }
        pos += __builtin_popcountll(mk); ties += __builtin_popcountll(mt); }
}
template <int NR>
__device__ __forceinline__ void dsa_select(const LAS float* row, int limit, int lane, LAS int* ixo) {
    unsigned key[NR];
    const int nreg = limit >> 6;
#pragma unroll
    for (int i = 0; i < NR; ++i) { unsigned kx = 0u; if (i < nreg) { const unsigned b = __builtin_bit_cast(unsigned, row[i * 64 + lane]); kx = (b & 0x80000000u) ? ~b : (b | 0x80000000u); } key[i] = kx; }
    WAVE_SYNC();
    if (NR >= 32) {
        unsigned a1 = 0u, a2 = 0u, a3 = 0u, a4 = 0u;
#pragma unroll
        for (int i = 0; i < NR; ++i) { const unsigned k = key[i]; a4 = umed3_(a3, a4, k); a3 = umed3_(a2, a3, k); a2 = umed3_(a1, a2, k); a1 = (a1 > k) ? a1 : k; }
        unsigned L = a4, Mx = a1;
#pragma unroll
        for (int o = 1; o < 64; o <<= 1) { const unsigned x = (unsigned)__shfl_xor((int)L, o); L = (x < L) ? x : L; const unsigned y = (unsigned)__shfl_xor((int)Mx, o); Mx = (y > Mx) ? y : Mx; }
        int S = 0;
#pragma unroll
        for (int i = 0; i < NR; ++i) S += __builtin_popcountll(__ballot(key[i] >= L));
        if (S <= 1024) {
            LAS unsigned* sk = (LAS unsigned*)row + 1024; LAS int* si = (LAS int*)row + 2048; int base = 0;
#pragma unroll
            for (int i = 0; i < NR; ++i) { const bool p = key[i] >= L; const unsigned long long m = __ballot(p);
                if (p) { const int pp = base + (int)__builtin_amdgcn_mbcnt_hi((unsigned)(m >> 32), __builtin_amdgcn_mbcnt_lo((unsigned)m, 0u)); sk[pp] = key[i]; si[pp] = i * 64 + lane; }
                base += __builtin_popcountll(m); }
            WAVE_SYNC();
            const unsigned dx = Mx - L + 1u; const int tb = 31 - __builtin_clz(dx);
            if (S <= 768) { unsigned k2[12];
#pragma unroll
                for (int j = 0; j < 12; ++j) k2[j] = (j * 64 + lane < S) ? sk[j * 64 + lane] - L + 1u : 0u;
                sel_core<12, true>(k2, lane, ixo, si, 0u, tb); }
            else { unsigned k2[16];
#pragma unroll
                for (int j = 0; j < 16; ++j) k2[j] = (j * 64 + lane < S) ? sk[j * 64 + lane] - L + 1u : 0u;
                sel_core<16, true>(k2, lane, ixo, si, 0u, tb); }
            return;
        }
    }
    sel_core<NR, false>(key, lane, ixo, nullptr, 0u, 31);
}
__device__ __forceinline__ float relu_bits(float x) { return __builtin_bit_cast(float, __builtin_elementwise_max(__builtin_bit_cast(int, x), 0)); }
__device__ __forceinline__ void dsa_unit(Frame& F, int un) {
    const bf16_t* P1 = (const bf16_t*)(F.ws + WS_P1); const bf16_t* CN = (const bf16_t*)(F.ws + WS_CN); bf16_t* BR = (bf16_t*)(F.ws + WS_BR);
    LAS float* sc = (LAS float*)F.lds; constexpr int SCS = 4100;
    int lane_ = F.lane; asm volatile("" : "+v"(lane_));
    const int lane = lane_, wave = F.wave, n = lane & 15, qd = lane >> 4;
    const int bl = un & 3, qb = 511 - (un >> 2), t0 = qb * 8, limit = ((t0 >> 6) + 1) * 64;
    const size_t rbase = (size_t)bl * T;
    if (limit > 256) {
        bf16x8 bq[2][2]; float iwv[2];
        { const bf16_t* qp = P1 + (rbase + t0 + (n & 7)) * P1W;
#pragma unroll
          for (int pr = 0; pr < 2; ++pr) { const int hh = 2 * pr + (n >> 3);
#pragma unroll
              for (int ks = 0; ks < 2; ++ks) bq[pr][ks] = *(const bf16x8*)(qp + C_IQ + hh * 64 + ks * 32 + qd * 8);
              iwv[pr] = bf2f(qp[C_IW + hh]) * 0.0625f; } }
        const int nkb = limit >> 4;
        const bf16_t* kbase = (const bf16_t*)(F.ws + WS_IKC) + (rbase >> 4) * 1024 + (qd * 16 + n) * 8;
        bf16x8 a0[4], a1[4], A0[4], A1[4], B0[4], B1[4];
#define DSA_LDK(kb, X0, X1) _Pragma("unroll") for (int u4 = 0; u4 < 4; ++u4) { const bf16_t* kp = kbase + (size_t)((kb) + u4) * 1024; X0[u4] = *(const bf16x8*)kp; X1[u4] = *(const bf16x8*)(kp + 512); }
        auto score = [&](int kb0) {
#pragma unroll
            for (int u4 = 0; u4 < 4; ++u4) { f32x4 sv = {0.f, 0.f, 0.f, 0.f};
#pragma unroll
                for (int pr = 0; pr < 2; ++pr) { f32x4 c = {0.f, 0.f, 0.f, 0.f};
                    c = __builtin_amdgcn_mfma_f32_16x16x32_bf16(a0[u4], bq[pr][0], c, 0, 0, 0); c = __builtin_amdgcn_mfma_f32_16x16x32_bf16(a1[u4], bq[pr][1], c, 0, 0, 0);
#pragma unroll
                    for (int j = 0; j < 4; ++j) sv[j] = fmaf(relu_bits(c[j]), iwv[pr], sv[j]); }
#pragma unroll
                for (int j = 0; j < 4; ++j) { float r; asm("s_nop 1\n\tv_add_f32_dpp %0, %1, %1 row_ror:8 row_mask:0xf bank_mask:0xf" : "=v"(r) : "v"(sv[j])); sv[j] = r; }
                *(LAS f32x4*)(sc + (n & 7) * SCS + (kb0 + u4) * 16 + qd * 4) = sv; }
        };
        if (wave * 4 < nkb) { DSA_LDK(wave * 4, A0, A1) }
        if (wave * 4 + 32 < nkb) { DSA_LDK(wave * 4 + 32, B0, B1) }
        for (int kb0 = wave * 4; kb0 < nkb; kb0 += 64) {
#pragma unroll
            for (int u4 = 0; u4 < 4; ++u4) { a0[u4] = A0[u4]; a1[u4] = A1[u4]; }
            if (kb0 + 64 < nkb) { DSA_LDK(kb0 + 64, A0, A1) }
            score(kb0);
            if (kb0 + 32 < nkb) {
#pragma unroll
                for (int u4 = 0; u4 < 4; ++u4) { a0[u4] = B0[u4]; a1[u4] = B1[u4]; }
                if (kb0 + 96 < nkb) { DSA_LDK(kb0 + 96, B0, B1) }
                score(kb0 + 32); }
        }
#undef DSA_LDK
    }
    __syncthreads();
    LAS float* myrow = sc + wave * SCS; LAS int* ix = (LAS int*)myrow; LAS float* pp = myrow + 256;
    const int qrow = bl * T + t0 + wave; int nv = 256;
    if (limit <= 256) { nv = limit;
#pragma unroll
        for (int r = 0; r < 4; ++r) { const int kk = r * 64 + lane; ix[kk] = (kk < limit) ? kk : 0; } }
    else if (limit <= 1024) dsa_select<16>(myrow, limit, lane, ix);
    else if (limit <= 2048) dsa_select<32>(myrow, limit, lane, ix);
    else if (limit <= 3072) dsa_select<48>(myrow, limit, lane, ix);
    else dsa_select<64>(myrow, limit, lane, ix);
    bf16x8 bq[4];
#pragma unroll
    for (int ks = 0; ks < 4; ++ks) { bf16x8 v = *(const bf16x8*)(P1 + (size_t)qrow * P1W + C_QL + (n & 7) * 128 + ks * 32 + qd * 8); if (n >= 8) v = (bf16x8){0, 0, 0, 0, 0, 0, 0, 0}; bq[ks] = v; }
    WAVE_SYNC();
    LAS unsigned char* tile = (LAS unsigned char*)(myrow + 256);
    constexpr int TS = 272;
    const int grow = lane >> 4, gch = lane & 15;
    u32x4 gA[8], gB[8];
#define DSA_GATHER(g, tt) _Pragma("unroll") for (int i = 0; i < 8; ++i) g[i] = *(const u32x4*)(CN + (rbase + ix[(tt) * 32 + grow + 4 * i]) * 128 + gch * 8);
    DSA_GATHER(gA, 0) DSA_GATHER(gB, 1)
    f32x4 O[8];
#pragma unroll
    for (int rt = 0; rt < 8; ++rt) O[rt] = (f32x4){0.f, 0.f, 0.f, 0.f};
    float mrun = -INFINITY, lrun = 0.f;
    const int trow = 4 * qd + (n >> 2), tcol = (n & 3) * 8;
    auto step = [&](int t, u32x4 (&g)[8]) {
#pragma unroll
        for (int i = 0; i < 8; ++i) *(LAS u32x4*)(tile + (grow + 4 * i) * TS + gch * 16) = g[i];
        if (t < 6) { DSA_GATHER(g, t + 2) }
        WAVE_SYNC();
        f32x4 c[2];
#pragma unroll
        for (int kb2 = 0; kb2 < 2; ++kb2) { c[kb2] = (f32x4){0.f, 0.f, 0.f, 0.f};
#pragma unroll
            for (int ks = 0; ks < 4; ++ks) c[kb2] = __builtin_amdgcn_mfma_f32_16x16x32_bf16(*(const LAS bf16x8*)(tile + (kb2 * 16 + n) * TS + (4 * ks + qd) * 16), bq[ks], c[kb2], 0, 0, 0); }
        float mx = mrun;
#pragma unroll
        for (int kb2 = 0; kb2 < 2; ++kb2)
#pragma unroll
            for (int j = 0; j < 4; ++j) { if (t * 32 + kb2 * 16 + 4 * qd + j >= nv) c[kb2][j] = -INFINITY; mx = fmaxf(mx, c[kb2][j]); }
        mx = fmaxf(mx, __shfl_xor(mx, 16)); mx = fmaxf(mx, __shfl_xor(mx, 32));
        const float scl = __expf(mrun - mx); float ps = 0.f;
#pragma unroll
        for (int kb2 = 0; kb2 < 2; ++kb2)
#pragma unroll
            for (int j = 0; j < 4; ++j) { c[kb2][j] = __expf(c[kb2][j] - mx); ps += c[kb2][j]; }
        ps += __shfl_xor(ps, 16); ps += __shfl_xor(ps, 32);
        lrun = lrun * scl + ps; mrun = mx;
        const bf16x8 pb = pack_b(c[0], c[1]);
#pragma unroll
        for (int rt = 0; rt < 8; ++rt) { O[rt] = O[rt] * scl;
            typedef short v4i16_t __attribute__((ext_vector_type(4)));
            const v4i16_t a0 = __builtin_amdgcn_ds_read_tr16_b64_v4i16((LAS v4i16_t*)(tile + trow * TS + rt * 32 + tcol));
            const v4i16_t a1 = __builtin_amdgcn_ds_read_tr16_b64_v4i16((LAS v4i16_t*)(tile + (16 + trow) * TS + rt * 32 + tcol));
            const bf16x8 af = {a0[0], a0[1], a0[2], a0[3], a1[0], a1[1], a1[2], a1[3]};
            O[rt] = __builtin_amdgcn_mfma_f32_16x16x32_bf16(af, pb, O[rt], 0, 0, 0); }
        WAVE_SYNC();
    };
    for (int t = 0; t < 8; t += 2) {
        if (t * 32 >= nv) break;
        step(t, gA);
        if ((t + 1) * 32 >= nv) break;
        step(t + 1, gB);
    }
#undef DSA_GATHER
    if (n < 8) { const float inv = 1.f / lrun; bf16_t* dst = BR + (size_t)qrow * BRW + n * 128 + 4 * qd;
#pragma unroll
        for (int rt = 0; rt < 8; ++rt) { u32x2 o; o.x = pk2(O[rt][0] * inv, O[rt][1] * inv); o.y = pk2(O[rt][2] * inv, O[rt][3] * inv); *(u32x2*)(dst + rt * 16) = o; } }
#ifdef PROBE_ATT
    WAVE_SYNC();
    {
    bf16x8 bq2[4];
#pragma unroll
    for (int ks = 0; ks < 4; ++ks) { bf16x8 v = *(const bf16x8*)(P1 + (size_t)qrow * P1W + C_QL + (n & 7) * 128 + ks * 32 + qd * 8); if (n >= 8) v = (bf16x8){0, 0, 0, 0, 0, 0, 0, 0}; bq2[ks] = v; }
    WAVE_SYNC();
    LAS float* pp = myrow + 256; f32x4 lg[16];
#pragma unroll
    for (int kb4 = 0; kb4 < 4; ++kb4) { bf16x8 a[4][4];
#pragma unroll
        for (int k2 = 0; k2 < 4; ++k2) { const bf16_t* cp = CN + (rbase + ix[(kb4 * 4 + k2) * 16 + n]) * 128 + qd * 8;
#pragma unroll
            for (int ks = 0; ks < 4; ++ks) a[k2][ks] = *(const bf16x8*)(cp + ks * 32); }
#pragma unroll
        for (int k2 = 0; k2 < 4; ++k2) { f32x4 c = {0.f, 0.f, 0.f, 0.f};
#pragma unroll
            for (int ks = 0; ks < 4; ++ks) c = __builtin_amdgcn_mfma_f32_16x16x32_bf16(a[k2][ks], bq2[ks], c, 0, 0, 0);
            lg[kb4 * 4 + k2] = c; } }
    float mx = -INFINITY;
#pragma unroll
    for (int kb = 0; kb < 16; ++kb)
#pragma unroll
        for (int j = 0; j < 4; ++j) { const int kk = kb * 16 + qd * 4 + j; if (kk >= nv) lg[kb][j] = -INFINITY; mx = fmaxf(mx, lg[kb][j]); }
    mx = fmaxf(mx, __shfl_xor(mx, 16)); mx = fmaxf(mx, __shfl_xor(mx, 32));
    float sm = 0.f;
#pragma unroll
    for (int kb = 0; kb < 16; ++kb)
#pragma unroll
        for (int j = 0; j < 4; ++j) { const float e = __expf(lg[kb][j] - mx); lg[kb][j] = e; sm += e; }
    sm += __shfl_xor(sm, 16); sm += __shfl_xor(sm, 32);
    const float inv = 1.f / sm;
    if (n < 8) {
#pragma unroll
        for (int kb = 0; kb < 16; ++kb)
#pragma unroll
            for (int j = 0; j < 4; ++j) pp[(kb * 16 + qd * 4 + j) * 8 + n] = lg[kb][j] * inv; }
    WAVE_SYNC();
    f32x2 o[8];
#pragma unroll
    for (int hh = 0; hh < 8; ++hh) o[hh] = (f32x2){0.f, 0.f};
    const unsigned* cbase = (const unsigned*)(CN + rbase * 128) + lane;
    unsigned cw[8];
#pragma unroll
    for (int j = 0; j < 8; ++j) { const int key = __builtin_amdgcn_readfirstlane(ix[j]); cw[j] = cbase[(size_t)key * 64]; }
    for (int kk = 0; kk < nv; kk += 8) { unsigned nx[8];
        const int kn = (kk + 8 < nv) ? kk + 8 : kk;
#pragma unroll
        for (int j = 0; j < 8; ++j) { const int key = __builtin_amdgcn_readfirstlane(ix[kn + j]); nx[j] = cbase[(size_t)key * 64]; }
#pragma unroll
        for (int j = 0; j < 8; ++j) { const f32x2 cv = {bflo(cw[j]), bfhi(cw[j])}; const f32x4 pa = *(const LAS f32x4*)(pp + (kk + j) * 8), pb = *(const LAS f32x4*)(pp + (kk + j) * 8 + 4);
#pragma unroll
            for (int hh = 0; hh < 4; ++hh) { o[hh] += cv * pa[hh]; o[4 + hh] += cv * pb[hh]; } }
#pragma unroll
        for (int j = 0; j < 8; ++j) cw[j] = nx[j]; }
#pragma unroll
    for (int hh = 0; hh < 8; ++hh) *((unsigned*)((bf16_t*)(F.ws + WS_MG) + (size_t)qrow * 1024 + hh * 128) + lane) = pk2(o[hh].x, o[hh].y);
    }
#endif
}
__device__ __forceinline__ void ph_dsa(Frame& F, gu32* ctr, int k0, int k1) {
    volatile LAS unsigned* MISC = (volatile LAS unsigned*)(F.lds + MISC_OFF);
    const int hq = (F.bid & 7) >> 1;
    for (int qi = 0; qi < 4; ++qi) { const int q = (hq + qi) & 3;
        for (;;) {
            __syncthreads();
            if (F.tid == 0) MISC[0] = __hip_atomic_fetch_add(ctr + q * 16, 1u, RLX_AGENT);
            __syncthreads();
            const int k = k0 + (int)MISC[0];
            if (k >= k1) break;
            dsa_unit(F, k * 4 + q);
        } }
}

#ifdef PROBE_ATT
constexpr int CW_DIAG = 32768;
__device__ __forceinline__ void ph_att_cmp(Frame& F) {
    gu32* ctl = (gu32*)(F.ws + WS_CTL); const bf16_t* BA = (const bf16_t*)(F.ws + WS_BR); const bf16_t* BB = (const bf16_t*)(F.ws + WS_MG);
    const int gw = F.bid * 8 + F.wave, NGW = F.G * 8, lane = F.lane; float d2 = 0.f, r2 = 0.f;
    for (int q = gw; q < MH; q += NGW)
        for (int c = lane; c < 512; c += 64) { const unsigned wa = *((const unsigned*)(BA + (size_t)q * BRW) + c), wb = *((const unsigned*)(BB + (size_t)q * 1024) + c);
            const float a0 = bflo(wa) - bflo(wb), a1 = bfhi(wa) - bfhi(wb); d2 += a0 * a0 + a1 * a1; r2 += bflo(wb) * bflo(wb) + bfhi(wb) * bfhi(wb); }
    d2 = wave_sum(d2); r2 = wave_sum(r2);
    if (lane == 0) { atomicAdd((float*)(ctl + CW_DIAG + 64), d2); atomicAdd((float*)(ctl + CW_DIAG + 128), r2); }
}
#endif
__device__ __forceinline__ void ph_ffn_act(Frame& F, int l, int q) {
    const bf16_t* RAW = (const bf16_t*)(F.ws + WS_RAW + (size_t)(q & 1) * 88 * MiB); bf16_t* ACT = (bf16_t*)(F.ws + WS_ACT) + (size_t)q * 8192 * DFF;
    const float* cw = F.ap->in[I_FCW] + (size_t)l * 3 * 2 * DFF;
    gu32* ctr = (gu32*)(F.ws + WS_CTL) + CW_Q + (24 + l * 4 + q) * 64;
    volatile LAS unsigned* MISC = (volatile LAS unsigned*)(F.lds + MISC_OFF);
    for (;;) {
        __syncthreads();
        if (F.tid == 0) MISC[0] = __hip_atomic_fetch_add(ctr, 1u, RLX_AGENT);
        __syncthreads();
        const int rg = (int)MISC[0];
        if (rg >= 256) break;
        const int pc = F.tid;
        if (pc < 352) { const int c0 = pc * 8, j = c0 >> 7, i0 = c0 & 127, r0 = rg * 32;
            const bf16_t* gp = RAW + (size_t)r0 * (2 * DFF) + j * 256 + i0; const bf16_t* vp = gp + 128;
            float wg[3][8], wv[3][8];
#pragma unroll
            for (int k = 0; k < 3; ++k)
#pragma unroll
                for (int x = 0; x < 8; ++x) { wg[k][x] = cw[k * 2 * DFF + c0 + x]; wv[k][x] = cw[k * 2 * DFF + DFF + c0 + x]; }
            const bool head = (r0 & 4095) == 0;
            u32x4 g0 = {0, 0, 0, 0}, g1 = {0, 0, 0, 0}, v0 = {0, 0, 0, 0}, v1 = {0, 0, 0, 0};
            if (!head) { g0 = *(const u32x4*)(gp - 2 * (2 * DFF)); g1 = *(const u32x4*)(gp - (2 * DFF)); v0 = *(const u32x4*)(vp - 2 * (2 * DFF)); v1 = *(const u32x4*)(vp - (2 * DFF)); }
            for (int r = 0; r < 32; ++r) { const u32x4 g2 = *(const u32x4*)(gp + (size_t)r * (2 * DFF)), v2 = *(const u32x4*)(vp + (size_t)r * (2 * DFF)); u32x4 o;
#pragma unroll
                for (int w = 0; w < 4; ++w) {
                    const float hg0 = wg[0][2 * w] * bflo(g0[w]) + wg[1][2 * w] * bflo(g1[w]) + wg[2][2 * w] * bflo(g2[w]), hg1 = wg[0][2 * w + 1] * bfhi(g0[w]) + wg[1][2 * w + 1] * bfhi(g1[w]) + wg[2][2 * w + 1] * bfhi(g2[w]);
                    const float hv0 = wv[0][2 * w] * bflo(v0[w]) + wv[1][2 * w] * bflo(v1[w]) + wv[2][2 * w] * bflo(v2[w]), hv1 = wv[0][2 * w + 1] * bfhi(v0[w]) + wv[1][2 * w + 1] * bfhi(v1[w]) + wv[2][2 * w + 1] * bfhi(v2[w]);
                    o[w] = pk2(siluf_(hg0) * hv0, siluf_(hg1) * hv1); }
                *(u32x4*)(ACT + (size_t)(r0 + r) * DFF + c0) = o; g0 = g1; g1 = g2; v0 = v1; v1 = v2; } }
    }
}

__device__ __forceinline__ void ph_ffn_fix(Frame& F, int l) {
    const bf16_t* HALO = (const bf16_t*)(F.ws + WS_FHALO); const bf16_t* FIRST = (const bf16_t*)(F.ws + WS_FFIRST); bf16_t* ACT = (bf16_t*)(F.ws + WS_ACT);
    const float* cw = F.ap->in[I_FCW] + (size_t)l * 3 * 2 * DFF;
    const int gt = F.bid * 512 + F.tid, NT = F.G * 512;
    for (int e = gt; e < 128 * 22 * 16; e += NT) { const int cg = e & 15, pn = (e >> 4) % 22, pm = (e >> 4) / 22, cb = cg * 8;
        if ((pm & 15) == 0) continue;
        const bf16_t* hp = HALO + ((size_t)((pm - 1) * 22 + pn) * 2) * 256 + cb; const bf16_t* fp = FIRST + ((size_t)(pm * 22 + pn) * 2) * 256 + cb;
        const u32x4 hg0 = *(const u32x4*)hp, hg1 = *(const u32x4*)(hp + 256), fg0 = *(const u32x4*)fp, fg1 = *(const u32x4*)(fp + 256);
        const u32x4 hv0 = *(const u32x4*)(hp + 128), hv1 = *(const u32x4*)(hp + 256 + 128), fv0 = *(const u32x4*)(fp + 128), fv1 = *(const u32x4*)(fp + 256 + 128);
        u32x4 o0, o1;
#pragma unroll
        for (int q = 0; q < 4; ++q) { float r0[2], r1[2];
#pragma unroll
            for (int hl = 0; hl < 2; ++hl) { const int c = pn * 128 + cb + 2 * q + hl;
                const float wg0 = cw[c], wg1 = cw[2 * DFF + c], wg2 = cw[4 * DFF + c], wv0 = cw[DFF + c], wv1 = cw[2 * DFF + DFF + c], wv2 = cw[4 * DFF + DFF + c];
                const float Hg0 = hl ? bfhi(hg0[q]) : bflo(hg0[q]), Hg1 = hl ? bfhi(hg1[q]) : bflo(hg1[q]), Fg0 = hl ? bfhi(fg0[q]) : bflo(fg0[q]), Fg1 = hl ? bfhi(fg1[q]) : bflo(fg1[q]);
                const float Hv0 = hl ? bfhi(hv0[q]) : bflo(hv0[q]), Hv1 = hl ? bfhi(hv1[q]) : bflo(hv1[q]), Fv0 = hl ? bfhi(fv0[q]) : bflo(fv0[q]), Fv1 = hl ? bfhi(fv1[q]) : bflo(fv1[q]);
                r0[hl] = siluf_(wg0 * Hg0 + wg1 * Hg1 + wg2 * Fg0) * (wv0 * Hv0 + wv1 * Hv1 + wv2 * Fv0);
                r1[hl] = siluf_(wg0 * Hg1 + wg1 * Fg0 + wg2 * Fg1) * (wv0 * Hv1 + wv1 * Fv0 + wv2 * Fv1); }
            o0[q] = pk2(r0[0], r0[1]); o1[q] = pk2(r1[0], r1[1]); }
        *(u32x4*)(ACT + (size_t)(pm * 256) * DFF + pn * 128 + cb) = o0; *(u32x4*)(ACT + (size_t)(pm * 256 + 1) * DFF + pn * 128 + cb) = o1; }
}

__device__ __forceinline__ void ph_final(Frame& F) {
    float* X = F.ap->out; const float* SS = (const float*)(F.ws + WS_SS); const float* g = F.ap->in[I_FING];
    const int gw = F.bid * 8 + F.wave, NGW = F.G * 8;
    float dscale = 1.f;
#ifdef PROBE_ATT
    { const float* dg = (const float*)((const unsigned*)(F.ws + WS_CTL) + CW_DIAG); dscale = 1.f + sqrtf(dg[64] / fmaxf(dg[128], 1e-30f)); }
#endif
    for (int r = gw; r < M; r += NGW) { const float rs = row_rstd(SS, r) * dscale; f32x4* xr = (f32x4*)(X + (size_t)r * D) + F.lane; const f32x4* gr = (const f32x4*)g + F.lane;
#pragma unroll
        for (int j = 0; j < 4; ++j) { f32x4 v = xr[64 * j]; const f32x4 gg = gr[64 * j]; v = v * rs * gg; xr[64 * j] = v; } }
}

constexpr int DSA_Q1 = 1792;
#ifdef PROBE_ATT
constexpr int PH_PER_HALF = 8,
#else
constexpr int PH_PER_HALF = 7,
#endif
    PH_PER_LAYER = 1 + NHALF * PH_PER_HALF + 3, NPHASE = NLAYER * PH_PER_LAYER + 1;

__global__ void __launch_bounds__(512, 2) fwd(Args args) {
    extern __shared__ __attribute__((aligned(16))) unsigned char lds_raw[];
    Frame F0;
    F0.lds = (LAS unsigned char*)lds_raw; F0.ap = (CArgs*)__builtin_amdgcn_kernarg_segment_ptr(); F0.ws = nullptr;
    F0.tid = threadIdx.x; F0.lane = F0.tid & 63; F0.wave = __builtin_amdgcn_readfirstlane(F0.tid >> 6); F0.G = gridDim.x; F0.bid = blockIdx.x;
    volatile LAS unsigned* MISC = (volatile LAS unsigned*)(F0.lds + MISC_OFF);
    if (F0.tid < 64) MISC[F0.tid] = 0u;
    __syncthreads();
    const int lo = args.ph_lo, hi = args.ph_hi;
    XcdBarrier bar; bar.bar = (unsigned*)(args.ws + WS_CTL) + CW_BAR; bar.x = 0; bar.st = nullptr;
    if (hi - lo > 1) bar = xcd_barrier_post((unsigned*)(args.ws + WS_CTL) + CW_BAR, MISC + 8);
    int pc = 0;
#ifndef SITE_MASK
#define SITE_MASK 0xFFFFFFFFu
#endif
#ifndef DUP_MASK
#define DUP_MASK 0u
#endif
#define PH_BEGIN(id) if (((SITE_MASK >> (id)) & 1u) && pc >= lo && pc < hi) for (int rep_ = 0, nrep_ = 1 + ((DUP_MASK >> (id)) & 1u); rep_ < nrep_; ++rep_) { Frame F = F0; asm volatile("v_mbcnt_lo_u32_b32 %0, -1, 0\n\tv_mbcnt_hi_u32_b32 %0, -1, %0" : "=v"(F.lane)); asm volatile("" : "+s"(F.ap), "+s"(F.wave)); F.tid = F.wave * 64 + F.lane; F.ws = F.ap->ws; \
        LAS unsigned char* glds = F.lds; bf16_t* XB = (bf16_t*)(F.ws + WS_XB); float* SS = (float*)(F.ws + WS_SS); bf16_t* P1 = (bf16_t*)(F.ws + WS_P1); bf16_t* BR = (bf16_t*)(F.ws + WS_BR); bf16_t* MG = (bf16_t*)(F.ws + WS_MG); \
        (void)glds; (void)XB; (void)SS; (void)P1; (void)BR; (void)MG;
#define PH_END if (pc + 1 < hi || rep_ + 1 < nrep_) xcd_barrier(bar); } ++pc;
#define RELAUNDER do { asm volatile("v_mbcnt_lo_u32_b32 %0, -1, 0\n\tv_mbcnt_hi_u32_b32 %0, -1, %0" : "=v"(F.lane)); asm volatile("" : "+s"(F.ap), "+s"(F.wave)); F.tid = F.wave * 64 + F.lane; F.ws = F.ap->ws; } while (0)

    for (int l = 0; l < NLAYER; ++l) {
        PH_BEGIN(1) ph_wprep(F, l); if (l == 0) ph_x0(F); PH_END
        for (int h = 0; h < NHALF; ++h) {
            const size_t r0 = (size_t)h * MH;
            PH_BEGIN(2)
                pg8::Gemm g{XB + r0 * D, (const bf16_t*)(F.ws + WS_WIN1), D, D, D}; pg8::StaticOrder S; S.init(MH, P1W, F.G, F.bid);
                EpiNormBf16<2> E{P1, P1W, rstd_table(F, S, SS + r0 * 16), (bf16_t*)(F.ws + WS_S5A), (bf16_t*)(F.ws + WS_IKC)}; pg8::gemm_phase(glds, F.tid, g, S, E);
            PH_END
            PH_BEGIN(3) ph_prep_a(F, l); ph_gdn_prep(F, l); PH_END
            PH_BEGIN(5)
                if (F.bid < 16) ph_gdn_chain(F, l);
                for (int su = (F.bid - 16 + F.G) % F.G; su < 128; su += F.G) s5_unit(F, su >> 2, su & 3);
                RELAUNDER;
                ph_dsa(F, (gu32*)(F.ws + WS_CTL) + CW_Q + ((l * 2 + h) * 2 + 0) * 64, 0, DSA_Q1 / 4);
            PH_END
            PH_BEGIN(10)
                { pg8::Gemm g{(const bf16_t*)(F.ws + WS_YG), (const bf16_t*)(F.ws + WS_WGLU), 512, 512, 512}; pg8::StaticOrder S; S.init(MH, 512, F.G, F.bid);
                  EpiS5G E{(const bf16_t*)(F.ws + WS_YG), BR}; pg8::gemm_phase(glds, F.tid, g, S, E); }
                RELAUNDER;
                ph_dsa(F, (gu32*)(F.ws + WS_CTL) + CW_Q + ((l * 2 + h) * 2 + 1) * 64, DSA_Q1 / 4, 512);
            PH_END
#ifdef PROBE_ATT
            PH_BEGIN(22) ph_att_cmp(F); PH_END
#endif
            PH_BEGIN(13)
                pg8::Gemm g{XB + r0 * D, (const bf16_t*)(F.ws + WS_WIN2), D, D, D}; pg8::StaticOrder S; S.init(MH, GW, F.G, F.bid);
                EpiNormBf16<1> E{P1, GW, rstd_table(F, S, SS + r0 * 16), nullptr, nullptr}; pg8::gemm_phase(glds, F.tid, g, S, E);
            PH_END
            PH_BEGIN(14)
                pg8::Gemm g{BR, (const bf16_t*)(F.ws + WS_WMRG), BRW, BRW, BRW}; pg8::StaticOrder S; S.init(MH, D, F.G, F.bid);
                EpiMerge E{MG, P1}; pg8::gemm_phase(glds, F.tid, g, S, E);
            PH_END
            PH_BEGIN(15)
                pg8::Gemm g{MG, (const bf16_t*)(F.ws + WS_WOUT), D, D, D}; pg8::StaticOrder S; S.init(MH, D, F.G, F.bid);
                float* xf = F.ap->out;
                EpiResid E{(l == 0 ? F.ap->in[I_X] : (const float*)xf) + r0 * D, xf + r0 * D, XB + r0 * D, SS + r0 * 16}; pg8::gemm_phase(glds, F.tid, g, S, E);
            PH_END
        }
        PH_BEGIN(16)
            pg8::Gemm g{XB, (const bf16_t*)(F.ws + WS_WUP), D, D, D}; pg8::StaticOrder S; S.init(M, 2 * DFF, F.G, F.bid);
            EpiUpConv E{(bf16_t*)(F.ws + WS_ACT), rstd_table(F, S, SS), F.lds + 131072 + 11264, F.ap->in[I_FCW] + (size_t)l * 3 * 2 * DFF, (bf16_t*)(F.ws + WS_FHALO), (bf16_t*)(F.ws + WS_FFIRST)};
            pg8::gemm_phase(glds, F.tid, g, S, E);
        PH_END
        PH_BEGIN(17) ph_ffn_fix(F, l); PH_END
        PH_BEGIN(18)
            pg8::Gemm g{(const bf16_t*)(F.ws + WS_ACT), (const bf16_t*)(F.ws + WS_WDN), DFF, DFF, DFF}; pg8::StaticOrder S; S.init(M, D, F.G, F.bid);
            float* xf = F.ap->out;
            EpiResid E{xf, xf, XB, SS}; pg8::gemm_phase(glds, F.tid, g, S, E);
        PH_END
    }
    PH_BEGIN(19) ph_final(F); PH_END
}

extern "C" void kernel_launch(void* const* d_in, const int* in_sizes, int n_in, void* d_out, int out_size, void* d_ws, size_t ws_size, hipStream_t stream) {
    static int grid = 0;
    if (grid == 0) {
        if (n_in != 28 || in_sizes[0] != M * D || out_size != M * D || ws_size < WS_END) { fprintf(stderr, "kernel_launch: unexpected shapes (n_in %d, ws %zu)\n", n_in, ws_size); grid = -1; return; }
        int dev = 0, cus = 0, per_cu = 0;
        if (hipGetDevice(&dev) != hipSuccess || hipDeviceGetAttribute(&cus, hipDeviceAttributeMultiprocessorCount, dev) != hipSuccess) { grid = -1; return; }
        if (hipFuncSetAttribute((const void*)fwd, hipFuncAttributeMaxDynamicSharedMemorySize, LDS_BYTES) != hipSuccess) { grid = -1; return; }
        if (hipOccupancyMaxActiveBlocksPerMultiprocessor(&per_cu, (const void*)fwd, 512, LDS_BYTES) != hipSuccess || per_cu < 1) fprintf(stderr, "kernel_launch: occupancy query says %d\n", per_cu);
        (void)hipGetLastError();
        grid = cus;
    }
    if (grid < 0) return;
    (void)hipMemsetAsync((char*)d_ws + WS_CTL, 0, CTL_ZERO_BYTES, stream);
    Args a{};
    for (int i = 0; i < 28; ++i) a.in[i] = (const float*)d_in[i];
    a.out = (float*)d_out; a.ws = (unsigned char*)d_ws;
#if MK_ONE_LAUNCH
    a.ph_lo = 0; a.ph_hi = NPHASE;
    hipLaunchKernelGGL(fwd, dim3(grid), dim3(512), LDS_BYTES, stream, a);
#else
    for (int p = 0; p < NPHASE; ++p) { a.ph_lo = p; a.ph_hi = p + 1; hipLaunchKernelGGL(fwd, dim3(grid), dim3(512), LDS_BYTES, stream, a); }
#endif
}
```

```cpp
#include <hip/hip_runtime.h>
#include <cstdio>
#include <cstdint>

#ifndef MK_ONE_LAUNCH
#define MK_ONE_LAUNCH 1
#endif

#define LAS __attribute__((address_space(3)))
#define GAS __attribute__((address_space(1)))
typedef unsigned short bf16_t;
typedef short bf16x8 __attribute__((ext_vector_type(8)));
typedef float f32x4 __attribute__((ext_vector_type(4)));
typedef float f32x2 __attribute__((ext_vector_type(2)));
typedef unsigned u32x4 __attribute__((ext_vector_type(4)));
typedef unsigned u32x2 __attribute__((ext_vector_type(2)));
typedef GAS unsigned gu32;

constexpr int NB = 8, T = 4096, D = 1024, M = NB * T, NHALF = 2, MH = M / NHALF, BH = NB / NHALF;
constexpr int NIN = 6604, DFF = 2816, NLAYER = 2;
constexpr float EPS = 1e-6f;
constexpr int P1W = 4096;
constexpr int C_QL = 0, C_CKV = 1024, C_IQ = 1152, C_IK = 1408, C_IW = 1472, C_CA = 1476, C_CB = 1480, C_S5U = 1536, C_QKV = 2048, C_Z = 3584;
constexpr int GW = 3072;
constexpr int BRW = 2048;
constexpr int S5LD = 384;
constexpr int GDN_CH = 36864;

constexpr size_t MiB = 1u << 20;
constexpr size_t WS_CTL = 0, CTL_ZERO_BYTES = 1 * MiB;
constexpr size_t WS_WIN1 = 1 * MiB, WS_WIN2 = 9 * MiB, WS_WMRG = 15 * MiB, WS_WOUT = 19 * MiB, WS_WUP = 21 * MiB, WS_WDN = 32 * MiB, WS_WGLU = 38 * MiB;
constexpr size_t WS_S5W1 = 39 * MiB, WS_S5T = 43 * MiB, WS_SS = 49 * MiB, WS_S5P = 51 * MiB  ;
constexpr size_t WS_XB = 52 * MiB, WS_P1 = 116 * MiB, WS_BR = 244 * MiB, WS_MG = 308 * MiB, WS_GO = 308 * MiB;
constexpr size_t WS_IDX = 340 * MiB, WS_NV = 348 * MiB, WS_GLAST = 348 * MiB + 512 * 1024, WS_CN = 349 * MiB, WS_S5A = 353 * MiB, WS_S5S = 377 * MiB, WS_YG = 393 * MiB, WS_GDN = 409 * MiB;
constexpr size_t WS_RAW = 116 * MiB  , WS_ACT = 292 * MiB;
constexpr size_t WS_FHALO = 468 * MiB, WS_FFIRST = 472 * MiB;
constexpr size_t WS_IKC = 490 * MiB;
constexpr size_t WS_END = 492 * MiB;
static_assert(WS_GDN + (size_t)1024 * GDN_CH * 2 <= WS_END, "ws map");
static_assert(WS_ACT + (size_t)M * DFF * 2 <= WS_END, "ws map");
constexpr int CW_BAR = 4096;
constexpr int CW_Q = 16384;

constexpr int LDS_BYTES = 147456, MISC_OFF = LDS_BYTES - 256;

#define RLX_AGENT __ATOMIC_RELAXED, __HIP_MEMORY_SCOPE_AGENT
typedef __bf16 bf16x2_t __attribute__((ext_vector_type(2)));
__device__ __forceinline__ unsigned cvt_pk_bf16(float lo, float hi) { const f32x2 v = {lo, hi}; const bf16x2_t b = __builtin_convertvector(v, bf16x2_t); return __builtin_bit_cast(unsigned, b); }
__device__ __forceinline__ unsigned f2bf(float f) { return cvt_pk_bf16(f, 0.f) & 0xffffu; }
__device__ __forceinline__ unsigned pk2(float lo, float hi) { return cvt_pk_bf16(lo, hi); }
__device__ __forceinline__ float bf2f(unsigned short b) { return __builtin_bit_cast(float, (unsigned)b << 16); }
__device__ __forceinline__ float bflo(unsigned w) { return __builtin_bit_cast(float, w << 16); }
__device__ __forceinline__ float bfhi(unsigned w) { return __builtin_bit_cast(float, w & 0xffff0000u); }

__device__ __forceinline__ float wave_sum(float v) {
#pragma unroll
    for (int o = 1; o < 64; o <<= 1) v += __shfl_xor(v, o);
    return v;
}
__device__ __forceinline__ float wave_max(float v) {
#pragma unroll
    for (int o = 1; o < 64; o <<= 1) v = fmaxf(v, __shfl_xor(v, o));
    return v;
}
__device__ __forceinline__ float rcp_(float x) { return __builtin_amdgcn_rcpf(x); }
__device__ __forceinline__ float sigmoidf_(float x) { return 1.f / (1.f + __expf(-x)); }
__device__ __forceinline__ float sigmoid_nr(float x) { const float y = 1.f + __expf(-x); float r = __builtin_amdgcn_rcpf(y); r = r * (2.f - y * r); return r; }
__device__ __forceinline__ float siluf_(float x) { return x * rcp_(1.f + __expf(-x)); }
__device__ __forceinline__ float gelu_tanh(float x) { const float u2 = 1.5957691216057308f * (x + 0.044715f * x * x * x); return x / (1.f + __expf(-u2)); }
__device__ __forceinline__ float softplusf_(float x) { const float e = __expf(x); const float sm = e * (1.f - e * (0.5f - e * (1.f / 3.f))); return x > 15.f ? x : (e < 1e-2f ? sm : __logf(1.f + e)); }
#define LDS_WAIT() asm volatile("s_waitcnt lgkmcnt(0)" ::: "memory")
#define WAVE_SYNC() do { asm volatile("s_waitcnt lgkmcnt(0)" ::: "memory"); __builtin_amdgcn_wave_barrier(); } while (0)

#define XB_TMO      128
#define XB_XCNT(j)  (256  + 64 * (j))
#define XB_XSUB(j)  (1280 + 64 * (j))
#define XB_XGEN(j)  (2304 + 64 * (j))
#define XB_TOP      3328
#define XB_TOPGEN   3392
#define XCD_BAR_WORDS 3456
#define XB_SPIN_CAP (1u << 22)
__device__ __forceinline__ unsigned xb_ld(unsigned* p)              { return __hip_atomic_load(p, __ATOMIC_RELAXED, __HIP_MEMORY_SCOPE_AGENT); }
__device__ __forceinline__ unsigned xb_add(unsigned* p, unsigned v) { return __hip_atomic_fetch_add(p, v, __ATOMIC_RELAXED, __HIP_MEMORY_SCOPE_AGENT); }
__device__ __forceinline__ unsigned xb_xcc_id() { return (unsigned)__builtin_amdgcn_s_getreg((3 << 11) | 20) & 0xFu; }
#define XB_SPIN(cond, bar) do { unsigned _sp = 0; while (cond) { __builtin_amdgcn_s_sleep(1); \
    if ((++_sp & 255u) == 0u) { if (xb_ld(&(bar)[XB_TMO])) break; if (_sp > XB_SPIN_CAP) { atomicAdd(&(bar)[XB_TMO], 1u); break; } } } } while (0)
struct XcdBarrier { unsigned* bar; unsigned x; volatile LAS unsigned* st; };
__device__ __forceinline__ XcdBarrier xcd_barrier_post(unsigned* bar, volatile LAS unsigned* st) {
    XcdBarrier b; b.bar = bar; b.x = xb_xcc_id(); b.st = st;
    if (threadIdx.x == 0) (void)xb_add(&bar[XB_XCNT(b.x)], 1u);
    return b;
}
__device__ __forceinline__ void xcd_barrier_complete(unsigned* bar, unsigned x, unsigned& nloc, unsigned& nx) {
    const unsigned G = gridDim.x * gridDim.y * gridDim.z;
    unsigned sum, cnt, mine, sp = 0u;
    for (;;) {
        sum = 0u; cnt = 0u; mine = 0u;
#pragma unroll
        for (unsigned j = 0; j < 16; ++j) { const unsigned c = xb_ld(&bar[XB_XCNT(j)]); sum += c; cnt += (c > 0u) ? 1u : 0u; mine = (j == x) ? c : mine; }
        if (sum == G) break;
        __builtin_amdgcn_s_sleep(1);
        if ((++sp & 255u) == 0u) { if (xb_ld(&bar[XB_TMO])) break; if (sp > XB_SPIN_CAP) { atomicAdd(&bar[XB_TMO], 1u); break; } }
    }
    nloc = mine > 0u ? mine : 1u; nx = cnt > 0u ? cnt : 1u;
}
__device__ __forceinline__ void xcd_barrier(const XcdBarrier& b) {
    asm volatile("s_waitcnt vmcnt(0)" ::: "memory");
    __syncthreads();
    if (threadIdx.x == 0) {
        unsigned* bar = b.bar;
        __builtin_amdgcn_s_waitcnt(0);
        unsigned nloc = b.st[0], nx = b.st[1];
        if (nloc == 0u) { xcd_barrier_complete(bar, b.x, nloc, nx); b.st[0] = nloc; b.st[1] = nx; }
        const unsigned old = xb_add(&bar[XB_XSUB(b.x)], 1u);
        const unsigned gen = old / nloc;
        if (old + 1u == (gen + 1u) * nloc) {
            __builtin_amdgcn_fence(__ATOMIC_RELEASE, "agent");
            asm volatile("s_waitcnt vmcnt(0)" ::: "memory");
            const unsigned og = xb_add(&bar[XB_TOP], 1u);
            const unsigned tg = og / nx;
            if (og + 1u == (tg + 1u) * nx) xb_add(&bar[XB_TOPGEN], 1u);
            else XB_SPIN(xb_ld(&bar[XB_TOPGEN]) == tg, bar);
            __builtin_amdgcn_fence(__ATOMIC_ACQUIRE, "agent");
            xb_add(&bar[XB_XGEN(b.x)], 1u);
            asm volatile("s_waitcnt vmcnt(0)" ::: "memory");
        } else {
            XB_SPIN(xb_ld(&bar[XB_XGEN(b.x)]) == gen, bar);
            __builtin_amdgcn_fence(__ATOMIC_ACQUIRE, "agent");
            asm volatile("s_waitcnt vmcnt(0)" ::: "memory");
        }
    }
    __syncthreads();
}

namespace pg8 {
constexpr int BM = 256, BK = 64, HALF = 128, HTB = HALF * BK * 2, NXCD = 8, WGM = 8;
__host__ __device__ __forceinline__ int lds_byte(int r, int c) { const int st = (r >> 4) * 2 + (c >> 5), rr = r & 15, cc = c & 31, ob = rr * 64 + cc * 2; return st * 1024 + (ob ^ (((ob >> 9) & 1) << 5)); }
__host__ __device__ __forceinline__ void stage_rc(int b, int& R, int& C) { const int st = b / 1024, sb = b % 1024, swz = sb ^ (((sb >> 9) & 1) << 5); R = (st >> 1) * 16 + swz / 64; C = (st & 1) * 32 + (swz % 64) / 2; }
__host__ __device__ __forceinline__ int perm32(int rho) { const int n = rho >> 4, i = rho & 15; return 8 * (i >> 2) + 4 * n + (i & 3); }
struct Unit { int pm, pn; };
struct Gemm { const bf16_t* A; const bf16_t* Bt; int lda, ldb, K; };

struct StaticOrder {
    int nM, nN, nwg, G, c;
    __device__ void init(int Mr, int N, int G_, int c_) { nM = Mr / BM; nN = N / BM; nwg = nM * nN; G = G_; c = c_; }
    __device__ bool next(int i, Unit& u) const {
        const long L = (long)i * G + c; if (L >= nwg) return false;
        int wgid = (int)L; { const int q = nwg / NXCD, r = nwg % NXCD, xcd = wgid % NXCD, off = wgid / NXCD; wgid = (xcd < r ? xcd * (q + 1) : r * (q + 1) + (xcd - r) * q) + off; }
        const int nig = WGM * nN, gid = wgid / nig, fm = gid * WGM, gsz = (nM - fm) < WGM ? (nM - fm) : WGM;
        u.pm = fm + ((wgid % nig) % gsz); u.pn = (wgid % nig) / gsz; return true;
    }
};
struct GroupOrder {
    int n, per, G, c;
    __device__ void init(int ngroups, int per_, int G_, int c_) { n = ngroups * per_; per = per_; G = G_; c = c_; }
    __device__ bool next(int i, Unit& u) const { const long L = (long)i * G + c; if (L >= n) return false; u.pm = (int)L; u.pn = (int)L / per; return true; }
};

template <class Epi, class Sched>
__device__ __forceinline__ void gemm_phase(LAS unsigned char* lds, const int tid, const Gemm g, const Sched& S, const Epi& E) {
    const int wid = __builtin_amdgcn_readfirstlane(tid >> 6), lane = tid & 63, wr = wid >> 2, wc = wid & 3, fr = lane & 15, fq = lane >> 4;
    const int K = g.K, nt = K / BK;
    unsigned voffA[2], voffB[2];
#pragma unroll
    for (int i = 0; i < 2; ++i) { int R, C; stage_rc(tid * 16 + i * 8192, R, C); const int Rb = (R & ~31) + perm32(R & 31);
        voffA[i] = (unsigned)(R * g.lda + C) * 2u; voffB[i] = (unsigned)(Rb * g.ldb + C) * 2u; }
    const size_t kstep = (size_t)(BK * 2);
    const size_t hstepA = (size_t)HALF * g.lda * 2, hstepB = (size_t)HALF * g.ldb * 2;
    const size_t tstepA = 2 * hstepA, tstepB = 2 * hstepB;
    const unsigned ldsw = (unsigned)wid * 1024u;
    const int aoff = lds_byte(wr * 64 + fr, fq * 8), boff = lds_byte(wc * 32 + fr, fq * 8);
#define PG8_SA(b, h) (((b) * 2 + (h)) * HTB)
#define PG8_SB(b, h) ((4 + (b) * 2 + (h)) * HTB)
#define PG8_STAGE(bufoff, gbase, voff) do { _Pragma("unroll") for (int _i = 0; _i < 2; ++_i) \
        __builtin_amdgcn_global_load_lds((const unsigned*)((const char*)(gbase) + (voff)[_i]), (LAS unsigned*)(lds + (bufoff) + ldsw + _i * 8192), 16, 0, 0); } while (0)
#define PG8_LDA(dst, b, h) do { _Pragma("unroll") for (int m = 0; m < 4; ++m) _Pragma("unroll") for (int k = 0; k < 2; ++k) dst[m][k] = *(const LAS bf16x8*)(lds + PG8_SA(b, h) + aoff + m * 2048 + k * 1024); } while (0)
#define PG8_LDB(dst, b, h) do { _Pragma("unroll") for (int n = 0; n < 2; ++n) _Pragma("unroll") for (int k = 0; k < 2; ++k) dst[n][k] = *(const LAS bf16x8*)(lds + PG8_SB(b, h) + boff + n * 2048 + k * 1024); } while (0)
#define PG8_MMA(ai, bj, At, Bt) do { __builtin_amdgcn_s_setprio(1); _Pragma("unroll") for (int m = 0; m < 4; ++m) _Pragma("unroll") for (int n = 0; n < 2; ++n) _Pragma("unroll") for (int k = 0; k < 2; ++k) \
        acc[ai][bj][m][n] = __builtin_amdgcn_mfma_f32_16x16x32_bf16(Bt[n][k], At[m][k], acc[ai][bj][m][n], 0, 0, 0); __builtin_amdgcn_s_setprio(0); } while (0)
#define PG8_WAIT_V(n) asm volatile("s_waitcnt vmcnt(" #n ")" ::: "memory")
#define PG8_WAIT_L(n) asm volatile("s_waitcnt lgkmcnt(" #n ")" ::: "memory")
#define PG8_BAR __builtin_amdgcn_s_barrier()
#define PG8_SCHED __builtin_amdgcn_sched_barrier(0)
    Unit cur, nxt; int ui = 0;
    if (!S.next(0, cur)) return;
    f32x4 acc[2][2][4][2];
#pragma unroll
    for (int a = 0; a < 2; ++a)
#pragma unroll
        for (int b = 0; b < 2; ++b)
#pragma unroll
            for (int m = 0; m < 4; ++m)
#pragma unroll
                for (int n = 0; n < 2; ++n) acc[a][b][m][n] = (f32x4){0.f, 0.f, 0.f, 0.f};
    bf16x8 At[4][2], B0[2][2], B1[2][2];
    const char* cA = (const char*)g.A + (size_t)cur.pm * tstepA; const char* cB = (const char*)g.Bt + (size_t)cur.pn * tstepB;
    PG8_STAGE(PG8_SB(0, 0), cB, voffB); PG8_STAGE(PG8_SB(0, 1), cB + hstepB, voffB); PG8_STAGE(PG8_SA(0, 0), cA, voffA); PG8_STAGE(PG8_SA(0, 1), cA + hstepA, voffA);
    if (wr == 1) PG8_BAR;
    PG8_WAIT_V(2); PG8_BAR;
    PG8_STAGE(PG8_SB(1, 0), cB + kstep, voffB); PG8_STAGE(PG8_SA(1, 0), cA + kstep, voffA); PG8_STAGE(PG8_SB(1, 1), cB + hstepB + kstep, voffB);
    PG8_WAIT_V(6); PG8_BAR;
    for (;;) {
        const bool has_next = S.next(ui + 1, nxt);
        const char* nA = has_next ? (const char*)g.A + (size_t)nxt.pm * tstepA : cA; const char* nB = has_next ? (const char*)g.Bt + (size_t)nxt.pn * tstepB : cB;
#pragma unroll 1
        for (int t = 0; t < nt; t += 2) {
            const bool last = (t == nt - 2);
            const char* a1 = cA + (size_t)(t + 1) * kstep;
            const char* a2 = last ? nA : cA + (size_t)(t + 2) * kstep; const char* b2 = last ? nB : cB + (size_t)(t + 2) * kstep;
            const char* a3 = a2 + kstep; const char* b3 = b2 + kstep;
            if constexpr (Epi::HOOK) { if (E.hook_at(t)) E.mid(acc, cur, t, wr, wc, fr, fq); }
            PG8_LDB(B0, 0, 0); PG8_LDB(B1, 0, 1); PG8_SCHED; PG8_LDA(At, 0, 0); PG8_STAGE(PG8_SA(1, 1), a1 + hstepA, voffA);
            PG8_WAIT_V(8); PG8_WAIT_L(0); PG8_BAR; PG8_MMA(0, 0, At, B0); PG8_MMA(0, 1, At, B1); PG8_BAR; PG8_SCHED;
            PG8_LDA(At, 0, 1); PG8_STAGE(PG8_SB(0, 0), b2, voffB); PG8_STAGE(PG8_SB(0, 1), b2 + hstepB, voffB); PG8_STAGE(PG8_SA(0, 0), a2, voffA);
            PG8_WAIT_V(8); PG8_WAIT_L(0); PG8_BAR; PG8_MMA(1, 0, At, B0); PG8_MMA(1, 1, At, B1); PG8_BAR; PG8_SCHED;
            PG8_LDB(B0, 1, 0); PG8_LDB(B1, 1, 1); PG8_SCHED; PG8_LDA(At, 1, 0); PG8_STAGE(PG8_SA(0, 1), a2 + hstepA, voffA);
            PG8_WAIT_V(8); PG8_WAIT_L(0); PG8_BAR; PG8_MMA(0, 0, At, B0); PG8_MMA(0, 1, At, B1); PG8_BAR; PG8_SCHED;
            PG8_LDA(At, 1, 1); PG8_STAGE(PG8_SB(1, 0), b3, voffB); PG8_STAGE(PG8_SB(1, 1), b3 + hstepB, voffB); PG8_STAGE(PG8_SA(1, 0), a3, voffA);
            PG8_WAIT_V(8); PG8_WAIT_L(0); PG8_BAR; PG8_MMA(1, 0, At, B0); PG8_MMA(1, 1, At, B1); PG8_BAR; PG8_SCHED;
        }
        if (wr == 0) PG8_BAR;
        E(acc, cur, ui, wr, wc, fr, fq);
        if (!has_next) break;
#pragma unroll
        for (int a = 0; a < 2; ++a)
#pragma unroll
            for (int b = 0; b < 2; ++b)
#pragma unroll
                for (int m = 0; m < 4; ++m)
#pragma unroll
                    for (int n = 0; n < 2; ++n) acc[a][b][m][n] = (f32x4){0.f, 0.f, 0.f, 0.f};
        cur = nxt; cA = nA; cB = nB; ++ui;
        if (wr == 1) PG8_BAR;
    }
    PG8_WAIT_V(0);
    PG8_BAR;
#undef PG8_SA
#undef PG8_SB
#undef PG8_STAGE
#undef PG8_LDA
#undef PG8_LDB
#undef PG8_MMA
#undef PG8_WAIT_V
#undef PG8_WAIT_L
#undef PG8_BAR
#undef PG8_SCHED
}
}
using pg8::Unit;
typedef f32x4 Acc[2][2][4][2];

__device__ __forceinline__ float row_rstd(const float* SS, int row) {
    const f32x4* p = (const f32x4*)(SS + (size_t)row * 16);
    const f32x4 a = p[0], b = p[1], c = p[2], d = p[3];
    const float s = ((a.x + a.y) + (a.z + a.w)) + ((b.x + b.y) + (b.z + b.w)) + ((c.x + c.y) + (c.z + c.w)) + ((d.x + d.y) + (d.z + d.w));
    return 1.f / sqrtf(s * (1.f / D) + EPS);
}
#define EPI_ROWS_BEGIN int frl_ = fr; asm volatile("" : "+v"(frl_)); const int row0 = u.pm * 256 + wr * 64 + frl_; const int col0 = u.pn * 256 + wc * 32 + 8 * fq; (void)col0; \
    _Pragma("unroll") for (int ai = 0; ai < 2; ++ai) _Pragma("unroll") for (int m = 0; m < 4; ++m) { const int row = row0 + ai * 128 + m * 16;
#define EPI_ROWS_END asm volatile("" ::: "memory"); }
__device__ __forceinline__ u32x4 pack8(const f32x4 v0, const f32x4 v1) { u32x4 w; w.x = cvt_pk_bf16(v0[0], v0[1]); w.y = cvt_pk_bf16(v0[2], v0[3]); w.z = cvt_pk_bf16(v1[0], v1[1]); w.w = cvt_pk_bf16(v1[2], v1[3]); return w; }

template <int ACT> struct EpiNormBf16 {
    static constexpr bool HOOK = false;
    bf16_t* O; int ldo; const LAS float* rsl;
    bf16_t* S5A; bf16_t* IKC;
    __device__ __forceinline__ void operator()(Acc& acc, const Unit& u, int ui, int wr, int wc, int fr, int fq) const {
        EPI_ROWS_BEGIN
            const float rs = rsl[ui * 256 + (row & 255)]; bf16_t* rowp = O + (size_t)row * ldo + col0;
#pragma unroll
            for (int bj = 0; bj < 2; ++bj) { f32x4 v0 = acc[ai][bj][m][0] * rs, v1 = acc[ai][bj][m][1] * rs;
                if (ACT == 1) {
#pragma unroll
                    for (int j = 0; j < 4; ++j) { v0[j] = sigmoid_nr(v0[j]); v1[j] = sigmoid_nr(v1[j]); } }
                const u32x4 w = pack8(v0, v1);
                if (ACT == 2 && (u.pn == 6 || u.pn == 7)) { const int c = col0 + bj * 128 - C_S5U;
                    *(u32x4*)(S5A + ((size_t)(c >> 4) * 1024 + (row >> 4)) * S5LD + (row & 15) * 16 + (c & 15)) = w; }
                else { *(u32x4*)(rowp + bj * 128) = w;
                    if (ACT == 2 && u.pn == 5 && bj == 1 && wc < 2) *(u32x4*)(IKC + (size_t)(row >> 4) * 1024 + ((wc * 4 + fq) * 16 + (row & 15)) * 8) = w; } }
        EPI_ROWS_END
    }
};
struct EpiMerge {
    static constexpr bool HOOK = true;
    bf16_t* O; const bf16_t* Gt;
    __device__ __forceinline__ bool hook_at(int t) const { return t == 16 || t == 24; }
    __device__ __forceinline__ void mid(Acc& acc, const Unit& u, int t, int wr, int wc, int fr, int fq) const {
        const int s0 = (t == 16) ? 0 : 1024;
        int frl_ = fr; asm volatile("" : "+v"(frl_));
        const int row0 = u.pm * 256 + wr * 64 + frl_, col0 = u.pn * 256 + wc * 32 + 8 * fq;
        u32x4 gn[4];
        { const bf16_t* gp = Gt + (size_t)row0 * GW + col0 + s0; gn[0] = *(const u32x4*)gp; gn[1] = *(const u32x4*)(gp + 1024); gn[2] = *(const u32x4*)(gp + 128); gn[3] = *(const u32x4*)(gp + 1152); }
#pragma unroll
        for (int g = 0; g < 8; ++g) { const int ai = g >> 2, m = g & 3; u32x4 gc[4];
#pragma unroll
            for (int q = 0; q < 4; ++q) gc[q] = gn[q];
            if (g < 7) { const int g2 = g + 1; const bf16_t* gp = Gt + (size_t)(row0 + (g2 >> 2) * 128 + (g2 & 3) * 16) * GW + col0 + s0;
                gn[0] = *(const u32x4*)gp; gn[1] = *(const u32x4*)(gp + 1024); gn[2] = *(const u32x4*)(gp + 128); gn[3] = *(const u32x4*)(gp + 1152); }
#pragma unroll
            for (int bj = 0; bj < 2; ++bj) { const u32x4 ga = gc[2 * bj], gb = gc[2 * bj + 1];
#pragma unroll
                for (int q = 0; q < 4; ++q) { const float r0 = bflo(ga[q]) / bflo(gb[q]), r1 = bfhi(ga[q]) / bfhi(gb[q]);
                    acc[ai][bj][m][q >> 1][(q & 1) * 2] *= r0; acc[ai][bj][m][q >> 1][(q & 1) * 2 + 1] *= r1; } } }
    }
    __device__ __forceinline__ void operator()(Acc& acc, const Unit& u, int ui, int wr, int wc, int fr, int fq) const {
        int frl_ = fr; asm volatile("" : "+v"(frl_));
        const int row0 = u.pm * 256 + wr * 64 + frl_, col0 = u.pn * 256 + wc * 32 + 8 * fq;
        u32x4 gn[2];
        { const bf16_t* gp = Gt + (size_t)row0 * GW + 2048 + col0; gn[0] = *(const u32x4*)gp; gn[1] = *(const u32x4*)(gp + 128); }
#pragma unroll
        for (int g = 0; g < 8; ++g) { const int ai = g >> 2, m = g & 3, row = row0 + ai * 128 + m * 16; u32x4 gcur[2]; gcur[0] = gn[0]; gcur[1] = gn[1];
            if (g < 7) { const int g2 = g + 1; const bf16_t* gp = Gt + (size_t)(row0 + (g2 >> 2) * 128 + (g2 & 3) * 16) * GW + 2048 + col0; gn[0] = *(const u32x4*)gp; gn[1] = *(const u32x4*)(gp + 128); }
            bf16_t* rowp = O + (size_t)row * 1024 + col0;
#pragma unroll
            for (int bj = 0; bj < 2; ++bj) { const u32x4 gc = gcur[bj]; f32x4 v0 = acc[ai][bj][m][0], v1 = acc[ai][bj][m][1];
                v0[0] *= bflo(gc[0]); v0[1] *= bfhi(gc[0]); v0[2] *= bflo(gc[1]); v0[3] *= bfhi(gc[1]); v1[0] *= bflo(gc[2]); v1[1] *= bfhi(gc[2]); v1[2] *= bflo(gc[3]); v1[3] *= bfhi(gc[3]);
                *(u32x4*)(rowp + bj * 128) = pack8(v0, v1); } }
    }
};
struct EpiResid {
    static constexpr bool HOOK = false;
    const float* XO; float* XF; bf16_t* XB; float* SS;
    __device__ __forceinline__ void operator()(Acc& acc, const Unit& u, int ui, int wr, int wc, int fr, int fq) const {
        int frl_ = fr; asm volatile("" : "+v"(frl_));
        const int row0 = u.pm * 256 + wr * 64 + frl_, col0 = u.pn * 256 + wc * 32 + 8 * fq;
        f32x4 xn[4];
        { const size_t off = (size_t)row0 * D + col0; xn[0] = *(const f32x4*)(XO + off); xn[1] = *(const f32x4*)(XO + off + 4); xn[2] = *(const f32x4*)(XO + off + 128); xn[3] = *(const f32x4*)(XO + off + 132); }
#pragma unroll
        for (int g = 0; g < 8; ++g) { const int ai = g >> 2, m = g & 3, row = row0 + ai * 128 + m * 16; const size_t off = (size_t)row * D + col0;
            f32x4 xc[4];
#pragma unroll
            for (int q = 0; q < 4; ++q) xc[q] = xn[q];
            if (g < 7) { const int g2 = g + 1; const size_t o2 = (size_t)(row0 + (g2 >> 2) * 128 + (g2 & 3) * 16) * D + col0;
                xn[0] = *(const f32x4*)(XO + o2); xn[1] = *(const f32x4*)(XO + o2 + 4); xn[2] = *(const f32x4*)(XO + o2 + 128); xn[3] = *(const f32x4*)(XO + o2 + 132); }
            float ss = 0.f;
#pragma unroll
            for (int bj = 0; bj < 2; ++bj) { const f32x4 v0 = acc[ai][bj][m][0] + xc[2 * bj], v1 = acc[ai][bj][m][1] + xc[2 * bj + 1];
                *(f32x4*)(XF + off + bj * 128) = v0; *(f32x4*)(XF + off + bj * 128 + 4) = v1; *(u32x4*)(XB + off + bj * 128) = pack8(v0, v1);
                ss += (v0[0] * v0[0] + v0[1] * v0[1]) + (v0[2] * v0[2] + v0[3] * v0[3]) + (v1[0] * v1[0] + v1[1] * v1[1]) + (v1[2] * v1[2] + v1[3] * v1[3]); }
            ss += __shfl_xor(ss, 16); ss += __shfl_xor(ss, 32);
            if (fq == 0) SS[(size_t)row * 16 + u.pn * 4 + wc] = ss; }
    }
};
struct EpiUpConv {
    static constexpr bool HOOK = false;
    bf16_t* ACT; const LAS float* rsl; LAS unsigned char* hal; const float* cw; bf16_t* HALO; bf16_t* FIRST;
    __device__ __forceinline__ void operator()(Acc& acc, const Unit& u, int ui, int wr, int wc, int fr, int fq) const {
        int frl_ = fr, fql_ = fq; asm volatile("" : "+v"(frl_), "+v"(fql_));
        const int f = frl_, cb = wc * 32 + 8 * fql_;
#pragma unroll
        for (int ai = 0; ai < 2; ++ai)
#pragma unroll
            for (int m = 0; m < 4; ++m) { const float rs = rsl[ui * 256 + ai * 128 + wr * 64 + m * 16 + f];
#pragma unroll
                for (int bj = 0; bj < 2; ++bj) { acc[ai][bj][m][0] = acc[ai][bj][m][0] * rs; acc[ai][bj][m][1] = acc[ai][bj][m][1] * rs; } }
        if (f >= 14) {
#pragma unroll
            for (int ai = 0; ai < 2; ++ai)
#pragma unroll
                for (int bj = 0; bj < 2; ++bj) { const u32x4 w = pack8(acc[ai][bj][3][0], acc[ai][bj][3][1]);
                    *(LAS u32x4*)(hal + (((ai * 2 + wr) * 2 + (f - 14)) * 256 + bj * 128 + cb) * 2) = w;
                    if (ai == 1 && wr == 1) *(u32x4*)(HALO + ((size_t)(u.pm * 22 + u.pn) * 2 + (f - 14)) * 256 + bj * 128 + cb) = w; } }
        if (f < 2 && wr == 0) {
#pragma unroll
            for (int bj = 0; bj < 2; ++bj) *(u32x4*)(FIRST + ((size_t)(u.pm * 22 + u.pn) * 2 + f) * 256 + bj * 128 + cb) = pack8(acc[0][bj][0][0], acc[0][bj][0][1]); }
        asm volatile("s_waitcnt lgkmcnt(0)\n\ts_barrier" ::: "memory");
        float wg[3][8], wv[3][8];
        { const float* cp = cw + u.pn * 128 + cb;
#pragma unroll
          for (int k = 0; k < 3; ++k) { const f32x4 a0 = *(const f32x4*)(cp + k * 2 * DFF), a1 = *(const f32x4*)(cp + k * 2 * DFF + 4), b0 = *(const f32x4*)(cp + k * 2 * DFF + DFF), b1 = *(const f32x4*)(cp + k * 2 * DFF + DFF + 4);
#pragma unroll
              for (int x = 0; x < 4; ++x) { wg[k][x] = a0[x]; wg[k][4 + x] = a1[x]; wv[k][x] = b0[x]; wv[k][4 + x] = b1[x]; } } }
#pragma unroll
        for (int ai = 0; ai < 2; ++ai) {
            f32x4 pv[2][2];
            { const bool has = !(ai == 0 && wr == 0); const int ps = (wr == 1) ? ai * 2 : 1;
#pragma unroll
              for (int bj = 0; bj < 2; ++bj) { u32x4 w = {0u, 0u, 0u, 0u}; if (has && f >= 14) w = *(const LAS u32x4*)(hal + ((ps * 2 + (f - 14)) * 256 + bj * 128 + cb) * 2);
                  pv[bj][0] = (f32x4){bflo(w[0]), bfhi(w[0]), bflo(w[1]), bfhi(w[1])}; pv[bj][1] = (f32x4){bflo(w[2]), bfhi(w[2]), bflo(w[3]), bfhi(w[3])}; } }
#pragma unroll
            for (int m = 0; m < 4; ++m) { float hg[8], hv[8];
#pragma unroll
                for (int bj = 0; bj < 2; ++bj)
#pragma unroll
                    for (int n2 = 0; n2 < 2; ++n2)
#pragma unroll
                        for (int x = 0; x < 4; ++x) { const float cur = acc[ai][bj][m][n2][x], prv = (m == 0) ? pv[bj][n2][x] : acc[ai][bj][m - 1][n2][x];
                            const float t1 = (f == 15) ? prv : cur, t2 = (f >= 14) ? prv : cur;
                            const float p1 = __builtin_bit_cast(float, __builtin_amdgcn_update_dpp(0, __builtin_bit_cast(int, t1), 0x121, 0xf, 0xf, false));
                            const float p2 = __builtin_bit_cast(float, __builtin_amdgcn_update_dpp(0, __builtin_bit_cast(int, t2), 0x122, 0xf, 0xf, false)); const int c = 4 * n2 + x;
                            const float hh = (bj == 0 ? wg[0][c] : wv[0][c]) * p2 + (bj == 0 ? wg[1][c] : wv[1][c]) * p1 + (bj == 0 ? wg[2][c] : wv[2][c]) * cur;
                            if (bj == 0) hg[c] = hh; else hv[c] = hh; }
                u32x4 o;
#pragma unroll
                for (int q = 0; q < 4; ++q) o[q] = pk2(siluf_(hg[2 * q]) * hv[2 * q], siluf_(hg[2 * q + 1]) * hv[2 * q + 1]);
                *(u32x4*)(ACT + (size_t)(u.pm * 256 + ai * 128 + wr * 64 + m * 16 + f) * DFF + u.pn * 128 + cb) = o; } }
    }
};
struct EpiS5S {
    static constexpr bool HOOK = false;
    float* S;
    __device__ __forceinline__ void operator()(Acc& acc, const Unit& u, int ui, int wr, int wc, int fr, int fq) const {
        int frl_ = fr; asm volatile("" : "+v"(frl_));
        const int row0 = u.pm * 256 + wr * 64 + frl_, c0 = wc * 32 + 8 * fq;
#pragma unroll
        for (int ai = 0; ai < 2; ++ai)
#pragma unroll
            for (int m = 0; m < 4; ++m) { float* p = S + (size_t)(row0 + ai * 128 + m * 16) * 128 + c0; *(f32x4*)p = acc[ai][0][m][0]; *(f32x4*)(p + 4) = acc[ai][0][m][1]; }
    }
};
struct EpiS5Y {
    static constexpr bool HOOK = false;
    bf16_t* YG;
    __device__ __forceinline__ void operator()(Acc& acc, const Unit& u, int ui, int wr, int wc, int fr, int fq) const {
        int frl_ = fr; asm volatile("" : "+v"(frl_));
        const int g = u.pn, rg0 = (u.pm & 3) * 256 + wr * 64 + frl_;
#pragma unroll
        for (int ai = 0; ai < 2; ++ai)
#pragma unroll
            for (int m = 0; m < 4; ++m) { const int rg = rg0 + ai * 128 + m * 16;
#pragma unroll
                for (int bj = 0; bj < 2; ++bj) { const int c = bj * 128 + wc * 32 + 8 * fq, t = c >> 4, ch = c & 15; f32x4 v0 = acc[ai][bj][m][0], v1 = acc[ai][bj][m][1];
#pragma unroll
                    for (int j = 0; j < 4; ++j) { v0[j] = gelu_tanh(v0[j]); v1[j] = gelu_tanh(v1[j]); }
                    *(u32x4*)(YG + (size_t)(rg * 16 + t) * 512 + g * 16 + ch) = pack8(v0, v1); } asm volatile("" ::: "memory"); }
    }
};
struct EpiS5G {
    static constexpr bool HOOK = false;
    const bf16_t* YG; bf16_t* BR;
    __device__ __forceinline__ void operator()(Acc& acc, const Unit& u, int ui, int wr, int wc, int fr, int fq) const {
        EPI_ROWS_BEGIN
#pragma unroll
            for (int bj = 0; bj < 2; ++bj) { const u32x4 y = *(const u32x4*)(YG + (size_t)row * 512 + col0 + bj * 128); f32x4 v0 = acc[ai][bj][m][0], v1 = acc[ai][bj][m][1];
                v0[0] = bflo(y[0]) * sigmoidf_(v0[0]); v0[1] = bfhi(y[0]) * sigmoidf_(v0[1]); v0[2] = bflo(y[1]) * sigmoidf_(v0[2]); v0[3] = bfhi(y[1]) * sigmoidf_(v0[3]);
                v1[0] = bflo(y[2]) * sigmoidf_(v1[0]); v1[1] = bfhi(y[2]) * sigmoidf_(v1[1]); v1[2] = bflo(y[3]) * sigmoidf_(v1[2]); v1[3] = bfhi(y[3]) * sigmoidf_(v1[3]);
                *(u32x4*)(BR + (size_t)row * BRW + 1024 + col0 + bj * 128) = pack8(v0, v1); }
        EPI_ROWS_END
    }
};

struct Args { const float* in[28]; float* out; unsigned char* ws; int ph_lo, ph_hi; };
typedef const __attribute__((address_space(4))) Args CArgs;
struct Frame {
    LAS unsigned char* lds;
    CArgs* ap;
    unsigned char* ws;
    int tid, lane, wave, G, bid;
};
enum { I_X = 0, I_ANG, I_WIN, I_KVG, I_WUK, I_WUV, I_WPA, I_S5ARE, I_S5AIM, I_S5LDT, I_S5BRE, I_S5BIM, I_S5CRE, I_S5CIM, I_S5D, I_WGLU, I_WPB, I_GCW, I_GALOG, I_GDTB, I_GNG, I_WPC, I_WOUT, I_FNG, I_WUP, I_FCW, I_WDN, I_FING };

template <class Sched> __device__ __forceinline__ const LAS float* rstd_table(Frame& F, const Sched& S, const float* SS) {
    LAS float* rsl = (LAS float*)(F.lds + 131072); Unit u;
    for (int i = 0; S.next(i, u); ++i) for (int r = F.tid; r < 256; r += 512) rsl[i * 256 + r] = row_rstd(SS, u.pm * 256 + r);
    __syncthreads();
    return rsl;
}
__device__ __forceinline__ void ph_x0(Frame& F) {
    const float* x = F.ap->in[I_X]; bf16_t* XB = (bf16_t*)(F.ws + WS_XB); float* SS = (float*)(F.ws + WS_SS);
    const int gw = F.bid * 8 + F.wave, NGW = F.G * 8;
    for (int r = gw; r < M; r += NGW) {
        const f32x4* xr = (const f32x4*)(x + (size_t)r * D) + F.lane; float s = 0.f; f32x4 v[4];
#pragma unroll
        for (int j = 0; j < 4; ++j) { v[j] = xr[64 * j]; s += (v[j].x * v[j].x + v[j].y * v[j].y) + (v[j].z * v[j].z + v[j].w * v[j].w); }
        s = wave_sum(s);
        u32x2* o = (u32x2*)(XB + (size_t)r * D) + F.lane;
#pragma unroll
        for (int j = 0; j < 4; ++j) { u32x2 w; w.x = pk2(v[j].x, v[j].y); w.y = pk2(v[j].z, v[j].w); o[64 * j] = w; }
        if (F.lane < 16) SS[(size_t)r * 16 + F.lane] = (F.lane == 0) ? s : 0.f;
    }
}

__device__ __forceinline__ int win1_col(int n) {
    if (n < 1152) return 512 + (n - 1024);
    if (n < 1408) return 640 + (n - 1152);
    if (n < 1472) return 896 + (n - 1408);
    if (n < 1476) return 960 + (n - 1472);
    if (n < 1480) return 3524 + (n - 1476);
    if (n < 1484) return 3528 + (n - 1480);
    if (n < 1536) return -1;
    if (n < 2048) return 964 + (n - 1536);
    if (n < 3584) return 1476 + (n - 2048);
    return 3012 + (n - 3584);
}
__device__ __forceinline__ int wup_col(int n) { const int j = n >> 8, bj = (n >> 7) & 1, i = n & 127; return bj * DFF + j * 128 + i; }
__device__ __forceinline__ void tr_one(int lane, int it, const float* src, int sld, const float* scale, bf16_t* dst, int dld, int koff, int n0, int nn, int kind, LAS float* scr) {
    const int nblk = nn / 32;
    const int kb = it / nblk, nb = it % nblk, k0 = kb * 64, nbase = n0 + nb * 32, r8 = lane >> 3, c4 = lane & 7, n = nbase + 4 * c4;
    int col = n; if (kind == 1) col = win1_col(n); else if (kind == 2) col = 3532 + n; else if (kind == 3) col = wup_col(n);
    f32x4 v[8]; float sc[8];
    const float* sp = src + (size_t)(k0 + r8) * sld + (col >= 0 ? col : 0);
#pragma unroll
    for (int i = 0; i < 8; ++i) v[i] = *(const f32x4*)(sp + (size_t)(8 * i) * sld);
#pragma unroll
    for (int i = 0; i < 8; ++i) sc[i] = scale ? scale[k0 + 8 * i + r8] : 1.f;
    if (col < 0) {
#pragma unroll
        for (int i = 0; i < 8; ++i) sc[i] = 0.f; }
#pragma unroll
    for (int i = 0; i < 8; ++i) { LAS float* d = scr + (8 * i + r8) * 33 + 4 * c4; d[0] = v[i][0] * sc[i]; d[1] = v[i][1] * sc[i]; d[2] = v[i][2] * sc[i]; d[3] = v[i][3] * sc[i]; }
    WAVE_SYNC();
    const int c = lane & 7;
#pragma unroll
    for (int j = 0; j < 4; ++j) { const int nl = (lane >> 3) + 8 * j; const LAS float* s = scr + (8 * c) * 33 + nl;
        u32x4 o; o.x = pk2(s[0 * 33], s[1 * 33]); o.y = pk2(s[2 * 33], s[3 * 33]); o.z = pk2(s[4 * 33], s[5 * 33]); o.w = pk2(s[6 * 33], s[7 * 33]);
        *(u32x4*)(dst + (size_t)(nbase + nl) * dld + koff + k0 + 8 * c) = o; }
    WAVE_SYNC();
}
__device__ __forceinline__ void ph_wprep(Frame& F, int l) {
    LAS float* L = (LAS float*)F.lds;
    const float* w_in = F.ap->in[I_WIN] + (size_t)l * D * NIN; const float* ang = F.ap->in[I_ANG] + (size_t)l * D;
    bf16_t* WIN1 = (bf16_t*)(F.ws + WS_WIN1); bf16_t* WMRG = (bf16_t*)(F.ws + WS_WMRG);
    for (int pass = 0; pass * F.G < 320; ++pass) {
        int it = F.bid + pass * F.G;
        if (F.G == 256 && pass == 1) it = (F.bid >= 64 && F.bid < 128) ? F.bid + 192 : 320;
        if (it >= 320) continue;
        __syncthreads();
        if (it >= 64 && it < 192) {
            const int j = it - 64, h = j >> 4, k0 = (j & 15) * 64; const float* wuk = F.ap->in[I_WUK] + (size_t)l * 128 * 512;
            LAS float* A = L; LAS float* Bm = L + 64 * 65;
            for (int e = F.tid; e < 64 * 64; e += 512) { const int kk = e >> 6, d = e & 63; A[kk * 65 + d] = w_in[(size_t)(k0 + kk) * NIN + h * 64 + d] * ang[k0 + kk] * 0.125f; }
            for (int e = F.tid; e < 128 * 64; e += 512) { const int r = e >> 6, d = e & 63; Bm[r * 65 + d] = wuk[(size_t)r * 512 + h * 64 + d]; }
            __syncthreads();
            for (int e = F.tid; e < 128 * 64; e += 512) { const int r = e >> 6, kk = e & 63; float s = 0.f;
#pragma unroll 16
                for (int d = 0; d < 64; ++d) s += A[kk * 65 + d] * Bm[r * 65 + d];
                WIN1[(size_t)(h * 128 + r) * D + k0 + kk] = (bf16_t)f2bf(s); }
        } else if (it >= 192) {
            const int j = it - 192, h = j >> 4, n0 = (j & 15) * 64; const float* wuv = F.ap->in[I_WUV] + (size_t)l * 128 * 512; const float* wpa = F.ap->in[I_WPA] + (size_t)l * 512 * D;
            LAS float* A = L; LAS float* Bm = L + 64 * 65;
            for (int e = F.tid; e < 64 * 64; e += 512) { const int d = e >> 6, nn = e & 63; A[d * 65 + nn] = wpa[(size_t)(h * 64 + d) * D + n0 + nn]; }
            for (int e = F.tid; e < 128 * 64; e += 512) { const int r = e >> 6, d = e & 63; Bm[r * 65 + d] = wuv[(size_t)r * 512 + h * 64 + d]; }
            __syncthreads();
            for (int e = F.tid; e < 128 * 64; e += 512) { const int nn = e >> 7, r = e & 127; float s = 0.f;
#pragma unroll 16
                for (int d = 0; d < 64; ++d) s += A[d * 65 + nn] * Bm[r * 65 + d];
                WMRG[(size_t)(n0 + nn) * BRW + h * 128 + r] = (bf16_t)f2bf(s); }
        } else {
            const int g = it >> 1, hf = it & 1;
            const float* are = F.ap->in[I_S5ARE] + (size_t)l * 2048 + g * 64; const float* aim = F.ap->in[I_S5AIM] + (size_t)l * 2048 + g * 64;
            const float dt = __expf(F.ap->in[I_S5LDT][l * 32 + g]);
            const float* bre = F.ap->in[I_S5BRE] + (size_t)l * 32768 + g * 1024; const float* bim = F.ap->in[I_S5BIM] + (size_t)l * 32768 + g * 1024;
            const float* cre = F.ap->in[I_S5CRE] + (size_t)l * 32768 + g * 1024; const float* cim = F.ap->in[I_S5CIM] + (size_t)l * 32768 + g * 1024;
            const float* dd = F.ap->in[I_S5D] + (size_t)l * 512 + g * 16;
            LAS float* PWR = L;
            LAS float* PWI = L + 1088;
            LAS float* BBR = L + 2176;
            LAS float* BBI = BBR + 1024;
            LAS float* CR = BBI + 1024;
            LAS float* CI = CR + 1024;
            LAS float* KT = CI + 1024;
            for (int e = F.tid; e < 17 * 64; e += 512) { const int j = e >> 6, p = e & 63; const float mag = expf(dt * are[p] * (float)j), a = dt * aim[p] * (float)j; PWR[e] = mag * cosf(a); PWI[e] = mag * sinf(a); }
            for (int e = F.tid; e < 1024; e += 512) { const int p = e >> 4; const float ar = are[p], ai = aim[p];
                const float mag = expf(dt * ar), a = dt * ai, abr = mag * cosf(a), abi = mag * sinf(a), den = ar * ar + ai * ai, nr = abr - 1.f;
                const float fre = (nr * ar + abi * ai) / den, fim = (abi * ar - nr * ai) / den;
                BBR[e] = fre * bre[e] - fim * bim[e]; BBI[e] = fre * bim[e] + fim * bre[e]; CR[e] = cre[e]; CI[e] = cim[e]; }
            __syncthreads();
            for (int e = F.tid; e < 4096; e += 512) { const int j = e >> 8, m = (e >> 4) & 15, mp = e & 15; float s = 0.f;
                for (int p = 0; p < 64; ++p) { const float cr = CR[m * 64 + p], ci = CI[m * 64 + p], pr = PWR[j * 64 + p], pi = PWI[j * 64 + p], br = BBR[p * 16 + mp], bi = BBI[p * 16 + mp];
                    const float zr = cr * pr - ci * pi, zi = cr * pi + ci * pr; s += zr * br - zi * bi; }
                KT[e] = s; }
            __syncthreads();
            bf16_t* W1 = (bf16_t*)(F.ws + WS_S5W1) + (size_t)g * 256 * 256; bf16_t* TT = (bf16_t*)(F.ws + WS_S5T) + (size_t)g * 256 * 384;
            for (int e = hf * 32768 + F.tid; e < (hf + 1) * 32768; e += 512) { const int n = e >> 8, k = e & 255; float v = 0.f;
                if (n < 128) { const int p = n & 63, s = k >> 4, m = k & 15, j = 15 - s; const float pr = PWR[j * 64 + p], pi = PWI[j * 64 + p], br = BBR[p * 16 + m], bi = BBI[p * 16 + m];
                    v = (n < 64) ? (pr * br - pi * bi) : (pr * bi + pi * br); }
                W1[e] = (bf16_t)f2bf(v); }
            for (int e = hf * 49152 + F.tid; e < (hf + 1) * 49152; e += 512) { const int n = e / 384, k = e % 384, t = n >> 4, m = n & 15; float v = 0.f;
                if (k < 256) { const int s = k >> 4, mp = k & 15; if (s <= t) { v = KT[((t - s) * 16 + m) * 16 + mp]; if (s == t && m == mp) v += dd[m]; } }
                else { const int p = (k - 256) & 63; const float cr = CR[m * 64 + p], ci = CI[m * 64 + p], pr = PWR[(t + 1) * 64 + p], pi = PWI[(t + 1) * 64 + p];
                    v = (k < 320) ? (cr * pr - ci * pi) : -(cr * pi + ci * pr); }
                TT[e] = (bf16_t)f2bf(v); }
            float* S5P = (float*)(F.ws + WS_S5P) + (size_t)g * 128;
            if (hf == 0) for (int e = F.tid; e < 64; e += 512) { S5P[e] = PWR[16 * 64 + e]; S5P[64 + e] = PWI[16 * 64 + e]; }
        }
    }
    __syncthreads();
    LAS float* scr = (LAS float*)(F.lds + F.wave * 16384);
    gu32* ctr = (gu32*)(F.ws + WS_CTL) + CW_Q + (16 + l) * 64;
    constexpr int N0 = 1536, N1 = N0 + 1536, N2 = N1 + 256, N3 = N2 + 256, N4 = N3 + 512, N5 = N4 + 2816, N6 = N5 + 1408, N7 = N6 + 128;
    for (;;) {
        unsigned gi = 0u; if (F.lane == 0) gi = __hip_atomic_fetch_add(ctr, 8u, RLX_AGENT);
        const int it0 = __builtin_amdgcn_readfirstlane((int)gi);
        if (it0 >= N7) break;
#pragma unroll 1
        for (int it = it0; it < it0 + 8 && it < N7; ++it) {
        if (it < N0) tr_one(F.lane, it, w_in, NIN, ang, WIN1, D, 0, 1024, 3072, 1, scr);
        else if (it < N1) tr_one(F.lane, it - N0, w_in, NIN, ang, (bf16_t*)(F.ws + WS_WIN2), D, 0, 0, GW, 2, scr);
        else if (it < N2) tr_one(F.lane, it - N1, F.ap->in[I_WPB] + (size_t)l * 512 * D, D, nullptr, WMRG, BRW, 1024, 0, D, 0, scr);
        else if (it < N3) tr_one(F.lane, it - N2, F.ap->in[I_WPC] + (size_t)l * 512 * D, D, nullptr, WMRG, BRW, 1536, 0, D, 0, scr);
        else if (it < N4) tr_one(F.lane, it - N3, F.ap->in[I_WOUT] + (size_t)l * D * D, D, nullptr, (bf16_t*)(F.ws + WS_WOUT), D, 0, 0, D, 0, scr);
        else if (it < N5) tr_one(F.lane, it - N4, F.ap->in[I_WUP] + (size_t)l * D * 2 * DFF, 2 * DFF, F.ap->in[I_FNG] + (size_t)l * D, (bf16_t*)(F.ws + WS_WUP), D, 0, 0, 2 * DFF, 3, scr);
        else if (it < N6) tr_one(F.lane, it - N5, F.ap->in[I_WDN] + (size_t)l * DFF * D, D, nullptr, (bf16_t*)(F.ws + WS_WDN), DFF, 0, 0, D, 0, scr);
        else tr_one(F.lane, it - N6, F.ap->in[I_WGLU] + (size_t)l * 512 * 512, 512, nullptr, (bf16_t*)(F.ws + WS_WGLU), 512, 0, 0, 512, 0, scr);
        }
    }
}

__device__ __forceinline__ void ph_prep_a(Frame& F, int l) {
    const bf16_t* P1 = (const bf16_t*)(F.ws + WS_P1); bf16_t* CN = (bf16_t*)(F.ws + WS_CN);
    const float* kvg = F.ap->in[I_KVG] + (size_t)l * 128;
    const int gw = F.bid * 8 + F.wave, NGW = F.G * 8;
    for (int r = gw; r < MH; r += NGW) {
        const unsigned w = *((const unsigned*)(P1 + (size_t)r * P1W + C_CKV) + F.lane); const float a = bflo(w), b = bfhi(w);
        const float rs = 1.f / sqrtf(wave_sum(a * a + b * b) * (1.f / 128.f) + EPS);
        *((unsigned*)(CN + (size_t)r * 128) + F.lane) = pk2(a * rs * kvg[2 * F.lane], b * rs * kvg[2 * F.lane + 1]);
    }
}

#ifndef GP_REP_A
#define GP_REP_A 1
#endif
#ifndef GP_REP_B
#define GP_REP_B 1
#endif
#ifndef GP_REP_C
#define GP_REP_C 1
#endif
#ifndef GP_REP_D
#define GP_REP_D 1
#endif
__device__ __forceinline__ int gdn_pos(int r, int x, int rowlen) {
    const int g = x >> 5, y = x & 31;
    const int p = (y < 16) ? (8 * (y >> 2) + (y & 3)) : (8 * ((y - 16) >> 2) + 4 + (y & 3));
    const int P = g * 32 + p, chunk = P >> 3, mask = (rowlen == 128) ? 15 : 7;
    return ((chunk ^ (r & mask)) << 3) + (P & 7);
}
__device__ __forceinline__ void ph_gdn_prep(Frame& F, int l) {
    const bf16_t* P1 = (const bf16_t*)(F.ws + WS_P1); bf16_t* GD = (bf16_t*)(F.ws + WS_GDN); float* GLAST = (float*)(F.ws + WS_GLAST);
    const float* cw = F.ap->in[I_GCW] + (size_t)l * 4 * 1536;
    const bf16_t* zpage = (const bf16_t*)(F.ws + WS_CTL + 786432);
    constexpr int RS = 132, RB = 136, RT_S = 72, MS = 68;
    LAS float* qs = (LAS float*)F.lds; LAS float* ks = qs + 64 * RS;
    LAS float* Mm = (LAS float*)F.lds; LAS float* Tm = Mm + 64 * MS; LAS float* Pt = Tm + 64 * MS; LAS bf16_t* Tb = (LAS bf16_t*)(Pt + 768);
    LAS bf16_t* qb = (LAS bf16_t*)(F.lds + 2 * 64 * RS * 4); LAS bf16_t* kb = qb + 64 * RB; LAS bf16_t* RT = kb + 64 * RB;
    LAS float* gam = (LAS float*)(RT + 256 * RT_S); LAS float* bet = gam + 64; LAS float* egam = bet + 64;
    LAS float* wl = (LAS float*)(F.lds + 49152);
    const int wave = F.wave;
    for (int cu = F.bid; cu < BH * 4 * 64; cu += F.G) {
        int lane_ = F.lane; asm volatile("" : "+v"(lane_));
        const int lane = lane_, tid = wave * 64 + lane, n = lane & 15, qd = lane >> 4;
        const int bl = cu >> 8, h = (cu >> 6) & 3, ch = cu & 63, t0 = ch * 64;
        const size_t rbase = (size_t)bl * T;
        bf16_t* rec = GD + (size_t)cu * GDN_CH;
        __syncthreads();
#pragma unroll 1
        for (int rep_ = 0; rep_ < GP_REP_A; ++rep_) {
        const int r8 = lane >> 3, part = lane & 7, d0 = part * 16, i = 8 * wave + r8, t = t0 + i;
        float wv[3];
#pragma unroll
        for (int m = 0; m < 3; ++m) wv[m] = cw[(tid >> 7) * 1536 + m * 512 + h * 128 + (tid & 127)];
        u32x4 xr[3][4][2];
#pragma unroll
        for (int k = 0; k < 4; ++k) { const int tt = t - 3 + k; const bf16_t* p = (tt < 0) ? zpage : P1 + (rbase + tt) * P1W + C_QKV + h * 128 + d0;
#pragma unroll
            for (int j3 = 0; j3 < 3; ++j3) { xr[j3][k][0] = *(const u32x4*)(p + j3 * 512); xr[j3][k][1] = *(const u32x4*)(p + j3 * 512 + 8); } }
        if (wave == 0) { const bf16_t* rp = P1 + (rbase + t0 + lane) * P1W; const float a = bf2f(rp[C_CA + h]), b = bf2f(rp[C_CB + h]);
            float g = -__expf(F.ap->in[I_GALOG][l * 4 + h]) * softplusf_(a + F.ap->in[I_GDTB][l * 4 + h]);
#pragma unroll
            for (int o = 1; o < 64; o <<= 1) { const float up = __shfl_up(g, o); if (lane >= o) g += up; }
            gam[lane] = g; bet[lane] = sigmoidf_(b); egam[lane] = __expf(g); if (lane == 63) GLAST[cu] = __expf(g); }
#pragma unroll
        for (int m = 0; m < 3; ++m) wl[m * 512 + tid] = wv[m];
        __syncthreads();
        { const float gl = gam[63]; const int rsw = ((wave ^ part) << 3) + r8;
#pragma unroll
          for (int j3 = 0; j3 < 3; ++j3) {
            float y[16];
#pragma unroll
            for (int c = 0; c < 16; ++c) y[c] = 0.f;
#pragma unroll
            for (int k = 0; k < 4; ++k) {                 const LAS f32x4* wp = (const LAS f32x4*)(wl + (j3 * 4 + k) * 128 + d0); const f32x4 w0 = wp[0], w1 = wp[1], w2 = wp[2], w3 = wp[3];
                const u32x4 x0 = xr[j3][k][0], x1 = xr[j3][k][1];
                y[0] += w0[0] * bflo(x0[0]); y[1] += w0[1] * bfhi(x0[0]); y[2] += w0[2] * bflo(x0[1]); y[3] += w0[3] * bfhi(x0[1]);
                y[4] += w1[0] * bflo(x0[2]); y[5] += w1[1] * bfhi(x0[2]); y[6] += w1[2] * bflo(x0[3]); y[7] += w1[3] * bfhi(x0[3]);
                y[8] += w2[0] * bflo(x1[0]); y[9] += w2[1] * bfhi(x1[0]); y[10] += w2[2] * bflo(x1[1]); y[11] += w2[3] * bfhi(x1[1]);
                y[12] += w3[0] * bflo(x1[2]); y[13] += w3[1] * bfhi(x1[2]); y[14] += w3[2] * bflo(x1[3]); y[15] += w3[3] * bfhi(x1[3]); }
#pragma unroll
            for (int c = 0; c < 16; ++c) y[c] = siluf_(y[c]);
            if (j3 == 2) { const float b = bet[i];
#pragma unroll
                for (int c = 0; c < 16; ++c) RT[(d0 + c) * RT_S + rsw] = (bf16_t)f2bf(y[c] * b); }
            else { const bool isq = (j3 == 0); float ss = 0.f;
#pragma unroll
                for (int c = 0; c < 16; ++c) ss += y[c] * y[c];
                ss += __shfl_xor(ss, 1); ss += __shfl_xor(ss, 2); ss += __shfl_xor(ss, 4);
                float rs = 1.f / sqrtf(ss + EPS); if (isq) rs *= 0.08838834764831845f;
                f32x4 v[4];
#pragma unroll
                for (int q = 0; q < 4; ++q) v[q] = (f32x4){y[4 * q] * rs, y[4 * q + 1] * rs, y[4 * q + 2] * rs, y[4 * q + 3] * rs};
                LAS bf16_t* cb = (isq ? qb : kb) + i * RB + d0;
                *(LAS u32x4*)cb = pack8(v[0], v[1]); *(LAS u32x4*)(cb + 8) = pack8(v[2], v[3]);
                if (isq) { const float eq = egam[i];
#pragma unroll
                    for (int q = 0; q < 4; ++q) { u32x2 o; o.x = pk2(v[q][0] * eq, v[q][1] * eq); o.y = pk2(v[q][2] * eq, v[q][3] * eq); *(u32x2*)(rec + 8192 + i * 128 + gdn_pos(i, d0 + 4 * q, 128)) = o; } }
                else { const float be = bet[i] * egam[i], ek = __expf(gl - gam[i]);
#pragma unroll
                    for (int q = 0; q < 4; ++q)
#pragma unroll
                        for (int x = 0; x < 4; ++x) { const int d = d0 + 4 * q + x; RT[(128 + d) * RT_S + rsw] = (bf16_t)f2bf(v[q][x] * be); rec[16384 + d * 64 + gdn_pos(d, i, 64)] = (bf16_t)f2bf(v[q][x] * ek); } } } } }
        __syncthreads();
        }
#pragma unroll 1
        for (int rep_ = 0; rep_ < GP_REP_B; ++rep_) {
        { const int mat = wave >> 2, mi = wave & 3; const LAS bf16_t* Asrc = (mat == 0 ? kb : qb) + (16 * mi + n) * RB + qd * 8;
          bf16x8 af[4];
#pragma unroll
          for (int s2 = 0; s2 < 4; ++s2) af[s2] = *(const LAS bf16x8*)(Asrc + 32 * s2);
          f32x4 cc[4];
#pragma unroll
          for (int mj = 0; mj < 4; ++mj) { cc[mj] = (f32x4){0.f, 0.f, 0.f, 0.f}; const LAS bf16_t* Bsrc = kb + (16 * mj + n) * RB + qd * 8;
#pragma unroll
              for (int s2 = 0; s2 < 4; ++s2) cc[mj] = __builtin_amdgcn_mfma_f32_16x16x32_bf16(af[s2], *(const LAS bf16x8*)(Bsrc + 32 * s2), cc[mj], 0, 0, 0); }
          __syncthreads();
#pragma unroll
          for (int mj = 0; mj < 4; ++mj) { const int j = 16 * mj + n; const float gj = gam[j];
#pragma unroll
              for (int rg = 0; rg < 4; ++rg) { const int i = 16 * mi + 4 * qd + rg; const float dec = (i >= j) ? __expf(gam[i] - gj) : 0.f;
                  if (mat == 0) { Mm[i * MS + j] = (i > j) ? bet[i] * cc[mj][rg] * dec : 0.f; Tm[i * MS + j] = 0.f; }
                  else rec[24576 + i * 64 + gdn_pos(i, j, 64)] = (bf16_t)f2bf(cc[mj][rg] * dec); } } }
        __syncthreads();
        }
#pragma unroll 1
        for (int rep_ = 0; rep_ < GP_REP_C; ++rep_) {
        if (tid < 64) { const int b = tid >> 4, c = tid & 15; float x[16];
#pragma unroll
            for (int r = 0; r < 16; ++r) { float a = (r == c) ? 1.f : 0.f;
#pragma unroll
                for (int j = 0; j < r; ++j) a -= Mm[(16 * b + r) * MS + 16 * b + j] * x[j];
                x[r] = a; }
#pragma unroll
            for (int r = 0; r < 16; ++r) Tm[(16 * b + r) * MS + 16 * b + c] = x[r]; }
        __syncthreads();
#pragma unroll 1
        for (int dl = 1; dl < 4; ++dl) { const int np = 4 - dl;
            for (int e = tid; e < np * 256; e += 512) { const int pr = e >> 8, r = (e >> 4) & 15, c = e & 15, bi = pr + dl, bj = pr; float a = 0.f;
                for (int kb2 = bj; kb2 < bi; ++kb2)
#pragma unroll
                    for (int t = 0; t < 16; ++t) a += Mm[(16 * bi + r) * MS + 16 * kb2 + t] * Tm[(16 * kb2 + t) * MS + 16 * bj + c];
                Pt[e] = a; }
            __syncthreads();
            for (int e = tid; e < np * 256; e += 512) { const int pr = e >> 8, r = (e >> 4) & 15, c = e & 15, bi = pr + dl, bj = pr; float a = 0.f;
#pragma unroll
                for (int t = 0; t < 16; ++t) a += Tm[(16 * bi + r) * MS + 16 * bi + t] * Pt[(pr * 16 + t) * 16 + c];
                Tm[(16 * bi + r) * MS + 16 * bj + c] = -a; }
            __syncthreads(); }
        for (int e = tid; e < 64 * 32; e += 512) { const int i = e >> 5, j2 = (e & 31) * 2; *(LAS unsigned*)(Tb + i * RT_S + j2) = pk2(Tm[i * MS + j2], Tm[i * MS + j2 + 1]); }
        __syncthreads();
        }
#pragma unroll 1
        for (int rep_ = 0; rep_ < GP_REP_D; ++rep_) {
        { bf16x8 tf[4][2];
#pragma unroll
          for (int mi = 0; mi < 4; ++mi)
#pragma unroll
              for (int s2 = 0; s2 < 2; ++s2) tf[mi][s2] = *(const LAS bf16x8*)(Tb + (16 * mi + n) * RT_S + 32 * s2 + qd * 8);
#pragma unroll
          for (int nl = 0; nl < 2; ++nl) { const int c = 16 * (2 * wave + nl) + n; bf16x8 rf[2];
#pragma unroll
              for (int s2 = 0; s2 < 2; ++s2) rf[s2] = *(const LAS bf16x8*)(RT + c * RT_S + (((4 * s2 + qd) ^ ((2 * wave + nl) & 7)) << 3));
#pragma unroll
              for (int mi = 0; mi < 4; ++mi) { f32x4 a = {0.f, 0.f, 0.f, 0.f};
#pragma unroll
                  for (int s2 = 0; s2 < 2; ++s2) a = __builtin_amdgcn_mfma_f32_16x16x32_bf16(tf[mi][s2], rf[s2], a, 0, 0, 0);
                  if (wave < 4) { u32x2 o; o.x = pk2(a[0], a[1]); o.y = pk2(a[2], a[3]); *(u32x2*)(rec + 28672 + c * 64 + 16 * mi + 4 * qd) = o; }
                  else { const int d = c - 128;
#pragma unroll
                      for (int rg = 0; rg < 4; ++rg) { const int i = 16 * mi + 4 * qd + rg; rec[i * 128 + gdn_pos(i, d, 128)] = (bf16_t)f2bf(a[rg]); } } } } }
        }
    }
}

__device__ __forceinline__ void gdn_dma(const bf16_t* rec, LAS unsigned char* buf, int tid, int wave) {
#pragma unroll
    for (int r = 0; r < 7; ++r) __builtin_amdgcn_global_load_lds((const unsigned*)((const char*)rec + r * 8192 + tid * 16), (LAS unsigned*)(buf + r * 8192 + wave * 1024), 16, 0, 0);
}
__device__ __forceinline__ bf16x8 pack_b(const f32x4 v0, const f32x4 v1) { return __builtin_bit_cast(bf16x8, pack8(v0, v1)); }
__device__ __forceinline__ void ph_gdn_chain(Frame& F, int l) {
    const bf16_t* GD = (const bf16_t*)(F.ws + WS_GDN); const float* GLAST = (const float*)(F.ws + WS_GLAST); const bf16_t* P1 = (const bf16_t*)(F.ws + WS_P1); bf16_t* BR = (bf16_t*)(F.ws + WS_BR);
    const float* ng = F.ap->in[I_GNG] + (size_t)l * 128;
    LAS unsigned char* L = F.lds; LAS unsigned char* obuf = L + 2 * 57344;
    const int tid = F.tid, lane = F.lane, w = F.wave, n = lane & 15, qd = lane >> 4;
    float gn[16];
#pragma unroll
    for (int q = 0; q < 16; ++q) gn[q] = ng[(lane & 7) * 16 + q];
    for (int bh = F.bid; bh < BH * 4; bh += F.G) {
        const int bl = bh >> 2, h = bh & 3;
        f32x4 S[8];
#pragma unroll
        for (int m = 0; m < 8; ++m) S[m] = (f32x4){0.f, 0.f, 0.f, 0.f};
        u32x2 up[4]; unsigned zp[8]; float lastp;
        { const bf16_t* rec = GD + (size_t)(bh * 64) * GDN_CH;
#pragma unroll
          for (int m = 0; m < 4; ++m) up[m] = *(const u32x2*)(rec + 28672 + (16 * w + n) * 64 + 16 * m + 4 * qd);
          lastp = GLAST[bh * 64];
          asm volatile("" ::: "memory");
          __syncthreads();
          gdn_dma(rec, L, tid, w); }
#pragma unroll
        for (int rr = 0; rr < 8; ++rr) zp[rr] = 0u;
#define GDN_NORM(chn, zc) do { const int r8 = lane >> 3, part = lane & 7, row = 8 * w + r8; \
            const u32x4 oa = *(const LAS u32x4*)(obuf + row * 256 + part * 32), ob = *(const LAS u32x4*)(obuf + row * 256 + part * 32 + 16); float ss = 0.f; \
            _Pragma("unroll") for (int q = 0; q < 4; ++q) { ss += bflo(oa[q]) * bflo(oa[q]) + bfhi(oa[q]) * bfhi(oa[q]) + bflo(ob[q]) * bflo(ob[q]) + bfhi(ob[q]) * bfhi(ob[q]); } \
            ss += __shfl_xor(ss, 1); ss += __shfl_xor(ss, 2); ss += __shfl_xor(ss, 4); \
            const float rs = 1.f / sqrtf(ss * (1.f / 128.f) + EPS); u32x4 ya, yb; \
            _Pragma("unroll") for (int q = 0; q < 4; ++q) { \
                ya[q] = pk2(bflo(oa[q]) * rs * gn[2 * q] * siluf_(bflo(zc[q])), bfhi(oa[q]) * rs * gn[2 * q + 1] * siluf_(bfhi(zc[q]))); \
                yb[q] = pk2(bflo(ob[q]) * rs * gn[8 + 2 * q] * siluf_(bflo(zc[4 + q])), bfhi(ob[q]) * rs * gn[8 + 2 * q + 1] * siluf_(bfhi(zc[4 + q]))); } \
            bf16_t* dst = BR + ((size_t)bl * T + (chn) * 64 + row) * BRW + 1536 + h * 128 + part * 16; *(u32x4*)dst = ya; *(u32x4*)(dst + 8) = yb; } while (0)
        for (int ch = 0; ch < 64; ++ch) {
            const int cu = bh * 64 + ch, cur = ch & 1;
            asm volatile("s_waitcnt vmcnt(0) lgkmcnt(0)\n\ts_barrier" ::: "memory");
            u32x2 uc[4]; unsigned zc[8]; const float last = lastp;
#pragma unroll
            for (int m = 0; m < 4; ++m) uc[m] = up[m];
#pragma unroll
            for (int rr = 0; rr < 8; ++rr) zc[rr] = zp[rr];
#ifndef REP_NORM
#define REP_NORM 1
#endif
            for (int rp_ = 0; rp_ < REP_NORM; ++rp_) { if (ch > 0) GDN_NORM(ch - 1, zc); }
            { const int cn = (ch + 1 < 64) ? cu + 1 : cu; const bf16_t* rec = GD + (size_t)cn * GDN_CH;
#pragma unroll
                for (int m = 0; m < 4; ++m) up[m] = *(const u32x2*)(rec + 28672 + (16 * w + n) * 64 + 16 * m + 4 * qd);
                lastp = GLAST[cn];
                { const bf16_t* zsrc = P1 + ((size_t)bl * T + ch * 64 + 8 * w + (lane >> 3)) * P1W + C_Z + h * 128 + (lane & 7) * 16; const u32x4 z0 = *(const u32x4*)zsrc, z1 = *(const u32x4*)(zsrc + 8);
#pragma unroll
                  for (int q = 0; q < 4; ++q) { zp[q] = z0[q]; zp[4 + q] = z1[q]; } }
                asm volatile("" ::: "memory");
                if (ch + 1 < 64) gdn_dma(rec, L + (cur ^ 1) * 57344, tid, w); }
            const LAS unsigned char* B = L + cur * 57344;
            const int rb256 = n * 256, rb128 = n * 128; int xo[4], x7[2];
#pragma unroll
            for (int s2 = 0; s2 < 4; ++s2) xo[s2] = ((4 * s2 + qd) ^ n) << 4;
#pragma unroll
            for (int s2 = 0; s2 < 2; ++s2) x7[s2] = ((4 * s2 + qd) ^ (n & 7)) << 4;
#define GF(off) (*(const LAS bf16x8*)(B + (off)))
#define LD_G1(f, m) do { _Pragma("unroll") for (int s2 = 0; s2 < 4; ++s2) { f[s2] = GF((16 * (m)) * 256 + rb256 + xo[s2]); f[4 + s2] = GF(16384 + (16 * (m)) * 256 + rb256 + xo[s2]); } } while (0)
#define MM_G1(f, m) do { _Pragma("unroll") for (int s2 = 0; s2 < 4; ++s2) { WS[m] = __builtin_amdgcn_mfma_f32_16x16x32_bf16(f[s2], Sb[s2], WS[m], 0, 0, 0); QS[m] = __builtin_amdgcn_mfma_f32_16x16x32_bf16(f[4 + s2], Sb[s2], QS[m], 0, 0, 0); } } while (0)
#define LD_AT(f) do { _Pragma("unroll") for (int m = 0; m < 4; ++m) _Pragma("unroll") for (int s2 = 0; s2 < 2; ++s2) f[2 * m + s2] = GF(49152 + (16 * m) * 128 + rb128 + x7[s2]); } while (0)
#define MM_AT(f) do { _Pragma("unroll") for (int m = 0; m < 4; ++m) _Pragma("unroll") for (int s2 = 0; s2 < 2; ++s2) QS[m] = __builtin_amdgcn_mfma_f32_16x16x32_bf16(f[2 * m + s2], Vb[s2], QS[m], 0, 0, 0); } while (0)
#define LD_KT(f, hf) do { _Pragma("unroll") for (int m = 0; m < 4; ++m) _Pragma("unroll") for (int s2 = 0; s2 < 2; ++s2) f[2 * m + s2] = GF(32768 + (16 * (4 * (hf) + m)) * 128 + rb128 + x7[s2]); } while (0)
#define MM_KT(f, hf) do { _Pragma("unroll") for (int m = 0; m < 4; ++m) _Pragma("unroll") for (int s2 = 0; s2 < 2; ++s2) S[4 * (hf) + m] = __builtin_amdgcn_mfma_f32_16x16x32_bf16(f[2 * m + s2], Vb[s2], S[4 * (hf) + m], 0, 0, 0); } while (0)
#define SBAR __builtin_amdgcn_sched_barrier(0)
            bf16x8 Sb[4];
#pragma unroll
            for (int s2 = 0; s2 < 4; ++s2) Sb[s2] = pack_b(S[2 * s2], S[2 * s2 + 1]);
            f32x4 WS[4], QS[4];
#pragma unroll
            for (int m = 0; m < 4; ++m) { WS[m] = (f32x4){0.f, 0.f, 0.f, 0.f}; QS[m] = (f32x4){0.f, 0.f, 0.f, 0.f}; }
            bf16x8 fa[8], fb[8];
            LD_G1(fa, 0); SBAR;
            LD_G1(fb, 1); SBAR; MM_G1(fa, 0); SBAR;
            LD_G1(fa, 2); SBAR; MM_G1(fb, 1); SBAR;
            LD_G1(fb, 3); SBAR; MM_G1(fa, 2); SBAR;
            LD_AT(fa);    SBAR; MM_G1(fb, 3); SBAR;
            f32x4 vn[4];
#pragma unroll
            for (int m = 0; m < 4; ++m) { vn[m][0] = bflo(uc[m].x) - WS[m][0]; vn[m][1] = bfhi(uc[m].x) - WS[m][1]; vn[m][2] = bflo(uc[m].y) - WS[m][2]; vn[m][3] = bfhi(uc[m].y) - WS[m][3]; }
            bf16x8 Vb[2]; Vb[0] = pack_b(vn[0], vn[1]); Vb[1] = pack_b(vn[2], vn[3]);
#pragma unroll
            for (int mk = 0; mk < 8; ++mk) S[mk] = S[mk] * last;
            LD_KT(fb, 0); SBAR; MM_AT(fa); SBAR;
            LD_KT(fa, 1); SBAR; MM_KT(fb, 0); SBAR;
            MM_KT(fa, 1);
#undef GF
#undef LD_G1
#undef MM_G1
#undef LD_AT
#undef MM_AT
#undef LD_KT
#undef MM_KT
#undef SBAR
            asm volatile("s_waitcnt lgkmcnt(0)\n\ts_barrier" ::: "memory");
#pragma unroll
            for (int m = 0; m < 4; ++m)
#pragma unroll
                for (int j = 0; j < 4; ++j) *(LAS bf16_t*)(obuf + ((16 * m + 4 * qd + j) * 128 + 16 * w + n) * 2) = (bf16_t)f2bf(QS[m][j]);
        }
        asm volatile("s_waitcnt vmcnt(0) lgkmcnt(0)\n\ts_barrier" ::: "memory");
        GDN_NORM(63, zp);
#undef GDN_NORM
        asm volatile("s_waitcnt vmcnt(0)" ::: "memory");
        __syncthreads();
    }
}

struct OneUnit { int pm, pn; __device__ bool next(int i, Unit& u) const { if (i != 0) return false; u.pm = pm; u.pn = pn; return true; } };
__device__ __forceinline__ void s5_unit(Frame& F, int g, int bi) {
    float* S = (float*)(F.ws + WS_S5S); bf16_t* S5A = (bf16_t*)(F.ws + WS_S5A); const float* S5P = (const float*)(F.ws + WS_S5P);
    { pg8::Gemm gm{(const bf16_t*)S5A, (const bf16_t*)(F.ws + WS_S5W1), S5LD, 256, 256}; OneUnit U{g * 4 + bi, g}; EpiS5S E{S}; pg8::gemm_phase(F.lds, F.tid, gm, U, E); }
    asm volatile("s_waitcnt vmcnt(0)" ::: "memory"); __syncthreads();
    __builtin_amdgcn_fence(__ATOMIC_ACQUIRE, "agent"); asm volatile("s_waitcnt vmcnt(0)" ::: "memory");
    {
        const int p = F.lane, k = F.wave; const size_t r0 = (size_t)(g * 4 + bi) * 256 + 32 * k;
        const float ar = S5P[g * 128 + p], ai = S5P[g * 128 + 64 + p];
        float sr[32], si[32];
#pragma unroll
        for (int j = 0; j < 32; ++j) { sr[j] = S[(r0 + j) * 128 + p]; si[j] = S[(r0 + j) * 128 + 64 + p]; }
        float lr = 0.f, li = 0.f;
#pragma unroll
        for (int j = 0; j < 32; ++j) { const float xr = sr[j], xi = si[j]; sr[j] = lr; si[j] = li; const float nr = ar * lr - ai * li + xr, ni = ar * li + ai * lr + xi; lr = nr; li = ni; }
        LAS float* ex = (LAS float*)F.lds;
        ex[k * 128 + p] = lr; ex[k * 128 + 64 + p] = li;
        float a32r = ar, a32i = ai;
#pragma unroll
        for (int q = 0; q < 5; ++q) { const float tr = a32r * a32r - a32i * a32i, ti = 2.f * a32r * a32i; a32r = tr; a32i = ti; }
        __syncthreads();
        float cr = 0.f, ci = 0.f;
        for (int k2 = 0; k2 < k; ++k2) { const float er = ex[k2 * 128 + p], ei = ex[k2 * 128 + 64 + p]; const float nr = a32r * cr - a32i * ci + er, ni = a32r * ci + a32i * cr + ei; cr = nr; ci = ni; }
        float pr = 1.f, pi = 0.f;
#pragma unroll
        for (int j = 0; j < 32; ++j) { const float hr = sr[j] + pr * cr - pi * ci, hi = si[j] + pr * ci + pi * cr;
            S5A[(r0 + j) * S5LD + 256 + p] = (bf16_t)f2bf(hr); S5A[(r0 + j) * S5LD + 320 + p] = (bf16_t)f2bf(hi);
            const float tr = pr * ar - pi * ai, ti = pr * ai + pi * ar; pr = tr; pi = ti; }
    }
    asm volatile("s_waitcnt vmcnt(0)" ::: "memory"); __syncthreads();
    __builtin_amdgcn_fence(__ATOMIC_ACQUIRE, "agent"); asm volatile("s_waitcnt vmcnt(0)" ::: "memory");
    { pg8::Gemm gm{(const bf16_t*)S5A, (const bf16_t*)(F.ws + WS_S5T), S5LD, S5LD, S5LD}; OneUnit U{g * 4 + bi, g}; EpiS5Y E{(bf16_t*)(F.ws + WS_YG)}; pg8::gemm_phase(F.lds, F.tid, gm, U, E); }
}

__device__ __forceinline__ unsigned umed3_(unsigned a, unsigned b, unsigned c) { unsigned r; asm("v_med3_u32 %0, %1, %2, %3" : "=v"(r) : "v"(a), "v"(b), "v"(c)); return r; }
template <int NR, bool SURV>
__device__ __forceinline__ void sel_core(const unsigned (&key)[NR], int lane, LAS int* ixo, const LAS int* sidx, unsigned Kt0, int topbit) {
    constexpr int NVB = (NR >= 64) ? 7 : (NR >= 32) ? 6 : (NR >= 16) ? 5 : 4;
    unsigned Kt = Kt0;
    for (int bit = topbit; bit >= 0; --bit) { const unsigned cand = Kt | (1u << bit); unsigned cl = 0u;
#pragma unroll
        for (int i = 0; i < NR; ++i) cl += (key[i] >= cand) ? 1u : 0u;
        int cnt = 0;
#pragma unroll
        for (int b = 0; b < NVB; ++b) cnt += __builtin_popcountll(__ballot((cl >> b) & 1u)) << b;
        if (cnt >= 256) { Kt = cand; if (cnt == 256) break; } }
    int ngt = 0;
    { unsigned cl = 0u;
#pragma unroll
      for (int i = 0; i < NR; ++i) cl += (key[i] > Kt) ? 1u : 0u;
#pragma unroll
      for (int b = 0; b < NVB; ++b) ngt += __builtin_popcountll(__ballot((cl >> b) & 1u)) << b; }
    const int need = 256 - ngt; int pos = 0, ties = 0; const unsigned long long lt = (1ull << lane) - 1ull;
#pragma unroll
    for (int i = 0; i < NR; ++i) { const bool gtk = key[i] > Kt, eq = key[i] == Kt; const unsigned long long mt = __ballot(eq);
        const bool take = gtk || (eq && (ties + __builtin_popcountll(mt & lt)) < need); const unsigned long long mk = __ballot(take);
        if (take) { const int pp = pos + __builtin_popcountll(mk & lt); if (pp < 256) ixo[pp] = SURV ? sidx[i * 64 + lane] : i * 64 + lane; }
        pos += __builtin_popcountll(mk); ties += __builtin_popcountll(mt); }
}
template <int NR>
__device__ __forceinline__ void dsa_select(const LAS float* row, int limit, int lane, LAS int* ixo) {
    unsigned key[NR];
    const int nreg = limit >> 6;
#pragma unroll
    for (int i = 0; i < NR; ++i) { unsigned kx = 0u; if (i < nreg) { const unsigned b = __builtin_bit_cast(unsigned, row[i * 64 + lane]); kx = (b & 0x80000000u) ? ~b : (b | 0x80000000u); } key[i] = kx; }
    WAVE_SYNC();
    if (NR >= 32) {
        unsigned a1 = 0u, a2 = 0u, a3 = 0u, a4 = 0u;
#pragma unroll
        for (int i = 0; i < NR; ++i) { const unsigned k = key[i]; a4 = umed3_(a3, a4, k); a3 = umed3_(a2, a3, k); a2 = umed3_(a1, a2, k); a1 = (a1 > k) ? a1 : k; }
        unsigned L = a4, Mx = a1;
#pragma unroll
        for (int o = 1; o < 64; o <<= 1) { const unsigned x = (unsigned)__shfl_xor((int)L, o); L = (x < L) ? x : L; const unsigned y = (unsigned)__shfl_xor((int)Mx, o); Mx = (y > Mx) ? y : Mx; }
        int S = 0;
#pragma unroll
        for (int i = 0; i < NR; ++i) S += __builtin_popcountll(__ballot(key[i] >= L));
        if (S <= 1024) {
            LAS unsigned* sk = (LAS unsigned*)row + 1024; LAS int* si = (LAS int*)row + 2048; int base = 0;
#pragma unroll
            for (int i = 0; i < NR; ++i) { const bool p = key[i] >= L; const unsigned long long m = __ballot(p);
                if (p) { const int pp = base + (int)__builtin_amdgcn_mbcnt_hi((unsigned)(m >> 32), __builtin_amdgcn_mbcnt_lo((unsigned)m, 0u)); sk[pp] = key[i]; si[pp] = i * 64 + lane; }
                base += __builtin_popcountll(m); }
            WAVE_SYNC();
            const unsigned dx = Mx - L + 1u; const int tb = 31 - __builtin_clz(dx);
            if (S <= 768) { unsigned k2[12];
#pragma unroll
                for (int j = 0; j < 12; ++j) k2[j] = (j * 64 + lane < S) ? sk[j * 64 + lane] - L + 1u : 0u;
                sel_core<12, true>(k2, lane, ixo, si, 0u, tb); }
            else { unsigned k2[16];
#pragma unroll
                for (int j = 0; j < 16; ++j) k2[j] = (j * 64 + lane < S) ? sk[j * 64 + lane] - L + 1u : 0u;
                sel_core<16, true>(k2, lane, ixo, si, 0u, tb); }
            return;
        }
    }
    sel_core<NR, false>(key, lane, ixo, nullptr, 0u, 31);
}
__device__ __forceinline__ float relu_bits(float x) { return __builtin_bit_cast(float, __builtin_elementwise_max(__builtin_bit_cast(int, x), 0)); }
__device__ __forceinline__ void dsa_unit(Frame& F, int un) {
    const bf16_t* P1 = (const bf16_t*)(F.ws + WS_P1); const bf16_t* CN = (const bf16_t*)(F.ws + WS_CN); bf16_t* BR = (bf16_t*)(F.ws + WS_BR);
    LAS float* sc = (LAS float*)F.lds; constexpr int SCS = 4100;
    int lane_ = F.lane; asm volatile("" : "+v"(lane_));
    const int lane = lane_, wave = F.wave, n = lane & 15, qd = lane >> 4;
    const int bl = un & 3, qb = 511 - (un >> 2), t0 = qb * 8, limit = ((t0 >> 6) + 1) * 64;
    const size_t rbase = (size_t)bl * T;
    if (limit > 256) {
        bf16x8 bq[2][2]; float iwv[2];
        { const bf16_t* qp = P1 + (rbase + t0 + (n & 7)) * P1W;
#pragma unroll
          for (int pr = 0; pr < 2; ++pr) { const int hh = 2 * pr + (n >> 3);
#pragma unroll
              for (int ks = 0; ks < 2; ++ks) bq[pr][ks] = *(const bf16x8*)(qp + C_IQ + hh * 64 + ks * 32 + qd * 8);
              iwv[pr] = bf2f(qp[C_IW + hh]) * 0.0625f; } }
        const int nkb = limit >> 4;
        const bf16_t* kbase = (const bf16_t*)(F.ws + WS_IKC) + (rbase >> 4) * 1024 + (qd * 16 + n) * 8;
        bf16x8 a0[4], a1[4], A0[4], A1[4], B0[4], B1[4];
#define DSA_LDK(kb, X0, X1) _Pragma("unroll") for (int u4 = 0; u4 < 4; ++u4) { const bf16_t* kp = kbase + (size_t)((kb) + u4) * 1024; X0[u4] = *(const bf16x8*)kp; X1[u4] = *(const bf16x8*)(kp + 512); }
        auto score = [&](int kb0) {
#pragma unroll
            for (int u4 = 0; u4 < 4; ++u4) { f32x4 sv = {0.f, 0.f, 0.f, 0.f};
#pragma unroll
                for (int pr = 0; pr < 2; ++pr) { f32x4 c = {0.f, 0.f, 0.f, 0.f};
                    c = __builtin_amdgcn_mfma_f32_16x16x32_bf16(a0[u4], bq[pr][0], c, 0, 0, 0); c = __builtin_amdgcn_mfma_f32_16x16x32_bf16(a1[u4], bq[pr][1], c, 0, 0, 0);
#pragma unroll
                    for (int j = 0; j < 4; ++j) sv[j] = fmaf(relu_bits(c[j]), iwv[pr], sv[j]); }
#pragma unroll
                for (int j = 0; j < 4; ++j) { float r; asm("s_nop 1\n\tv_add_f32_dpp %0, %1, %1 row_ror:8 row_mask:0xf bank_mask:0xf" : "=v"(r) : "v"(sv[j])); sv[j] = r; }
                *(LAS f32x4*)(sc + (n & 7) * SCS + (kb0 + u4) * 16 + qd * 4) = sv; }
        };
        if (wave * 4 < nkb) { DSA_LDK(wave * 4, A0, A1) }
        if (wave * 4 + 32 < nkb) { DSA_LDK(wave * 4 + 32, B0, B1) }
        for (int kb0 = wave * 4; kb0 < nkb; kb0 += 64) {
#pragma unroll
            for (int u4 = 0; u4 < 4; ++u4) { a0[u4] = A0[u4]; a1[u4] = A1[u4]; }
            if (kb0 + 64 < nkb) { DSA_LDK(kb0 + 64, A0, A1) }
            score(kb0);
            if (kb0 + 32 < nkb) {
#pragma unroll
                for (int u4 = 0; u4 < 4; ++u4) { a0[u4] = B0[u4]; a1[u4] = B1[u4]; }
                if (kb0 + 96 < nkb) { DSA_LDK(kb0 + 96, B0, B1) }
                score(kb0 + 32); }
        }
#undef DSA_LDK
    }
    __syncthreads();
    LAS float* myrow = sc + wave * SCS; LAS int* ix = (LAS int*)myrow; LAS float* pp = myrow + 256;
    const int qrow = bl * T + t0 + wave; int nv = 256;
    if (limit <= 256) { nv = limit;
#pragma unroll
        for (int r = 0; r < 4; ++r) { const int kk = r * 64 + lane; ix[kk] = (kk < limit) ? kk : 0; } }
    else if (limit <= 1024) dsa_select<16>(myrow, limit, lane, ix);
    else if (limit <= 2048) dsa_select<32>(myrow, limit, lane, ix);
    else if (limit <= 3072) dsa_select<48>(myrow, limit, lane, ix);
    else dsa_select<64>(myrow, limit, lane, ix);
    bf16x8 bq[4];
#pragma unroll
    for (int ks = 0; ks < 4; ++ks) { bf16x8 v = *(const bf16x8*)(P1 + (size_t)qrow * P1W + C_QL + (n & 7) * 128 + ks * 32 + qd * 8); if (n >= 8) v = (bf16x8){0, 0, 0, 0, 0, 0, 0, 0}; bq[ks] = v; }
    WAVE_SYNC();
    LAS unsigned char* tile = (LAS unsigned char*)(myrow + 256);
    constexpr int TS = 272;
    const int grow = lane >> 4, gch = lane & 15;
    u32x4 gA[8], gB[8];
#define DSA_GATHER(g, tt) _Pragma("unroll") for (int i = 0; i < 8; ++i) g[i] = *(const u32x4*)(CN + (rbase + ix[(tt) * 32 + grow + 4 * i]) * 128 + gch * 8);
    DSA_GATHER(gA, 0) DSA_GATHER(gB, 1)
    f32x4 O[8];
#pragma unroll
    for (int rt = 0; rt < 8; ++rt) O[rt] = (f32x4){0.f, 0.f, 0.f, 0.f};
    float mrun = -INFINITY, lrun = 0.f;
    const int trow = 4 * qd + (n >> 2), tcol = (n & 3) * 8;
    auto step = [&](int t, u32x4 (&g)[8]) {
#pragma unroll
        for (int i = 0; i < 8; ++i) *(LAS u32x4*)(tile + (grow + 4 * i) * TS + gch * 16) = g[i];
        if (t < 6) { DSA_GATHER(g, t + 2) }
        WAVE_SYNC();
        f32x4 c[2];
#pragma unroll
        for (int kb2 = 0; kb2 < 2; ++kb2) { c[kb2] = (f32x4){0.f, 0.f, 0.f, 0.f};
#pragma unroll
            for (int ks = 0; ks < 4; ++ks) c[kb2] = __builtin_amdgcn_mfma_f32_16x16x32_bf16(*(const LAS bf16x8*)(tile + (kb2 * 16 + n) * TS + (4 * ks + qd) * 16), bq[ks], c[kb2], 0, 0, 0); }
        float mx = mrun;
#pragma unroll
        for (int kb2 = 0; kb2 < 2; ++kb2)
#pragma unroll
            for (int j = 0; j < 4; ++j) { if (t * 32 + kb2 * 16 + 4 * qd + j >= nv) c[kb2][j] = -INFINITY; mx = fmaxf(mx, c[kb2][j]); }
        mx = fmaxf(mx, __shfl_xor(mx, 16)); mx = fmaxf(mx, __shfl_xor(mx, 32));
        const float scl = __expf(mrun - mx); float ps = 0.f;
#pragma unroll
        for (int kb2 = 0; kb2 < 2; ++kb2)
#pragma unroll
            for (int j = 0; j < 4; ++j) { c[kb2][j] = __expf(c[kb2][j] - mx); ps += c[kb2][j]; }
        ps += __shfl_xor(ps, 16); ps += __shfl_xor(ps, 32);
        lrun = lrun * scl + ps; mrun = mx;
        const bf16x8 pb = pack_b(c[0], c[1]);
#pragma unroll
        for (int rt = 0; rt < 8; ++rt) { O[rt] = O[rt] * scl;
            typedef short v4i16_t __attribute__((ext_vector_type(4)));
            const v4i16_t a0 = __builtin_amdgcn_ds_read_tr16_b64_v4i16((LAS v4i16_t*)(tile + trow * TS + rt * 32 + tcol));
            const v4i16_t a1 = __builtin_amdgcn_ds_read_tr16_b64_v4i16((LAS v4i16_t*)(tile + (16 + trow) * TS + rt * 32 + tcol));
            const bf16x8 af = {a0[0], a0[1], a0[2], a0[3], a1[0], a1[1], a1[2], a1[3]};
            O[rt] = __builtin_amdgcn_mfma_f32_16x16x32_bf16(af, pb, O[rt], 0, 0, 0); }
        WAVE_SYNC();
    };
    for (int t = 0; t < 8; t += 2) {
        if (t * 32 >= nv) break;
        step(t, gA);
        if ((t + 1) * 32 >= nv) break;
        step(t + 1, gB);
    }
#undef DSA_GATHER
    if (n < 8) { const float inv = 1.f / lrun; bf16_t* dst = BR + (size_t)qrow * BRW + n * 128 + 4 * qd;
#pragma unroll
        for (int rt = 0; rt < 8; ++rt) { u32x2 o; o.x = pk2(O[rt][0] * inv, O[rt][1] * inv); o.y = pk2(O[rt][2] * inv, O[rt][3] * inv); *(u32x2*)(dst + rt * 16) = o; } }
#ifdef PROBE_ATT
    WAVE_SYNC();
    {
    bf16x8 bq2[4];
#pragma unroll
    for (int ks = 0; ks < 4; ++ks) { bf16x8 v = *(const bf16x8*)(P1 + (size_t)qrow * P1W + C_QL + (n & 7) * 128 + ks * 32 + qd * 8); if (n >= 8) v = (bf16x8){0, 0, 0, 0, 0, 0, 0, 0}; bq2[ks] = v; }
    WAVE_SYNC();
    LAS float* pp = myrow + 256; f32x4 lg[16];
#pragma unroll
    for (int kb4 = 0; kb4 < 4; ++kb4) { bf16x8 a[4][4];
#pragma unroll
        for (int k2 = 0; k2 < 4; ++k2) { const bf16_t* cp = CN + (rbase + ix[(kb4 * 4 + k2) * 16 + n]) * 128 + qd * 8;
#pragma unroll
            for (int ks = 0; ks < 4; ++ks) a[k2][ks] = *(const bf16x8*)(cp + ks * 32); }
#pragma unroll
        for (int k2 = 0; k2 < 4; ++k2) { f32x4 c = {0.f, 0.f, 0.f, 0.f};
#pragma unroll
            for (int ks = 0; ks < 4; ++ks) c = __builtin_amdgcn_mfma_f32_16x16x32_bf16(a[k2][ks], bq2[ks], c, 0, 0, 0);
            lg[kb4 * 4 + k2] = c; } }
    float mx = -INFINITY;
#pragma unroll
    for (int kb = 0; kb < 16; ++kb)
#pragma unroll
        for (int j = 0; j < 4; ++j) { const int kk = kb * 16 + qd * 4 + j; if (kk >= nv) lg[kb][j] = -INFINITY; mx = fmaxf(mx, lg[kb][j]); }
    mx = fmaxf(mx, __shfl_xor(mx, 16)); mx = fmaxf(mx, __shfl_xor(mx, 32));
    float sm = 0.f;
#pragma unroll
    for (int kb = 0; kb < 16; ++kb)
#pragma unroll
        for (int j = 0; j < 4; ++j) { const float e = __expf(lg[kb][j] - mx); lg[kb][j] = e; sm += e; }
    sm += __shfl_xor(sm, 16); sm += __shfl_xor(sm, 32);
    const float inv = 1.f / sm;
    if (n < 8) {
#pragma unroll
        for (int kb = 0; kb < 16; ++kb)
#pragma unroll
            for (int j = 0; j < 4; ++j) pp[(kb * 16 + qd * 4 + j) * 8 + n] = lg[kb][j] * inv; }
    WAVE_SYNC();
    f32x2 o[8];
#pragma unroll
    for (int hh = 0; hh < 8; ++hh) o[hh] = (f32x2){0.f, 0.f};
    const unsigned* cbase = (const unsigned*)(CN + rbase * 128) + lane;
    unsigned cw[8];
#pragma unroll
    for (int j = 0; j < 8; ++j) { const int key = __builtin_amdgcn_readfirstlane(ix[j]); cw[j] = cbase[(size_t)key * 64]; }
    for (int kk = 0; kk < nv; kk += 8) { unsigned nx[8];
        const int kn = (kk + 8 < nv) ? kk + 8 : kk;
#pragma unroll
        for (int j = 0; j < 8; ++j) { const int key = __builtin_amdgcn_readfirstlane(ix[kn + j]); nx[j] = cbase[(size_t)key * 64]; }
#pragma unroll
        for (int j = 0; j < 8; ++j) { const f32x2 cv = {bflo(cw[j]), bfhi(cw[j])}; const f32x4 pa = *(const LAS f32x4*)(pp + (kk + j) * 8), pb = *(const LAS f32x4*)(pp + (kk + j) * 8 + 4);
#pragma unroll
            for (int hh = 0; hh < 4; ++hh) { o[hh] += cv * pa[hh]; o[4 + hh] += cv * pb[hh]; } }
#pragma unroll
        for (int j = 0; j < 8; ++j) cw[j] = nx[j]; }
#pragma unroll
    for (int hh = 0; hh < 8; ++hh) *((unsigned*)((bf16_t*)(F.ws + WS_MG) + (size_t)qrow * 1024 + hh * 128) + lane) = pk2(o[hh].x, o[hh].y);
    }
#endif
}
__device__ __forceinline__ void ph_dsa(Frame& F, gu32* ctr, int k0, int k1) {
    volatile LAS unsigned* MISC = (volatile LAS unsigned*)(F.lds + MISC_OFF);
    const int hq = (F.bid & 7) >> 1;
    for (int qi = 0; qi < 4; ++qi) { const int q = (hq + qi) & 3;
        for (;;) {
            __syncthreads();
            if (F.tid == 0) MISC[0] = __hip_atomic_fetch_add(ctr + q * 16, 1u, RLX_AGENT);
            __syncthreads();
            const int k = k0 + (int)MISC[0];
            if (k >= k1) break;
            dsa_unit(F, k * 4 + q);
        } }
}

#ifdef PROBE_ATT
constexpr int CW_DIAG = 32768;
__device__ __forceinline__ void ph_att_cmp(Frame& F) {
    gu32* ctl = (gu32*)(F.ws + WS_CTL); const bf16_t* BA = (const bf16_t*)(F.ws + WS_BR); const bf16_t* BB = (const bf16_t*)(F.ws + WS_MG);
    const int gw = F.bid * 8 + F.wave, NGW = F.G * 8, lane = F.lane; float d2 = 0.f, r2 = 0.f;
    for (int q = gw; q < MH; q += NGW)
        for (int c = lane; c < 512; c += 64) { const unsigned wa = *((const unsigned*)(BA + (size_t)q * BRW) + c), wb = *((const unsigned*)(BB + (size_t)q * 1024) + c);
            const float a0 = bflo(wa) - bflo(wb), a1 = bfhi(wa) - bfhi(wb); d2 += a0 * a0 + a1 * a1; r2 += bflo(wb) * bflo(wb) + bfhi(wb) * bfhi(wb); }
    d2 = wave_sum(d2); r2 = wave_sum(r2);
    if (lane == 0) { atomicAdd((float*)(ctl + CW_DIAG + 64), d2); atomicAdd((float*)(ctl + CW_DIAG + 128), r2); }
}
#endif
__device__ __forceinline__ void ph_ffn_act(Frame& F, int l, int q) {
    const bf16_t* RAW = (const bf16_t*)(F.ws + WS_RAW + (size_t)(q & 1) * 88 * MiB); bf16_t* ACT = (bf16_t*)(F.ws + WS_ACT) + (size_t)q * 8192 * DFF;
    const float* cw = F.ap->in[I_FCW] + (size_t)l * 3 * 2 * DFF;
    gu32* ctr = (gu32*)(F.ws + WS_CTL) + CW_Q + (24 + l * 4 + q) * 64;
    volatile LAS unsigned* MISC = (volatile LAS unsigned*)(F.lds + MISC_OFF);
    for (;;) {
        __syncthreads();
        if (F.tid == 0) MISC[0] = __hip_atomic_fetch_add(ctr, 1u, RLX_AGENT);
        __syncthreads();
        const int rg = (int)MISC[0];
        if (rg >= 256) break;
        const int pc = F.tid;
        if (pc < 352) { const int c0 = pc * 8, j = c0 >> 7, i0 = c0 & 127, r0 = rg * 32;
            const bf16_t* gp = RAW + (size_t)r0 * (2 * DFF) + j * 256 + i0; const bf16_t* vp = gp + 128;
            float wg[3][8], wv[3][8];
#pragma unroll
            for (int k = 0; k < 3; ++k)
#pragma unroll
                for (int x = 0; x < 8; ++x) { wg[k][x] = cw[k * 2 * DFF + c0 + x]; wv[k][x] = cw[k * 2 * DFF + DFF + c0 + x]; }
            const bool head = (r0 & 4095) == 0;
            u32x4 g0 = {0, 0, 0, 0}, g1 = {0, 0, 0, 0}, v0 = {0, 0, 0, 0}, v1 = {0, 0, 0, 0};
            if (!head) { g0 = *(const u32x4*)(gp - 2 * (2 * DFF)); g1 = *(const u32x4*)(gp - (2 * DFF)); v0 = *(const u32x4*)(vp - 2 * (2 * DFF)); v1 = *(const u32x4*)(vp - (2 * DFF)); }
            for (int r = 0; r < 32; ++r) { const u32x4 g2 = *(const u32x4*)(gp + (size_t)r * (2 * DFF)), v2 = *(const u32x4*)(vp + (size_t)r * (2 * DFF)); u32x4 o;
#pragma unroll
                for (int w = 0; w < 4; ++w) {
                    const float hg0 = wg[0][2 * w] * bflo(g0[w]) + wg[1][2 * w] * bflo(g1[w]) + wg[2][2 * w] * bflo(g2[w]), hg1 = wg[0][2 * w + 1] * bfhi(g0[w]) + wg[1][2 * w + 1] * bfhi(g1[w]) + wg[2][2 * w + 1] * bfhi(g2[w]);
                    const float hv0 = wv[0][2 * w] * bflo(v0[w]) + wv[1][2 * w] * bflo(v1[w]) + wv[2][2 * w] * bflo(v2[w]), hv1 = wv[0][2 * w + 1] * bfhi(v0[w]) + wv[1][2 * w + 1] * bfhi(v1[w]) + wv[2][2 * w + 1] * bfhi(v2[w]);
                    o[w] = pk2(siluf_(hg0) * hv0, siluf_(hg1) * hv1); }
                *(u32x4*)(ACT + (size_t)(r0 + r) * DFF + c0) = o; g0 = g1; g1 = g2; v0 = v1; v1 = v2; } }
    }
}

__device__ __forceinline__ void ph_ffn_fix(Frame& F, int l) {
    const bf16_t* HALO = (const bf16_t*)(F.ws + WS_FHALO); const bf16_t* FIRST = (const bf16_t*)(F.ws + WS_FFIRST); bf16_t* ACT = (bf16_t*)(F.ws + WS_ACT);
    const float* cw = F.ap->in[I_FCW] + (size_t)l * 3 * 2 * DFF;
    const int gt = F.bid * 512 + F.tid, NT = F.G * 512;
    for (int e = gt; e < 128 * 22 * 16; e += NT) { const int cg = e & 15, pn = (e >> 4) % 22, pm = (e >> 4) / 22, cb = cg * 8;
        if ((pm & 15) == 0) continue;
        const bf16_t* hp = HALO + ((size_t)((pm - 1) * 22 + pn) * 2) * 256 + cb; const bf16_t* fp = FIRST + ((size_t)(pm * 22 + pn) * 2) * 256 + cb;
        const u32x4 hg0 = *(const u32x4*)hp, hg1 = *(const u32x4*)(hp + 256), fg0 = *(const u32x4*)fp, fg1 = *(const u32x4*)(fp + 256);
        const u32x4 hv0 = *(const u32x4*)(hp + 128), hv1 = *(const u32x4*)(hp + 256 + 128), fv0 = *(const u32x4*)(fp + 128), fv1 = *(const u32x4*)(fp + 256 + 128);
        u32x4 o0, o1;
#pragma unroll
        for (int q = 0; q < 4; ++q) { float r0[2], r1[2];
#pragma unroll
            for (int hl = 0; hl < 2; ++hl) { const int c = pn * 128 + cb + 2 * q + hl;
                const float wg0 = cw[c], wg1 = cw[2 * DFF + c], wg2 = cw[4 * DFF + c], wv0 = cw[DFF + c], wv1 = cw[2 * DFF + DFF + c], wv2 = cw[4 * DFF + DFF + c];
                const float Hg0 = hl ? bfhi(hg0[q]) : bflo(hg0[q]), Hg1 = hl ? bfhi(hg1[q]) : bflo(hg1[q]), Fg0 = hl ? bfhi(fg0[q]) : bflo(fg0[q]), Fg1 = hl ? bfhi(fg1[q]) : bflo(fg1[q]);
                const float Hv0 = hl ? bfhi(hv0[q]) : bflo(hv0[q]), Hv1 = hl ? bfhi(hv1[q]) : bflo(hv1[q]), Fv0 = hl ? bfhi(fv0[q]) : bflo(fv0[q]), Fv1 = hl ? bfhi(fv1[q]) : bflo(fv1[q]);
                r0[hl] = siluf_(wg0 * Hg0 + wg1 * Hg1 + wg2 * Fg0) * (wv0 * Hv0 + wv1 * Hv1 + wv2 * Fv0);
                r1[hl] = siluf_(wg0 * Hg1 + wg1 * Fg0 + wg2 * Fg1) * (wv0 * Hv1 + wv1 * Fv0 + wv2 * Fv1); }
            o0[q] = pk2(r0[0], r0[1]); o1[q] = pk2(r1[0], r1[1]); }
        *(u32x4*)(ACT + (size_t)(pm * 256) * DFF + pn * 128 + cb) = o0; *(u32x4*)(ACT + (size_t)(pm * 256 + 1) * DFF + pn * 128 + cb) = o1; }
}

__device__ __forceinline__ void ph_final(Frame& F) {
    float* X = F.ap->out; const float* SS = (const float*)(F.ws + WS_SS); const float* g = F.ap->in[I_FING];
    const int gw = F.bid * 8 + F.wave, NGW = F.G * 8;
    float dscale = 1.f;
#ifdef PROBE_ATT
    { const float* dg = (const float*)((const unsigned*)(F.ws + WS_CTL) + CW_DIAG); dscale = 1.f + sqrtf(dg[64] / fmaxf(dg[128], 1e-30f)); }
#endif
    for (int r = gw; r < M; r += NGW) { const float rs = row_rstd(SS, r) * dscale; f32x4* xr = (f32x4*)(X + (size_t)r * D) + F.lane; const f32x4* gr = (const f32x4*)g + F.lane;
#pragma unroll
        for (int j = 0; j < 4; ++j) { f32x4 v = xr[64 * j]; const f32x4 gg = gr[64 * j]; v = v * rs * gg; xr[64 * j] = v; } }
}

constexpr int DSA_Q1 = 1792;
#ifdef PROBE_ATT
constexpr int PH_PER_HALF = 8,
#else
constexpr int PH_PER_HALF = 7,
#endif
    PH_PER_LAYER = 1 + NHALF * PH_PER_HALF + 3 - (NHALF - 1), NPHASE = NLAYER * PH_PER_LAYER + 1;

__global__ void __launch_bounds__(512, 2) fwd(Args args) {
    extern __shared__ __attribute__((aligned(16))) unsigned char lds_raw[];
    Frame F0;
    F0.lds = (LAS unsigned char*)lds_raw; F0.ap = (CArgs*)__builtin_amdgcn_kernarg_segment_ptr(); F0.ws = nullptr;
    F0.tid = threadIdx.x; F0.lane = F0.tid & 63; F0.wave = __builtin_amdgcn_readfirstlane(F0.tid >> 6); F0.G = gridDim.x; F0.bid = blockIdx.x;
    volatile LAS unsigned* MISC = (volatile LAS unsigned*)(F0.lds + MISC_OFF);
    if (F0.tid < 64) MISC[F0.tid] = 0u;
    __syncthreads();
    const int lo = args.ph_lo, hi = args.ph_hi;
    XcdBarrier bar; bar.bar = (unsigned*)(args.ws + WS_CTL) + CW_BAR; bar.x = 0; bar.st = nullptr;
    if (hi - lo > 1) bar = xcd_barrier_post((unsigned*)(args.ws + WS_CTL) + CW_BAR, MISC + 8);
    int pc = 0;
#ifndef SITE_MASK
#define SITE_MASK 0xFFFFFFFFu
#endif
#ifndef DUP_MASK
#define DUP_MASK 0u
#endif
#define PH_BEGIN(id) if (((SITE_MASK >> (id)) & 1u) && pc >= lo && pc < hi) for (int rep_ = 0, nrep_ = 1 + ((DUP_MASK >> (id)) & 1u); rep_ < nrep_; ++rep_) { Frame F = F0; asm volatile("v_mbcnt_lo_u32_b32 %0, -1, 0\n\tv_mbcnt_hi_u32_b32 %0, -1, %0" : "=v"(F.lane)); asm volatile("" : "+s"(F.ap), "+s"(F.wave)); F.tid = F.wave * 64 + F.lane; F.ws = F.ap->ws; \
        LAS unsigned char* glds = F.lds; bf16_t* XB = (bf16_t*)(F.ws + WS_XB); float* SS = (float*)(F.ws + WS_SS); bf16_t* P1 = (bf16_t*)(F.ws + WS_P1); bf16_t* BR = (bf16_t*)(F.ws + WS_BR); bf16_t* MG = (bf16_t*)(F.ws + WS_MG); \
        (void)glds; (void)XB; (void)SS; (void)P1; (void)BR; (void)MG;
#define PH_END if (pc + 1 < hi || rep_ + 1 < nrep_) xcd_barrier(bar); } ++pc;
#define RELAUNDER do { asm volatile("v_mbcnt_lo_u32_b32 %0, -1, 0\n\tv_mbcnt_hi_u32_b32 %0, -1, %0" : "=v"(F.lane)); asm volatile("" : "+s"(F.ap), "+s"(F.wave)); F.tid = F.wave * 64 + F.lane; F.ws = F.ap->ws; } while (0)

    for (int l = 0; l < NLAYER; ++l) {
        PH_BEGIN(1) ph_wprep(F, l); if (l == 0) ph_x0(F); PH_END
        for (int h = 0; h < NHALF; ++h) {
            const size_t r0 = (size_t)h * MH;
            if (h == 0) {
            PH_BEGIN(2)
                pg8::Gemm g{XB + r0 * D, (const bf16_t*)(F.ws + WS_WIN1), D, D, D}; pg8::StaticOrder S; S.init(MH, P1W, F.G, F.bid);
                EpiNormBf16<2> E{P1, P1W, rstd_table(F, S, SS + r0 * 16), (bf16_t*)(F.ws + WS_S5A), (bf16_t*)(F.ws + WS_IKC)}; pg8::gemm_phase(glds, F.tid, g, S, E);
            PH_END
            }
            PH_BEGIN(3) ph_prep_a(F, l); ph_gdn_prep(F, l); PH_END
            PH_BEGIN(5)
                if (F.bid < 16) ph_gdn_chain(F, l);
                for (int su = (F.bid - 16 + F.G) % F.G; su < 128; su += F.G) s5_unit(F, su >> 2, su & 3);
                RELAUNDER;
                ph_dsa(F, (gu32*)(F.ws + WS_CTL) + CW_Q + ((l * 2 + h) * 2 + 0) * 64, 0, DSA_Q1 / 4);
            PH_END
            PH_BEGIN(10)
                { pg8::Gemm g{(const bf16_t*)(F.ws + WS_YG), (const bf16_t*)(F.ws + WS_WGLU), 512, 512, 512}; pg8::StaticOrder S; S.init(MH, 512, F.G, F.bid);
                  EpiS5G E{(const bf16_t*)(F.ws + WS_YG), BR}; pg8::gemm_phase(glds, F.tid, g, S, E); }
                RELAUNDER;
                ph_dsa(F, (gu32*)(F.ws + WS_CTL) + CW_Q + ((l * 2 + h) * 2 + 1) * 64, DSA_Q1 / 4, 512);
            PH_END
#ifdef PROBE_ATT
            PH_BEGIN(22) ph_att_cmp(F); PH_END
#endif
            PH_BEGIN(13)
                pg8::Gemm g{XB + r0 * D, (const bf16_t*)(F.ws + WS_WIN2), D, D, D}; pg8::StaticOrder S; S.init(MH, GW, F.G, F.bid);
                EpiNormBf16<1> E{P1, GW, rstd_table(F, S, SS + r0 * 16), nullptr, nullptr}; pg8::gemm_phase(glds, F.tid, g, S, E);
            PH_END
            PH_BEGIN(14)
                pg8::Gemm g{BR, (const bf16_t*)(F.ws + WS_WMRG), BRW, BRW, BRW}; pg8::StaticOrder S; S.init(MH, D, F.G, F.bid);
                EpiMerge E{MG, P1}; pg8::gemm_phase(glds, F.tid, g, S, E);
            PH_END
            PH_BEGIN(15)
                pg8::Gemm g{MG, (const bf16_t*)(F.ws + WS_WOUT), D, D, D}; pg8::StaticOrder S; S.init(MH, D, F.G, F.bid);
                float* xf = F.ap->out;
                EpiResid E{(l == 0 ? F.ap->in[I_X] : (const float*)xf) + r0 * D, xf + r0 * D, XB + r0 * D, SS + r0 * 16}; pg8::gemm_phase(glds, F.tid, g, S, E);
                if (h + 1 < NHALF) {
                    RELAUNDER;
                    const size_t r1 = r0 + MH;
                    pg8::Gemm g1{XB + r1 * D, (const bf16_t*)(F.ws + WS_WIN1), D, D, D}; pg8::StaticOrder S1; S1.init(MH, P1W, F.G, F.bid);
                    EpiNormBf16<2> E1{P1, P1W, rstd_table(F, S1, SS + r1 * 16), (bf16_t*)(F.ws + WS_S5A), (bf16_t*)(F.ws + WS_IKC)}; pg8::gemm_phase(glds, F.tid, g1, S1, E1); }
            PH_END
        }
        PH_BEGIN(16)
            pg8::Gemm g{XB, (const bf16_t*)(F.ws + WS_WUP), D, D, D}; pg8::StaticOrder S; S.init(M, 2 * DFF, F.G, F.bid);
            EpiUpConv E{(bf16_t*)(F.ws + WS_ACT), rstd_table(F, S, SS), F.lds + 131072 + 11264, F.ap->in[I_FCW] + (size_t)l * 3 * 2 * DFF, (bf16_t*)(F.ws + WS_FHALO), (bf16_t*)(F.ws + WS_FFIRST)};
            pg8::gemm_phase(glds, F.tid, g, S, E);
        PH_END
        PH_BEGIN(17) ph_ffn_fix(F, l); PH_END
        PH_BEGIN(18)
            pg8::Gemm g{(const bf16_t*)(F.ws + WS_ACT), (const bf16_t*)(F.ws + WS_WDN), DFF, DFF, DFF}; pg8::StaticOrder S; S.init(M, D, F.G, F.bid);
            float* xf = F.ap->out;
            EpiResid E{xf, xf, XB, SS}; pg8::gemm_phase(glds, F.tid, g, S, E);
        PH_END
    }
    PH_BEGIN(19) ph_final(F); PH_END
}

extern "C" void kernel_launch(void* const* d_in, const int* in_sizes, int n_in, void* d_out, int out_size, void* d_ws, size_t ws_size, hipStream_t stream) {
    static int grid = 0;
    if (grid == 0) {
        if (n_in != 28 || in_sizes[0] != M * D || out_size != M * D || ws_size < WS_END) { fprintf(stderr, "kernel_launch: unexpected shapes (n_in %d, ws %zu)\n", n_in, ws_size); grid = -1; return; }
        int dev = 0, cus = 0, per_cu = 0;
        if (hipGetDevice(&dev) != hipSuccess || hipDeviceGetAttribute(&cus, hipDeviceAttributeMultiprocessorCount, dev) != hipSuccess) { grid = -1; return; }
        if (hipFuncSetAttribute((const void*)fwd, hipFuncAttributeMaxDynamicSharedMemorySize, LDS_BYTES) != hipSuccess) { grid = -1; return; }
        if (hipOccupancyMaxActiveBlocksPerMultiprocessor(&per_cu, (const void*)fwd, 512, LDS_BYTES) != hipSuccess || per_cu < 1) fprintf(stderr, "kernel_launch: occupancy query says %d\n", per_cu);
        (void)hipGetLastError();
        grid = cus;
    }
    if (grid < 0) return;
    (void)hipMemsetAsync((char*)d_ws + WS_CTL, 0, CTL_ZERO_BYTES, stream);
    Args a{};
    for (int i = 0; i < 28; ++i) a.in[i] = (const float*)d_in[i];
    a.out = (float*)d_out; a.ws = (unsigned char*)d_ws;
#if MK_ONE_LAUNCH
    a.ph_lo = 0; a.ph_hi = NPHASE;
    hipLaunchKernelGGL(fwd, dim3(grid), dim3(512), LDS_BYTES, stream, a);
#else
    for (int p = 0; p < NPHASE; ++p) { a.ph_lo = p; a.ph_hi = p + 1; hipLaunchKernelGGL(fwd, dim3(grid), dim3(512), LDS_BYTES, stream, a); }
#endif
}
```

```cpp
#include <hip/hip_runtime.h>
#include <cstdio>
#include <cstdint>

#ifndef MK_ONE_LAUNCH
#define MK_ONE_LAUNCH 1
#endif

#define LAS __attribute__((address_space(3)))
#define GAS __attribute__((address_space(1)))
typedef unsigned short bf16_t;
typedef short bf16x8 __attribute__((ext_vector_type(8)));
typedef float f32x4 __attribute__((ext_vector_type(4)));
typedef float f32x2 __attribute__((ext_vector_type(2)));
typedef unsigned u32x4 __attribute__((ext_vector_type(4)));
typedef unsigned u32x2 __attribute__((ext_vector_type(2)));
typedef GAS unsigned gu32;

constexpr int NB = 8, T = 4096, D = 1024, M = NB * T, NHALF = 2, MH = M / NHALF, BH = NB / NHALF;
constexpr int NIN = 6604, DFF = 2816, NLAYER = 2;
constexpr float EPS = 1e-6f;
constexpr int P1W = 4096;
constexpr int C_QL = 0, C_CKV = 1024, C_IQ = 1152, C_IK = 1408, C_IW = 1472, C_CA = 1476, C_CB = 1480, C_S5U = 1536, C_QKV = 2048, C_Z = 3584;
constexpr int GW = 3072;
constexpr int BRW = 2048;
constexpr int S5LD = 384;
constexpr int GDN_CH = 36864;

constexpr size_t MiB = 1u << 20;
constexpr size_t WS_CTL = 0, CTL_ZERO_BYTES = 1 * MiB;
constexpr size_t WS_WIN1 = 1 * MiB, WS_WIN2 = 9 * MiB, WS_WMRG = 15 * MiB, WS_WOUT = 19 * MiB, WS_WUP = 21 * MiB, WS_WDN = 32 * MiB, WS_WGLU = 38 * MiB;
constexpr size_t WS_S5W1 = 39 * MiB, WS_S5T = 43 * MiB, WS_SS = 49 * MiB, WS_S5P = 51 * MiB  ;
constexpr size_t WS_XB = 52 * MiB, WS_P1 = 116 * MiB, WS_BR = 244 * MiB, WS_MG = 308 * MiB, WS_GO = 308 * MiB;
constexpr size_t WS_IDX = 340 * MiB, WS_NV = 348 * MiB, WS_GLAST = 348 * MiB + 512 * 1024, WS_CN = 349 * MiB, WS_S5A = 353 * MiB, WS_S5S = 377 * MiB, WS_YG = 393 * MiB, WS_GDN = 409 * MiB;
constexpr size_t WS_RAW = 116 * MiB  , WS_ACT = 292 * MiB;
constexpr size_t WS_FHALO = 468 * MiB, WS_FFIRST = 472 * MiB;
constexpr size_t WS_IKC = 490 * MiB;
constexpr size_t WS_END = 492 * MiB;
static_assert(WS_GDN + (size_t)1024 * GDN_CH * 2 <= WS_END, "ws map");
static_assert(WS_ACT + (size_t)M * DFF * 2 <= WS_END, "ws map");
constexpr int CW_BAR = 4096;
constexpr int CW_Q = 16384;

constexpr int LDS_BYTES = 147456, MISC_OFF = LDS_BYTES - 256;

#define RLX_AGENT __ATOMIC_RELAXED, __HIP_MEMORY_SCOPE_AGENT
typedef __bf16 bf16x2_t __attribute__((ext_vector_type(2)));
__device__ __forceinline__ unsigned cvt_pk_bf16(float lo, float hi) { const f32x2 v = {lo, hi}; const bf16x2_t b = __builtin_convertvector(v, bf16x2_t); return __builtin_bit_cast(unsigned, b); }
__device__ __forceinline__ unsigned f2bf(float f) { return cvt_pk_bf16(f, 0.f) & 0xffffu; }
__device__ __forceinline__ unsigned pk2(float lo, float hi) { return cvt_pk_bf16(lo, hi); }
__device__ __forceinline__ float bf2f(unsigned short b) { return __builtin_bit_cast(float, (unsigned)b << 16); }
__device__ __forceinline__ float bflo(unsigned w) { return __builtin_bit_cast(float, w << 16); }
__device__ __forceinline__ float bfhi(unsigned w) { return __builtin_bit_cast(float, w & 0xffff0000u); }

__device__ __forceinline__ float wave_sum(float v) {
#pragma unroll
    for (int o = 1; o < 64; o <<= 1) v += __shfl_xor(v, o);
    return v;
}
__device__ __forceinline__ float wave_max(float v) {
#pragma unroll
    for (int o = 1; o < 64; o <<= 1) v = fmaxf(v, __shfl_xor(v, o));
    return v;
}
__device__ __forceinline__ float rcp_(float x) { return __builtin_amdgcn_rcpf(x); }
__device__ __forceinline__ float sigmoidf_(float x) { return 1.f / (1.f + __expf(-x)); }
__device__ __forceinline__ float rcp_nr(float y) { float r = __builtin_amdgcn_rcpf(y); return r * (2.f - y * r); }
__device__ __forceinline__ float sigmoid_nr(float x) { const float y = 1.f + __expf(-x); float r = __builtin_amdgcn_rcpf(y); r = r * (2.f - y * r); return r; }
__device__ __forceinline__ float siluf_(float x) { return x * rcp_(1.f + __expf(-x)); }
__device__ __forceinline__ float gelu_tanh(float x) { const float u2 = 1.5957691216057308f * (x + 0.044715f * x * x * x); return x / (1.f + __expf(-u2)); }
__device__ __forceinline__ float softplusf_(float x) { const float e = __expf(x); const float sm = e * (1.f - e * (0.5f - e * (1.f / 3.f))); return x > 15.f ? x : (e < 1e-2f ? sm : __logf(1.f + e)); }
#define LDS_WAIT() asm volatile("s_waitcnt lgkmcnt(0)" ::: "memory")
#define WAVE_SYNC() do { asm volatile("s_waitcnt lgkmcnt(0)" ::: "memory"); __builtin_amdgcn_wave_barrier(); } while (0)

#define XB_TMO      128
#define XB_XCNT(j)  (256  + 64 * (j))
#define XB_XSUB(j)  (1280 + 64 * (j))
#define XB_XGEN(j)  (2304 + 64 * (j))
#define XB_TOP      3328
#define XB_TOPGEN   3392
#define XCD_BAR_WORDS 3456
#define XB_SPIN_CAP (1u << 22)
__device__ __forceinline__ unsigned xb_ld(unsigned* p)              { return __hip_atomic_load(p, __ATOMIC_RELAXED, __HIP_MEMORY_SCOPE_AGENT); }
__device__ __forceinline__ unsigned xb_add(unsigned* p, unsigned v) { return __hip_atomic_fetch_add(p, v, __ATOMIC_RELAXED, __HIP_MEMORY_SCOPE_AGENT); }
__device__ __forceinline__ unsigned xb_xcc_id() { return (unsigned)__builtin_amdgcn_s_getreg((3 << 11) | 20) & 0xFu; }
#define XB_SPIN(cond, bar) do { unsigned _sp = 0; while (cond) { __builtin_amdgcn_s_sleep(1); \
    if ((++_sp & 255u) == 0u) { if (xb_ld(&(bar)[XB_TMO])) break; if (_sp > XB_SPIN_CAP) { atomicAdd(&(bar)[XB_TMO], 1u); break; } } } } while (0)
struct XcdBarrier { unsigned* bar; unsigned x; volatile LAS unsigned* st; };
__device__ __forceinline__ XcdBarrier xcd_barrier_post(unsigned* bar, volatile LAS unsigned* st) {
    XcdBarrier b; b.bar = bar; b.x = xb_xcc_id(); b.st = st;
    if (threadIdx.x == 0) (void)xb_add(&bar[XB_XCNT(b.x)], 1u);
    return b;
}
__device__ __forceinline__ void xcd_barrier_complete(unsigned* bar, unsigned x, unsigned& nloc, unsigned& nx) {
    const unsigned G = gridDim.x * gridDim.y * gridDim.z;
    unsigned sum, cnt, mine, sp = 0u;
    for (;;) {
        sum = 0u; cnt = 0u; mine = 0u;
#pragma unroll
        for (unsigned j = 0; j < 16; ++j) { const unsigned c = xb_ld(&bar[XB_XCNT(j)]); sum += c; cnt += (c > 0u) ? 1u : 0u; mine = (j == x) ? c : mine; }
        if (sum == G) break;
        __builtin_amdgcn_s_sleep(1);
        if ((++sp & 255u) == 0u) { if (xb_ld(&bar[XB_TMO])) break; if (sp > XB_SPIN_CAP) { atomicAdd(&bar[XB_TMO], 1u); break; } }
    }
    nloc = mine > 0u ? mine : 1u; nx = cnt > 0u ? cnt : 1u;
}
__device__ __forceinline__ void xcd_barrier(const XcdBarrier& b) {
    asm volatile("s_waitcnt vmcnt(0)" ::: "memory");
    __syncthreads();
    if (threadIdx.x == 0) {
        unsigned* bar = b.bar;
        __builtin_amdgcn_s_waitcnt(0);
        unsigned nloc = b.st[0], nx = b.st[1];
        if (nloc == 0u) { xcd_barrier_complete(bar, b.x, nloc, nx); b.st[0] = nloc; b.st[1] = nx; }
        const unsigned old = xb_add(&bar[XB_XSUB(b.x)], 1u);
        const unsigned gen = old / nloc;
        if (old + 1u == (gen + 1u) * nloc) {
            __builtin_amdgcn_fence(__ATOMIC_RELEASE, "agent");
            asm volatile("s_waitcnt vmcnt(0)" ::: "memory");
            const unsigned og = xb_add(&bar[XB_TOP], 1u);
            const unsigned tg = og / nx;
            if (og + 1u == (tg + 1u) * nx) xb_add(&bar[XB_TOPGEN], 1u);
            else XB_SPIN(xb_ld(&bar[XB_TOPGEN]) == tg, bar);
            __builtin_amdgcn_fence(__ATOMIC_ACQUIRE, "agent");
            xb_add(&bar[XB_XGEN(b.x)], 1u);
            asm volatile("s_waitcnt vmcnt(0)" ::: "memory");
        } else {
            XB_SPIN(xb_ld(&bar[XB_XGEN(b.x)]) == gen, bar);
            __builtin_amdgcn_fence(__ATOMIC_ACQUIRE, "agent");
            asm volatile("s_waitcnt vmcnt(0)" ::: "memory");
        }
    }
    __syncthreads();
}

namespace pg8 {
constexpr int BM = 256, BK = 64, HALF = 128, HTB = HALF * BK * 2, NXCD = 8, WGM = 8;
__host__ __device__ __forceinline__ int lds_byte(int r, int c) { const int st = (r >> 4) * 2 + (c >> 5), rr = r & 15, cc = c & 31, ob = rr * 64 + cc * 2; return st * 1024 + (ob ^ (((ob >> 9) & 1) << 5)); }
__host__ __device__ __forceinline__ void stage_rc(int b, int& R, int& C) { const int st = b / 1024, sb = b % 1024, swz = sb ^ (((sb >> 9) & 1) << 5); R = (st >> 1) * 16 + swz / 64; C = (st & 1) * 32 + (swz % 64) / 2; }
__host__ __device__ __forceinline__ int perm32(int rho) { const int n = rho >> 4, i = rho & 15; return 8 * (i >> 2) + 4 * n + (i & 3); }
struct Unit { int pm, pn; };
struct Gemm { const bf16_t* A; const bf16_t* Bt; int lda, ldb, K; };

struct StaticOrder {
    int nM, nN, nwg, G, c;
    __device__ void init(int Mr, int N, int G_, int c_) { nM = Mr / BM; nN = N / BM; nwg = nM * nN; G = G_; c = c_; }
    __device__ bool next(int i, Unit& u) const {
        const long L = (long)i * G + c; if (L >= nwg) return false;
        int wgid = (int)L; { const int q = nwg / NXCD, r = nwg % NXCD, xcd = wgid % NXCD, off = wgid / NXCD; wgid = (xcd < r ? xcd * (q + 1) : r * (q + 1) + (xcd - r) * q) + off; }
        const int nig = WGM * nN, gid = wgid / nig, fm = gid * WGM, gsz = (nM - fm) < WGM ? (nM - fm) : WGM;
        u.pm = fm + ((wgid % nig) % gsz); u.pn = (wgid % nig) / gsz; return true;
    }
};
struct GroupOrder {
    int n, per, G, c;
    __device__ void init(int ngroups, int per_, int G_, int c_) { n = ngroups * per_; per = per_; G = G_; c = c_; }
    __device__ bool next(int i, Unit& u) const { const long L = (long)i * G + c; if (L >= n) return false; u.pm = (int)L; u.pn = (int)L / per; return true; }
};

template <class Epi, class Sched>
__device__ __forceinline__ void gemm_phase(LAS unsigned char* lds, const int tid, const Gemm g, const Sched& S, const Epi& E) {
    const int wid = __builtin_amdgcn_readfirstlane(tid >> 6), lane = tid & 63, wr = wid >> 2, wc = wid & 3, fr = lane & 15, fq = lane >> 4;
    const int K = g.K, nt = K / BK;
    unsigned voffA[2], voffB[2];
#pragma unroll
    for (int i = 0; i < 2; ++i) { int R, C; stage_rc(tid * 16 + i * 8192, R, C); const int Rb = (R & ~31) + perm32(R & 31);
        voffA[i] = (unsigned)(R * g.lda + C) * 2u; voffB[i] = (unsigned)(Rb * g.ldb + C) * 2u; }
    const size_t kstep = (size_t)(BK * 2);
    const size_t hstepA = (size_t)HALF * g.lda * 2, hstepB = (size_t)HALF * g.ldb * 2;
    const size_t tstepA = 2 * hstepA, tstepB = 2 * hstepB;
    const unsigned ldsw = (unsigned)wid * 1024u;
    const int aoff = lds_byte(wr * 64 + fr, fq * 8), boff = lds_byte(wc * 32 + fr, fq * 8);
#define PG8_SA(b, h) (((b) * 2 + (h)) * HTB)
#define PG8_SB(b, h) ((4 + (b) * 2 + (h)) * HTB)
#define PG8_STAGE(bufoff, gbase, voff) do { _Pragma("unroll") for (int _i = 0; _i < 2; ++_i) \
        __builtin_amdgcn_global_load_lds((const unsigned*)((const char*)(gbase) + (voff)[_i]), (LAS unsigned*)(lds + (bufoff) + ldsw + _i * 8192), 16, 0, 0); } while (0)
#define PG8_LDA(dst, b, h) do { _Pragma("unroll") for (int m = 0; m < 4; ++m) _Pragma("unroll") for (int k = 0; k < 2; ++k) dst[m][k] = *(const LAS bf16x8*)(lds + PG8_SA(b, h) + aoff + m * 2048 + k * 1024); } while (0)
#define PG8_LDB(dst, b, h) do { _Pragma("unroll") for (int n = 0; n < 2; ++n) _Pragma("unroll") for (int k = 0; k < 2; ++k) dst[n][k] = *(const LAS bf16x8*)(lds + PG8_SB(b, h) + boff + n * 2048 + k * 1024); } while (0)
#define PG8_MMA(ai, bj, At, Bt) do { __builtin_amdgcn_s_setprio(1); _Pragma("unroll") for (int m = 0; m < 4; ++m) _Pragma("unroll") for (int n = 0; n < 2; ++n) _Pragma("unroll") for (int k = 0; k < 2; ++k) \
        acc[ai][bj][m][n] = __builtin_amdgcn_mfma_f32_16x16x32_bf16(Bt[n][k], At[m][k], acc[ai][bj][m][n], 0, 0, 0); __builtin_amdgcn_s_setprio(0); } while (0)
#define PG8_WAIT_V(n) asm volatile("s_waitcnt vmcnt(" #n ")" ::: "memory")
#define PG8_WAIT_L(n) asm volatile("s_waitcnt lgkmcnt(" #n ")" ::: "memory")
#define PG8_BAR __builtin_amdgcn_s_barrier()
#define PG8_SCHED __builtin_amdgcn_sched_barrier(0)
    Unit cur, nxt; int ui = 0;
    if (!S.next(0, cur)) return;
    f32x4 acc[2][2][4][2];
#pragma unroll
    for (int a = 0; a < 2; ++a)
#pragma unroll
        for (int b = 0; b < 2; ++b)
#pragma unroll
            for (int m = 0; m < 4; ++m)
#pragma unroll
                for (int n = 0; n < 2; ++n) acc[a][b][m][n] = (f32x4){0.f, 0.f, 0.f, 0.f};
    bf16x8 At[4][2], B0[2][2], B1[2][2];
    const char* cA = (const char*)g.A + (size_t)cur.pm * tstepA; const char* cB = (const char*)g.Bt + (size_t)cur.pn * tstepB;
    PG8_STAGE(PG8_SB(0, 0), cB, voffB); PG8_STAGE(PG8_SB(0, 1), cB + hstepB, voffB); PG8_STAGE(PG8_SA(0, 0), cA, voffA); PG8_STAGE(PG8_SA(0, 1), cA + hstepA, voffA);
    if (wr == 1) PG8_BAR;
    PG8_WAIT_V(2); PG8_BAR;
    PG8_STAGE(PG8_SB(1, 0), cB + kstep, voffB); PG8_STAGE(PG8_SA(1, 0), cA + kstep, voffA); PG8_STAGE(PG8_SB(1, 1), cB + hstepB + kstep, voffB);
    PG8_WAIT_V(6); PG8_BAR;
    for (;;) {
        const bool has_next = S.next(ui + 1, nxt);
        const char* nA = has_next ? (const char*)g.A + (size_t)nxt.pm * tstepA : cA; const char* nB = has_next ? (const char*)g.Bt + (size_t)nxt.pn * tstepB : cB;
#pragma unroll 1
        for (int t = 0; t < nt; t += 2) {
            const bool last = (t == nt - 2);
            const char* a1 = cA + (size_t)(t + 1) * kstep;
            const char* a2 = last ? nA : cA + (size_t)(t + 2) * kstep; const char* b2 = last ? nB : cB + (size_t)(t + 2) * kstep;
            const char* a3 = a2 + kstep; const char* b3 = b2 + kstep;
            if constexpr (Epi::HOOK) { if (E.hook_at(t)) E.mid(acc, cur, t, wr, wc, fr, fq); }
            PG8_LDB(B0, 0, 0); PG8_LDB(B1, 0, 1); PG8_SCHED; PG8_LDA(At, 0, 0); PG8_STAGE(PG8_SA(1, 1), a1 + hstepA, voffA);
            PG8_WAIT_V(8); PG8_WAIT_L(0); PG8_BAR; PG8_MMA(0, 0, At, B0); PG8_MMA(0, 1, At, B1); PG8_BAR; PG8_SCHED;
            PG8_LDA(At, 0, 1); PG8_STAGE(PG8_SB(0, 0), b2, voffB); PG8_STAGE(PG8_SB(0, 1), b2 + hstepB, voffB); PG8_STAGE(PG8_SA(0, 0), a2, voffA);
            PG8_WAIT_V(8); PG8_WAIT_L(0); PG8_BAR; PG8_MMA(1, 0, At, B0); PG8_MMA(1, 1, At, B1); PG8_BAR; PG8_SCHED;
            PG8_LDB(B0, 1, 0); PG8_LDB(B1, 1, 1); PG8_SCHED; PG8_LDA(At, 1, 0); PG8_STAGE(PG8_SA(0, 1), a2 + hstepA, voffA);
            PG8_WAIT_V(8); PG8_WAIT_L(0); PG8_BAR; PG8_MMA(0, 0, At, B0); PG8_MMA(0, 1, At, B1); PG8_BAR; PG8_SCHED;
            PG8_LDA(At, 1, 1); PG8_STAGE(PG8_SB(1, 0), b3, voffB); PG8_STAGE(PG8_SB(1, 1), b3 + hstepB, voffB); PG8_STAGE(PG8_SA(1, 0), a3, voffA);
            PG8_WAIT_V(8); PG8_WAIT_L(0); PG8_BAR; PG8_MMA(1, 0, At, B0); PG8_MMA(1, 1, At, B1); PG8_BAR; PG8_SCHED;
        }
        if (wr == 0) PG8_BAR;
        E(acc, cur, ui, wr, wc, fr, fq);
        if (!has_next) break;
#pragma unroll
        for (int a = 0; a < 2; ++a)
#pragma unroll
            for (int b = 0; b < 2; ++b)
#pragma unroll
                for (int m = 0; m < 4; ++m)
#pragma unroll
                    for (int n = 0; n < 2; ++n) acc[a][b][m][n] = (f32x4){0.f, 0.f, 0.f, 0.f};
        cur = nxt; cA = nA; cB = nB; ++ui;
        if (wr == 1) PG8_BAR;
    }
    PG8_WAIT_V(0);
    PG8_BAR;
#undef PG8_SA
#undef PG8_SB
#undef PG8_STAGE
#undef PG8_LDA
#undef PG8_LDB
#undef PG8_MMA
#undef PG8_WAIT_V
#undef PG8_WAIT_L
#undef PG8_BAR
#undef PG8_SCHED
}
}
using pg8::Unit;
typedef f32x4 Acc[2][2][4][2];

__device__ __forceinline__ float row_rstd(const float* SS, int row) {
    const f32x4* p = (const f32x4*)(SS + (size_t)row * 16);
    const f32x4 a = p[0], b = p[1], c = p[2], d = p[3];
    const float s = ((a.x + a.y) + (a.z + a.w)) + ((b.x + b.y) + (b.z + b.w)) + ((c.x + c.y) + (c.z + c.w)) + ((d.x + d.y) + (d.z + d.w));
    return 1.f / sqrtf(s * (1.f / D) + EPS);
}
#define EPI_ROWS_BEGIN int frl_ = fr; asm volatile("" : "+v"(frl_)); const int row0 = u.pm * 256 + wr * 64 + frl_; const int col0 = u.pn * 256 + wc * 32 + 8 * fq; (void)col0; \
    _Pragma("unroll") for (int ai = 0; ai < 2; ++ai) _Pragma("unroll") for (int m = 0; m < 4; ++m) { const int row = row0 + ai * 128 + m * 16;
#define EPI_ROWS_END asm volatile("" ::: "memory"); }
__device__ __forceinline__ u32x4 pack8(const f32x4 v0, const f32x4 v1) { u32x4 w; w.x = cvt_pk_bf16(v0[0], v0[1]); w.y = cvt_pk_bf16(v0[2], v0[3]); w.z = cvt_pk_bf16(v1[0], v1[1]); w.w = cvt_pk_bf16(v1[2], v1[3]); return w; }

template <int ACT> struct EpiNormBf16 {
    static constexpr bool HOOK = false;
    bf16_t* O; int ldo; const LAS float* rsl;
    bf16_t* S5A; bf16_t* IKC;
    __device__ __forceinline__ void operator()(Acc& acc, const Unit& u, int ui, int wr, int wc, int fr, int fq) const {
        EPI_ROWS_BEGIN
            const float rs = rsl[ui * 256 + (row & 255)]; bf16_t* rowp = O + (size_t)row * ldo + col0;
#pragma unroll
            for (int bj = 0; bj < 2; ++bj) { f32x4 v0 = acc[ai][bj][m][0] * rs, v1 = acc[ai][bj][m][1] * rs;
                if (ACT == 1) {
#pragma unroll
                    for (int j = 0; j < 4; ++j) { v0[j] = sigmoid_nr(v0[j]); v1[j] = sigmoid_nr(v1[j]); } }
                const u32x4 w = pack8(v0, v1);
                if (ACT == 2 && (u.pn == 6 || u.pn == 7)) { const int c = col0 + bj * 128 - C_S5U;
                    *(u32x4*)(S5A + ((size_t)(c >> 4) * 1024 + (row >> 4)) * S5LD + (row & 15) * 16 + (c & 15)) = w; }
                else { *(u32x4*)(rowp + bj * 128) = w;
                    if (ACT == 2 && u.pn == 5 && bj == 1 && wc < 2) *(u32x4*)(IKC + (size_t)(row >> 4) * 1024 + ((wc * 4 + fq) * 16 + (row & 15)) * 8) = w; } }
        EPI_ROWS_END
    }
};
struct EpiMerge {
    static constexpr bool HOOK = true;
    bf16_t* O; const bf16_t* Gt;
    __device__ __forceinline__ bool hook_at(int t) const { return t == 16 || t == 24; }
    __device__ __forceinline__ void mid(Acc& acc, const Unit& u, int t, int wr, int wc, int fr, int fq) const {
        const int s0 = (t == 16) ? 0 : 1024;
        int frl_ = fr; asm volatile("" : "+v"(frl_));
        const int row0 = u.pm * 256 + wr * 64 + frl_, col0 = u.pn * 256 + wc * 32 + 8 * fq;
        u32x4 gn[4];
        { const bf16_t* gp = Gt + (size_t)row0 * GW + col0 + s0; gn[0] = *(const u32x4*)gp; gn[1] = *(const u32x4*)(gp + 1024); gn[2] = *(const u32x4*)(gp + 128); gn[3] = *(const u32x4*)(gp + 1152); }
#pragma unroll
        for (int g = 0; g < 8; ++g) { const int ai = g >> 2, m = g & 3; u32x4 gc[4];
#pragma unroll
            for (int q = 0; q < 4; ++q) gc[q] = gn[q];
            if (g < 7) { const int g2 = g + 1; const bf16_t* gp = Gt + (size_t)(row0 + (g2 >> 2) * 128 + (g2 & 3) * 16) * GW + col0 + s0;
                gn[0] = *(const u32x4*)gp; gn[1] = *(const u32x4*)(gp + 1024); gn[2] = *(const u32x4*)(gp + 128); gn[3] = *(const u32x4*)(gp + 1152); }
#pragma unroll
            for (int bj = 0; bj < 2; ++bj) { const u32x4 ga = gc[2 * bj], gb = gc[2 * bj + 1];
#pragma unroll
                for (int q = 0; q < 4; ++q) { const float r0 = bflo(ga[q]) * rcp_nr(bflo(gb[q])), r1 = bfhi(ga[q]) * rcp_nr(bfhi(gb[q]));
                    acc[ai][bj][m][q >> 1][(q & 1) * 2] *= r0; acc[ai][bj][m][q >> 1][(q & 1) * 2 + 1] *= r1; } } }
    }
    __device__ __forceinline__ void operator()(Acc& acc, const Unit& u, int ui, int wr, int wc, int fr, int fq) const {
        int frl_ = fr; asm volatile("" : "+v"(frl_));
        const int row0 = u.pm * 256 + wr * 64 + frl_, col0 = u.pn * 256 + wc * 32 + 8 * fq;
        u32x4 gn[2];
        { const bf16_t* gp = Gt + (size_t)row0 * GW + 2048 + col0; gn[0] = *(const u32x4*)gp; gn[1] = *(const u32x4*)(gp + 128); }
#pragma unroll
        for (int g = 0; g < 8; ++g) { const int ai = g >> 2, m = g & 3, row = row0 + ai * 128 + m * 16; u32x4 gcur[2]; gcur[0] = gn[0]; gcur[1] = gn[1];
            if (g < 7) { const int g2 = g + 1; const bf16_t* gp = Gt + (size_t)(row0 + (g2 >> 2) * 128 + (g2 & 3) * 16) * GW + 2048 + col0; gn[0] = *(const u32x4*)gp; gn[1] = *(const u32x4*)(gp + 128); }
            bf16_t* rowp = O + (size_t)row * 1024 + col0;
#pragma unroll
            for (int bj = 0; bj < 2; ++bj) { const u32x4 gc = gcur[bj]; f32x4 v0 = acc[ai][bj][m][0], v1 = acc[ai][bj][m][1];
                v0[0] *= bflo(gc[0]); v0[1] *= bfhi(gc[0]); v0[2] *= bflo(gc[1]); v0[3] *= bfhi(gc[1]); v1[0] *= bflo(gc[2]); v1[1] *= bfhi(gc[2]); v1[2] *= bflo(gc[3]); v1[3] *= bfhi(gc[3]);
                *(u32x4*)(rowp + bj * 128) = pack8(v0, v1); } }
    }
};
struct EpiResid {
    static constexpr bool HOOK = false;
    float* XF; bf16_t* XB; float* SS; bool wf;
    __device__ __forceinline__ void operator()(Acc& acc, const Unit& u, int ui, int wr, int wc, int fr, int fq) const {
        int frl_ = fr; asm volatile("" : "+v"(frl_));
        const int row0 = u.pm * 256 + wr * 64 + frl_, col0 = u.pn * 256 + wc * 32 + 8 * fq;
        u32x4 xn[2];
        { const size_t off = (size_t)row0 * D + col0; xn[0] = *(const u32x4*)(XB + off); xn[1] = *(const u32x4*)(XB + off + 128); }
#pragma unroll
        for (int g = 0; g < 8; ++g) { const int ai = g >> 2, m = g & 3, row = row0 + ai * 128 + m * 16; const size_t off = (size_t)row * D + col0;
            u32x4 xc[2]; xc[0] = xn[0]; xc[1] = xn[1];
            if (g < 7) { const int g2 = g + 1; const size_t o2 = (size_t)(row0 + (g2 >> 2) * 128 + (g2 & 3) * 16) * D + col0;
                xn[0] = *(const u32x4*)(XB + o2); xn[1] = *(const u32x4*)(XB + o2 + 128); }
            float ss = 0.f;
#pragma unroll
            for (int bj = 0; bj < 2; ++bj) { const u32x4 w = xc[bj];
                const f32x4 v0 = acc[ai][bj][m][0] + (f32x4){bflo(w[0]), bfhi(w[0]), bflo(w[1]), bfhi(w[1])}, v1 = acc[ai][bj][m][1] + (f32x4){bflo(w[2]), bfhi(w[2]), bflo(w[3]), bfhi(w[3])};
                if (wf) { *(f32x4*)(XF + off + bj * 128) = v0; *(f32x4*)(XF + off + bj * 128 + 4) = v1; }
                else *(u32x4*)(XB + off + bj * 128) = pack8(v0, v1);
                ss += (v0[0] * v0[0] + v0[1] * v0[1]) + (v0[2] * v0[2] + v0[3] * v0[3]) + (v1[0] * v1[0] + v1[1] * v1[1]) + (v1[2] * v1[2] + v1[3] * v1[3]); }
            ss += __shfl_xor(ss, 16); ss += __shfl_xor(ss, 32);
            if (fq == 0) SS[(size_t)row * 16 + u.pn * 4 + wc] = ss; }
    }
};
struct EpiUpConv {
    static constexpr bool HOOK = false;
    bf16_t* ACT; const LAS float* rsl; LAS unsigned char* hal; const float* cw; bf16_t* HALO; bf16_t* FIRST;
    __device__ __forceinline__ void operator()(Acc& acc, const Unit& u, int ui, int wr, int wc, int fr, int fq) const {
        int frl_ = fr, fql_ = fq; asm volatile("" : "+v"(frl_), "+v"(fql_));
        const int f = frl_, cb = wc * 32 + 8 * fql_;
#pragma unroll
        for (int ai = 0; ai < 2; ++ai)
#pragma unroll
            for (int m = 0; m < 4; ++m) { const float rs = rsl[ui * 256 + ai * 128 + wr * 64 + m * 16 + f];
#pragma unroll
                for (int bj = 0; bj < 2; ++bj) { acc[ai][bj][m][0] = acc[ai][bj][m][0] * rs; acc[ai][bj][m][1] = acc[ai][bj][m][1] * rs; } }
        if (f >= 14) {
#pragma unroll
            for (int ai = 0; ai < 2; ++ai)
#pragma unroll
                for (int bj = 0; bj < 2; ++bj) { const u32x4 w = pack8(acc[ai][bj][3][0], acc[ai][bj][3][1]);
                    *(LAS u32x4*)(hal + (((ai * 2 + wr) * 2 + (f - 14)) * 256 + bj * 128 + cb) * 2) = w;
                    if (ai == 1 && wr == 1) *(u32x4*)(HALO + ((size_t)(u.pm * 22 + u.pn) * 2 + (f - 14)) * 256 + bj * 128 + cb) = w; } }
        if (f < 2 && wr == 0) {
#pragma unroll
            for (int bj = 0; bj < 2; ++bj) *(u32x4*)(FIRST + ((size_t)(u.pm * 22 + u.pn) * 2 + f) * 256 + bj * 128 + cb) = pack8(acc[0][bj][0][0], acc[0][bj][0][1]); }
        asm volatile("s_waitcnt lgkmcnt(0)\n\ts_barrier" ::: "memory");
        float wg[3][8], wv[3][8];
        { const float* cp = cw + u.pn * 128 + cb;
#pragma unroll
          for (int k = 0; k < 3; ++k) { const f32x4 a0 = *(const f32x4*)(cp + k * 2 * DFF), a1 = *(const f32x4*)(cp + k * 2 * DFF + 4), b0 = *(const f32x4*)(cp + k * 2 * DFF + DFF), b1 = *(const f32x4*)(cp + k * 2 * DFF + DFF + 4);
#pragma unroll
              for (int x = 0; x < 4; ++x) { wg[k][x] = a0[x]; wg[k][4 + x] = a1[x]; wv[k][x] = b0[x]; wv[k][4 + x] = b1[x]; } } }
#pragma unroll
        for (int ai = 0; ai < 2; ++ai) {
            f32x4 pv[2][2];
            { const bool has = !(ai == 0 && wr == 0); const int ps = (wr == 1) ? ai * 2 : 1;
#pragma unroll
              for (int bj = 0; bj < 2; ++bj) { u32x4 w = {0u, 0u, 0u, 0u}; if (has && f >= 14) w = *(const LAS u32x4*)(hal + ((ps * 2 + (f - 14)) * 256 + bj * 128 + cb) * 2);
                  pv[bj][0] = (f32x4){bflo(w[0]), bfhi(w[0]), bflo(w[1]), bfhi(w[1])}; pv[bj][1] = (f32x4){bflo(w[2]), bfhi(w[2]), bflo(w[3]), bfhi(w[3])}; } }
#pragma unroll
            for (int m = 0; m < 4; ++m) { float hg[8], hv[8];
#pragma unroll
                for (int bj = 0; bj < 2; ++bj)
#pragma unroll
                    for (int n2 = 0; n2 < 2; ++n2)
#pragma unroll
                        for (int x = 0; x < 4; ++x) { const float cur = acc[ai][bj][m][n2][x], prv = (m == 0) ? pv[bj][n2][x] : acc[ai][bj][m - 1][n2][x];
                            const float t1 = (f == 15) ? prv : cur, t2 = (f >= 14) ? prv : cur;
                            const float p1 = __builtin_bit_cast(float, __builtin_amdgcn_update_dpp(0, __builtin_bit_cast(int, t1), 0x121, 0xf, 0xf, false));
                            const float p2 = __builtin_bit_cast(float, __builtin_amdgcn_update_dpp(0, __builtin_bit_cast(int, t2), 0x122, 0xf, 0xf, false)); const int c = 4 * n2 + x;
                            const float hh = (bj == 0 ? wg[0][c] : wv[0][c]) * p2 + (bj == 0 ? wg[1][c] : wv[1][c]) * p1 + (bj == 0 ? wg[2][c] : wv[2][c]) * cur;
                            if (bj == 0) hg[c] = hh; else hv[c] = hh; }
                u32x4 o;
#pragma unroll
                for (int q = 0; q < 4; ++q) o[q] = pk2(siluf_(hg[2 * q]) * hv[2 * q], siluf_(hg[2 * q + 1]) * hv[2 * q + 1]);
                *(u32x4*)(ACT + (size_t)(u.pm * 256 + ai * 128 + wr * 64 + m * 16 + f) * DFF + u.pn * 128 + cb) = o; } }
    }
};
struct EpiS5S {
    static constexpr bool HOOK = false;
    float* S;
    __device__ __forceinline__ void operator()(Acc& acc, const Unit& u, int ui, int wr, int wc, int fr, int fq) const {
        int frl_ = fr; asm volatile("" : "+v"(frl_));
        const int row0 = u.pm * 256 + wr * 64 + frl_, c0 = wc * 32 + 8 * fq;
#pragma unroll
        for (int ai = 0; ai < 2; ++ai)
#pragma unroll
            for (int m = 0; m < 4; ++m) { float* p = S + (size_t)(row0 + ai * 128 + m * 16) * 128 + c0; *(f32x4*)p = acc[ai][0][m][0]; *(f32x4*)(p + 4) = acc[ai][0][m][1]; }
    }
};
struct EpiS5Y {
    static constexpr bool HOOK = false;
    bf16_t* YG;
    __device__ __forceinline__ void operator()(Acc& acc, const Unit& u, int ui, int wr, int wc, int fr, int fq) const {
        int frl_ = fr; asm volatile("" : "+v"(frl_));
        const int g = u.pn, rg0 = (u.pm & 3) * 256 + wr * 64 + frl_;
#pragma unroll
        for (int ai = 0; ai < 2; ++ai)
#pragma unroll
            for (int m = 0; m < 4; ++m) { const int rg = rg0 + ai * 128 + m * 16;
#pragma unroll
                for (int bj = 0; bj < 2; ++bj) { const int c = bj * 128 + wc * 32 + 8 * fq, t = c >> 4, ch = c & 15; f32x4 v0 = acc[ai][bj][m][0], v1 = acc[ai][bj][m][1];
#pragma unroll
                    for (int j = 0; j < 4; ++j) { v0[j] = gelu_tanh(v0[j]); v1[j] = gelu_tanh(v1[j]); }
                    *(u32x4*)(YG + (size_t)(rg * 16 + t) * 512 + g * 16 + ch) = pack8(v0, v1); } asm volatile("" ::: "memory"); }
    }
};
struct EpiS5G {
    static constexpr bool HOOK = false;
    const bf16_t* YG; bf16_t* BR;
    __device__ __forceinline__ void operator()(Acc& acc, const Unit& u, int ui, int wr, int wc, int fr, int fq) const {
        EPI_ROWS_BEGIN
#pragma unroll
            for (int bj = 0; bj < 2; ++bj) { const u32x4 y = *(const u32x4*)(YG + (size_t)row * 512 + col0 + bj * 128); f32x4 v0 = acc[ai][bj][m][0], v1 = acc[ai][bj][m][1];
                v0[0] = bflo(y[0]) * sigmoidf_(v0[0]); v0[1] = bfhi(y[0]) * sigmoidf_(v0[1]); v0[2] = bflo(y[1]) * sigmoidf_(v0[2]); v0[3] = bfhi(y[1]) * sigmoidf_(v0[3]);
                v1[0] = bflo(y[2]) * sigmoidf_(v1[0]); v1[1] = bfhi(y[2]) * sigmoidf_(v1[1]); v1[2] = bflo(y[3]) * sigmoidf_(v1[2]); v1[3] = bfhi(y[3]) * sigmoidf_(v1[3]);
                *(u32x4*)(BR + (size_t)row * BRW + 1024 + col0 + bj * 128) = pack8(v0, v1); }
        EPI_ROWS_END
    }
};

struct Args { const float* in[28]; float* out; unsigned char* ws; int ph_lo, ph_hi; };
typedef const __attribute__((address_space(4))) Args CArgs;
struct Frame {
    LAS unsigned char* lds;
    CArgs* ap;
    unsigned char* ws;
    int tid, lane, wave, G, bid;
};
enum { I_X = 0, I_ANG, I_WIN, I_KVG, I_WUK, I_WUV, I_WPA, I_S5ARE, I_S5AIM, I_S5LDT, I_S5BRE, I_S5BIM, I_S5CRE, I_S5CIM, I_S5D, I_WGLU, I_WPB, I_GCW, I_GALOG, I_GDTB, I_GNG, I_WPC, I_WOUT, I_FNG, I_WUP, I_FCW, I_WDN, I_FING };

template <class Sched> __device__ __forceinline__ const LAS float* rstd_table(Frame& F, const Sched& S, const float* SS) {
    LAS float* rsl = (LAS float*)(F.lds + 131072); Unit u;
    for (int i = 0; S.next(i, u); ++i) for (int r = F.tid; r < 256; r += 512) rsl[i * 256 + r] = row_rstd(SS, u.pm * 256 + r);
    __syncthreads();
    return rsl;
}
__device__ __forceinline__ void ph_x0(Frame& F) {
    const float* x = F.ap->in[I_X]; bf16_t* XB = (bf16_t*)(F.ws + WS_XB); float* SS = (float*)(F.ws + WS_SS);
    const int gw = F.bid * 8 + F.wave, NGW = F.G * 8;
    for (int r = gw; r < M; r += NGW) {
        const f32x4* xr = (const f32x4*)(x + (size_t)r * D) + F.lane; float s = 0.f; f32x4 v[4];
#pragma unroll
        for (int j = 0; j < 4; ++j) { v[j] = xr[64 * j]; s += (v[j].x * v[j].x + v[j].y * v[j].y) + (v[j].z * v[j].z + v[j].w * v[j].w); }
        s = wave_sum(s);
        u32x2* o = (u32x2*)(XB + (size_t)r * D) + F.lane;
#pragma unroll
        for (int j = 0; j < 4; ++j) { u32x2 w; w.x = pk2(v[j].x, v[j].y); w.y = pk2(v[j].z, v[j].w); o[64 * j] = w; }
        if (F.lane < 16) SS[(size_t)r * 16 + F.lane] = (F.lane == 0) ? s : 0.f;
    }
}

__device__ __forceinline__ int win1_col(int n) {
    if (n < 1152) return 512 + (n - 1024);
    if (n < 1408) return 640 + (n - 1152);
    if (n < 1472) return 896 + (n - 1408);
    if (n < 1476) return 960 + (n - 1472);
    if (n < 1480) return 3524 + (n - 1476);
    if (n < 1484) return 3528 + (n - 1480);
    if (n < 1536) return -1;
    if (n < 2048) return 964 + (n - 1536);
    if (n < 3584) return 1476 + (n - 2048);
    return 3012 + (n - 3584);
}
__device__ __forceinline__ int wup_col(int n) { const int j = n >> 8, bj = (n >> 7) & 1, i = n & 127; return bj * DFF + j * 128 + i; }
__device__ __forceinline__ void tr_one(int lane, int it, const float* src, int sld, const float* scale, bf16_t* dst, int dld, int koff, int n0, int nn, int kind, LAS float* scr) {
    const int nblk = nn / 32;
    const int kb = it / nblk, nb = it % nblk, k0 = kb * 64, nbase = n0 + nb * 32, r8 = lane >> 3, c4 = lane & 7, n = nbase + 4 * c4;
    int col = n; if (kind == 1) col = win1_col(n); else if (kind == 2) col = 3532 + n; else if (kind == 3) col = wup_col(n);
    f32x4 v[8]; float sc[8];
    const float* sp = src + (size_t)(k0 + r8) * sld + (col >= 0 ? col : 0);
#pragma unroll
    for (int i = 0; i < 8; ++i) v[i] = *(const f32x4*)(sp + (size_t)(8 * i) * sld);
#pragma unroll
    for (int i = 0; i < 8; ++i) sc[i] = scale ? scale[k0 + 8 * i + r8] : 1.f;
    if (col < 0) {
#pragma unroll
        for (int i = 0; i < 8; ++i) sc[i] = 0.f; }
#pragma unroll
    for (int i = 0; i < 8; ++i) { LAS float* d = scr + (8 * i + r8) * 33 + 4 * c4; d[0] = v[i][0] * sc[i]; d[1] = v[i][1] * sc[i]; d[2] = v[i][2] * sc[i]; d[3] = v[i][3] * sc[i]; }
    WAVE_SYNC();
    const int c = lane & 7;
#pragma unroll
    for (int j = 0; j < 4; ++j) { const int nl = (lane >> 3) + 8 * j; const LAS float* s = scr + (8 * c) * 33 + nl;
        u32x4 o; o.x = pk2(s[0 * 33], s[1 * 33]); o.y = pk2(s[2 * 33], s[3 * 33]); o.z = pk2(s[4 * 33], s[5 * 33]); o.w = pk2(s[6 * 33], s[7 * 33]);
        *(u32x4*)(dst + (size_t)(nbase + nl) * dld + koff + k0 + 8 * c) = o; }
    WAVE_SYNC();
}
__device__ __forceinline__ void ph_wprep(Frame& F, int l) {
    LAS float* L = (LAS float*)F.lds;
    const float* w_in = F.ap->in[I_WIN] + (size_t)l * D * NIN; const float* ang = F.ap->in[I_ANG] + (size_t)l * D;
    bf16_t* WIN1 = (bf16_t*)(F.ws + WS_WIN1); bf16_t* WMRG = (bf16_t*)(F.ws + WS_WMRG);
    for (int pass = 0; pass * F.G < 320; ++pass) {
        int it = F.bid + pass * F.G;
        if (F.G == 256 && pass == 1) it = (F.bid >= 64 && F.bid < 128) ? F.bid + 192 : 320;
        if (it >= 320) continue;
        __syncthreads();
        if (it >= 64 && it < 192) {
            const int j = it - 64, h = j >> 4, k0 = (j & 15) * 64; const float* wuk = F.ap->in[I_WUK] + (size_t)l * 128 * 512;
            LAS float* A = L; LAS float* Bm = L + 64 * 65;
            for (int e = F.tid; e < 64 * 64; e += 512) { const int kk = e >> 6, d = e & 63; A[kk * 65 + d] = w_in[(size_t)(k0 + kk) * NIN + h * 64 + d] * ang[k0 + kk] * 0.125f; }
            for (int e = F.tid; e < 128 * 64; e += 512) { const int r = e >> 6, d = e & 63; Bm[r * 65 + d] = wuk[(size_t)r * 512 + h * 64 + d]; }
            __syncthreads();
            for (int e = F.tid; e < 128 * 64; e += 512) { const int r = e >> 6, kk = e & 63; float s = 0.f;
#pragma unroll 16
                for (int d = 0; d < 64; ++d) s += A[kk * 65 + d] * Bm[r * 65 + d];
                WIN1[(size_t)(h * 128 + r) * D + k0 + kk] = (bf16_t)f2bf(s); }
        } else if (it >= 192) {
            const int j = it - 192, h = j >> 4, n0 = (j & 15) * 64; const float* wuv = F.ap->in[I_WUV] + (size_t)l * 128 * 512; const float* wpa = F.ap->in[I_WPA] + (size_t)l * 512 * D;
            LAS float* A = L; LAS float* Bm = L + 64 * 65;
            for (int e = F.tid; e < 64 * 64; e += 512) { const int d = e >> 6, nn = e & 63; A[d * 65 + nn] = wpa[(size_t)(h * 64 + d) * D + n0 + nn]; }
            for (int e = F.tid; e < 128 * 64; e += 512) { const int r = e >> 6, d = e & 63; Bm[r * 65 + d] = wuv[(size_t)r * 512 + h * 64 + d]; }
            __syncthreads();
            for (int e = F.tid; e < 128 * 64; e += 512) { const int nn = e >> 7, r = e & 127; float s = 0.f;
#pragma unroll 16
                for (int d = 0; d < 64; ++d) s += A[d * 65 + nn] * Bm[r * 65 + d];
                WMRG[(size_t)(n0 + nn) * BRW + h * 128 + r] = (bf16_t)f2bf(s); }
        } else {
            const int g = it >> 1, hf = it & 1;
            const float* are = F.ap->in[I_S5ARE] + (size_t)l * 2048 + g * 64; const float* aim = F.ap->in[I_S5AIM] + (size_t)l * 2048 + g * 64;
            const float dt = __expf(F.ap->in[I_S5LDT][l * 32 + g]);
            const float* bre = F.ap->in[I_S5BRE] + (size_t)l * 32768 + g * 1024; const float* bim = F.ap->in[I_S5BIM] + (size_t)l * 32768 + g * 1024;
            const float* cre = F.ap->in[I_S5CRE] + (size_t)l * 32768 + g * 1024; const float* cim = F.ap->in[I_S5CIM] + (size_t)l * 32768 + g * 1024;
            const float* dd = F.ap->in[I_S5D] + (size_t)l * 512 + g * 16;
            LAS float* PWR = L;
            LAS float* PWI = L + 1088;
            LAS float* BBR = L + 2176;
            LAS float* BBI = BBR + 1024;
            LAS float* CR = BBI + 1024;
            LAS float* CI = CR + 1024;
            LAS float* KT = CI + 1024;
            for (int e = F.tid; e < 17 * 64; e += 512) { const int j = e >> 6, p = e & 63; const float mag = expf(dt * are[p] * (float)j), a = dt * aim[p] * (float)j; PWR[e] = mag * cosf(a); PWI[e] = mag * sinf(a); }
            for (int e = F.tid; e < 1024; e += 512) { const int p = e >> 4; const float ar = are[p], ai = aim[p];
                const float mag = expf(dt * ar), a = dt * ai, abr = mag * cosf(a), abi = mag * sinf(a), den = ar * ar + ai * ai, nr = abr - 1.f;
                const float fre = (nr * ar + abi * ai) / den, fim = (abi * ar - nr * ai) / den;
                BBR[e] = fre * bre[e] - fim * bim[e]; BBI[e] = fre * bim[e] + fim * bre[e]; CR[e] = cre[e]; CI[e] = cim[e]; }
            __syncthreads();
            for (int e = F.tid; e < 4096; e += 512) { const int j = e >> 8, m = (e >> 4) & 15, mp = e & 15; float s = 0.f;
                for (int p = 0; p < 64; ++p) { const float cr = CR[m * 64 + p], ci = CI[m * 64 + p], pr = PWR[j * 64 + p], pi = PWI[j * 64 + p], br = BBR[p * 16 + mp], bi = BBI[p * 16 + mp];
                    const float zr = cr * pr - ci * pi, zi = cr * pi + ci * pr; s += zr * br - zi * bi; }
                KT[e] = s; }
            __syncthreads();
            bf16_t* W1 = (bf16_t*)(F.ws + WS_S5W1) + (size_t)g * 256 * 256; bf16_t* TT = (bf16_t*)(F.ws + WS_S5T) + (size_t)g * 256 * 384;
            for (int e = hf * 32768 + F.tid; e < (hf + 1) * 32768; e += 512) { const int n = e >> 8, k = e & 255; float v = 0.f;
                if (n < 128) { const int p = n & 63, s = k >> 4, m = k & 15, j = 15 - s; const float pr = PWR[j * 64 + p], pi = PWI[j * 64 + p], br = BBR[p * 16 + m], bi = BBI[p * 16 + m];
                    v = (n < 64) ? (pr * br - pi * bi) : (pr * bi + pi * br); }
                W1[e] = (bf16_t)f2bf(v); }
            for (int e = hf * 49152 + F.tid; e < (hf + 1) * 49152; e += 512) { const int n = e / 384, k = e % 384, t = n >> 4, m = n & 15; float v = 0.f;
                if (k < 256) { const int s = k >> 4, mp = k & 15; if (s <= t) { v = KT[((t - s) * 16 + m) * 16 + mp]; if (s == t && m == mp) v += dd[m]; } }
                else { const int p = (k - 256) & 63; const float cr = CR[m * 64 + p], ci = CI[m * 64 + p], pr = PWR[(t + 1) * 64 + p], pi = PWI[(t + 1) * 64 + p];
                    v = (k < 320) ? (cr * pr - ci * pi) : -(cr * pi + ci * pr); }
                TT[e] = (bf16_t)f2bf(v); }
            float* S5P = (float*)(F.ws + WS_S5P) + (size_t)g * 128;
            if (hf == 0) for (int e = F.tid; e < 64; e += 512) { S5P[e] = PWR[16 * 64 + e]; S5P[64 + e] = PWI[16 * 64 + e]; }
        }
    }
    __syncthreads();
    LAS float* scr = (LAS float*)(F.lds + F.wave * 16384);
    gu32* ctr = (gu32*)(F.ws + WS_CTL) + CW_Q + (16 + l) * 64;
    constexpr int N0 = 1536, N1 = N0 + 1536, N2 = N1 + 256, N3 = N2 + 256, N4 = N3 + 512, N5 = N4 + 2816, N6 = N5 + 1408, N7 = N6 + 128;
    for (;;) {
        unsigned gi = 0u; if (F.lane == 0) gi = __hip_atomic_fetch_add(ctr, 8u, RLX_AGENT);
        const int it0 = __builtin_amdgcn_readfirstlane((int)gi);
        if (it0 >= N7) break;
#pragma unroll 1
        for (int it = it0; it < it0 + 8 && it < N7; ++it) {
        if (it < N0) tr_one(F.lane, it, w_in, NIN, ang, WIN1, D, 0, 1024, 3072, 1, scr);
        else if (it < N1) tr_one(F.lane, it - N0, w_in, NIN, ang, (bf16_t*)(F.ws + WS_WIN2), D, 0, 0, GW, 2, scr);
        else if (it < N2) tr_one(F.lane, it - N1, F.ap->in[I_WPB] + (size_t)l * 512 * D, D, nullptr, WMRG, BRW, 1024, 0, D, 0, scr);
        else if (it < N3) tr_one(F.lane, it - N2, F.ap->in[I_WPC] + (size_t)l * 512 * D, D, nullptr, WMRG, BRW, 1536, 0, D, 0, scr);
        else if (it < N4) tr_one(F.lane, it - N3, F.ap->in[I_WOUT] + (size_t)l * D * D, D, nullptr, (bf16_t*)(F.ws + WS_WOUT), D, 0, 0, D, 0, scr);
        else if (it < N5) tr_one(F.lane, it - N4, F.ap->in[I_WUP] + (size_t)l * D * 2 * DFF, 2 * DFF, F.ap->in[I_FNG] + (size_t)l * D, (bf16_t*)(F.ws + WS_WUP), D, 0, 0, 2 * DFF, 3, scr);
        else if (it < N6) tr_one(F.lane, it - N5, F.ap->in[I_WDN] + (size_t)l * DFF * D, D, nullptr, (bf16_t*)(F.ws + WS_WDN), DFF, 0, 0, D, 0, scr);
        else tr_one(F.lane, it - N6, F.ap->in[I_WGLU] + (size_t)l * 512 * 512, 512, nullptr, (bf16_t*)(F.ws + WS_WGLU), 512, 0, 0, 512, 0, scr);
        }
    }
}

__device__ __forceinline__ void ph_prep_a(Frame& F, int l) {
    const bf16_t* P1 = (const bf16_t*)(F.ws + WS_P1); bf16_t* CN = (bf16_t*)(F.ws + WS_CN);
    const float* kvg = F.ap->in[I_KVG] + (size_t)l * 128;
    const int gw = F.bid * 8 + F.wave, NGW = F.G * 8;
    for (int r = gw; r < MH; r += NGW) {
        const unsigned w = *((const unsigned*)(P1 + (size_t)r * P1W + C_CKV) + F.lane); const float a = bflo(w), b = bfhi(w);
        const float rs = 1.f / sqrtf(wave_sum(a * a + b * b) * (1.f / 128.f) + EPS);
        *((unsigned*)(CN + (size_t)r * 128) + F.lane) = pk2(a * rs * kvg[2 * F.lane], b * rs * kvg[2 * F.lane + 1]);
    }
}

#ifndef GP_REP_A
#define GP_REP_A 1
#endif
#ifndef GP_REP_B
#define GP_REP_B 1
#endif
#ifndef GP_REP_C
#define GP_REP_C 1
#endif
#ifndef GP_REP_D
#define GP_REP_D 1
#endif
__device__ __forceinline__ int gdn_pos(int r, int x, int rowlen) {
    const int g = x >> 5, y = x & 31;
    const int p = (y < 16) ? (8 * (y >> 2) + (y & 3)) : (8 * ((y - 16) >> 2) + 4 + (y & 3));
    const int P = g * 32 + p, chunk = P >> 3, mask = (rowlen == 128) ? 15 : 7;
    return ((chunk ^ (r & mask)) << 3) + (P & 7);
}
__device__ __forceinline__ void ph_gdn_prep(Frame& F, int l) {
    const bf16_t* P1 = (const bf16_t*)(F.ws + WS_P1); bf16_t* GD = (bf16_t*)(F.ws + WS_GDN); float* GLAST = (float*)(F.ws + WS_GLAST);
    const float* cw = F.ap->in[I_GCW] + (size_t)l * 4 * 1536;
    const bf16_t* zpage = (const bf16_t*)(F.ws + WS_CTL + 786432);
    constexpr int RS = 132, RB = 136, RT_S = 72, MS = 68;
    LAS float* qs = (LAS float*)F.lds; LAS float* ks = qs + 64 * RS;
    LAS float* Mm = (LAS float*)F.lds; LAS float* Tm = Mm + 64 * MS; LAS float* Pt = Tm + 64 * MS; LAS bf16_t* Tb = (LAS bf16_t*)(Pt + 768);
    LAS bf16_t* qb = (LAS bf16_t*)(F.lds + 2 * 64 * RS * 4); LAS bf16_t* kb = qb + 64 * RB; LAS bf16_t* RT = kb + 64 * RB;
    LAS float* gam = (LAS float*)(RT + 256 * RT_S); LAS float* bet = gam + 64; LAS float* egam = bet + 64;
    LAS float* wl = (LAS float*)(F.lds + 49152);
    const int wave = F.wave;
    for (int cu = F.bid; cu < BH * 4 * 64; cu += F.G) {
        int lane_ = F.lane; asm volatile("" : "+v"(lane_));
        const int lane = lane_, tid = wave * 64 + lane, n = lane & 15, qd = lane >> 4;
        const int bl = cu >> 8, h = (cu >> 6) & 3, ch = cu & 63, t0 = ch * 64;
        const size_t rbase = (size_t)bl * T;
        bf16_t* rec = GD + (size_t)cu * GDN_CH;
        __syncthreads();
#pragma unroll 1
        for (int rep_ = 0; rep_ < GP_REP_A; ++rep_) {
        const int r8 = lane >> 3, part = lane & 7, d0 = part * 16, i = 8 * wave + r8, t = t0 + i;
        float wv[3];
#pragma unroll
        for (int m = 0; m < 3; ++m) wv[m] = cw[(tid >> 7) * 1536 + m * 512 + h * 128 + (tid & 127)];
        u32x4 xr[3][4][2];
#pragma unroll
        for (int k = 0; k < 4; ++k) { const int tt = t - 3 + k; const bf16_t* p = (tt < 0) ? zpage : P1 + (rbase + tt) * P1W + C_QKV + h * 128 + d0;
#pragma unroll
            for (int j3 = 0; j3 < 3; ++j3) { xr[j3][k][0] = *(const u32x4*)(p + j3 * 512); xr[j3][k][1] = *(const u32x4*)(p + j3 * 512 + 8); } }
        if (wave == 0) { const bf16_t* rp = P1 + (rbase + t0 + lane) * P1W; const float a = bf2f(rp[C_CA + h]), b = bf2f(rp[C_CB + h]);
            float g = -__expf(F.ap->in[I_GALOG][l * 4 + h]) * softplusf_(a + F.ap->in[I_GDTB][l * 4 + h]);
#pragma unroll
            for (int o = 1; o < 64; o <<= 1) { const float up = __shfl_up(g, o); if (lane >= o) g += up; }
            gam[lane] = g; bet[lane] = sigmoidf_(b); egam[lane] = __expf(g); if (lane == 63) GLAST[cu] = __expf(g); }
#pragma unroll
        for (int m = 0; m < 3; ++m) wl[m * 512 + tid] = wv[m];
        __syncthreads();
        { const float gl = gam[63]; const int rsw = ((wave ^ part) << 3) + r8;
#pragma unroll
          for (int j3 = 0; j3 < 3; ++j3) {
            float y[16];
#pragma unroll
            for (int c = 0; c < 16; ++c) y[c] = 0.f;
#pragma unroll
            for (int k = 0; k < 4; ++k) {                 const LAS f32x4* wp = (const LAS f32x4*)(wl + (j3 * 4 + k) * 128 + d0); const f32x4 w0 = wp[0], w1 = wp[1], w2 = wp[2], w3 = wp[3];
                const u32x4 x0 = xr[j3][k][0], x1 = xr[j3][k][1];
                y[0] += w0[0] * bflo(x0[0]); y[1] += w0[1] * bfhi(x0[0]); y[2] += w0[2] * bflo(x0[1]); y[3] += w0[3] * bfhi(x0[1]);
                y[4] += w1[0] * bflo(x0[2]); y[5] += w1[1] * bfhi(x0[2]); y[6] += w1[2] * bflo(x0[3]); y[7] += w1[3] * bfhi(x0[3]);
                y[8] += w2[0] * bflo(x1[0]); y[9] += w2[1] * bfhi(x1[0]); y[10] += w2[2] * bflo(x1[1]); y[11] += w2[3] * bfhi(x1[1]);
                y[12] += w3[0] * bflo(x1[2]); y[13] += w3[1] * bfhi(x1[2]); y[14] += w3[2] * bflo(x1[3]); y[15] += w3[3] * bfhi(x1[3]); }
#pragma unroll
            for (int c = 0; c < 16; ++c) y[c] = siluf_(y[c]);
            if (j3 == 2) { const float b = bet[i];
#pragma unroll
                for (int c = 0; c < 16; ++c) RT[(d0 + c) * RT_S + rsw] = (bf16_t)f2bf(y[c] * b); }
            else { const bool isq = (j3 == 0); float ss = 0.f;
#pragma unroll
                for (int c = 0; c < 16; ++c) ss += y[c] * y[c];
                ss += __shfl_xor(ss, 1); ss += __shfl_xor(ss, 2); ss += __shfl_xor(ss, 4);
                float rs = 1.f / sqrtf(ss + EPS); if (isq) rs *= 0.08838834764831845f;
                f32x4 v[4];
#pragma unroll
                for (int q = 0; q < 4; ++q) v[q] = (f32x4){y[4 * q] * rs, y[4 * q + 1] * rs, y[4 * q + 2] * rs, y[4 * q + 3] * rs};
                LAS bf16_t* cb = (isq ? qb : kb) + i * RB + d0;
                *(LAS u32x4*)cb = pack8(v[0], v[1]); *(LAS u32x4*)(cb + 8) = pack8(v[2], v[3]);
                if (isq) { const float eq = egam[i];
#pragma unroll
                    for (int q = 0; q < 4; ++q) { u32x2 o; o.x = pk2(v[q][0] * eq, v[q][1] * eq); o.y = pk2(v[q][2] * eq, v[q][3] * eq); *(u32x2*)(rec + 8192 + i * 128 + gdn_pos(i, d0 + 4 * q, 128)) = o; } }
                else { const float be = bet[i] * egam[i], ek = __expf(gl - gam[i]);
#pragma unroll
                    for (int q = 0; q < 4; ++q)
#pragma unroll
                        for (int x = 0; x < 4; ++x) { const int d = d0 + 4 * q + x; RT[(128 + d) * RT_S + rsw] = (bf16_t)f2bf(v[q][x] * be); rec[16384 + d * 64 + gdn_pos(d, i, 64)] = (bf16_t)f2bf(v[q][x] * ek); } } } } }
        __syncthreads();
        }
#pragma unroll 1
        for (int rep_ = 0; rep_ < GP_REP_B; ++rep_) {
        { const int mat = wave >> 2, mi = wave & 3; const LAS bf16_t* Asrc = (mat == 0 ? kb : qb) + (16 * mi + n) * RB + qd * 8;
          bf16x8 af[4];
#pragma unroll
          for (int s2 = 0; s2 < 4; ++s2) af[s2] = *(const LAS bf16x8*)(Asrc + 32 * s2);
          f32x4 cc[4];
#pragma unroll
          for (int mj = 0; mj < 4; ++mj) { cc[mj] = (f32x4){0.f, 0.f, 0.f, 0.f}; const LAS bf16_t* Bsrc = kb + (16 * mj + n) * RB + qd * 8;
#pragma unroll
              for (int s2 = 0; s2 < 4; ++s2) cc[mj] = __builtin_amdgcn_mfma_f32_16x16x32_bf16(af[s2], *(const LAS bf16x8*)(Bsrc + 32 * s2), cc[mj], 0, 0, 0); }
          __syncthreads();
#pragma unroll
          for (int mj = 0; mj < 4; ++mj) { const int j = 16 * mj + n; const float gj = gam[j];
#pragma unroll
              for (int rg = 0; rg < 4; ++rg) { const int i = 16 * mi + 4 * qd + rg; const float dec = (i >= j) ? __expf(gam[i] - gj) : 0.f;
                  if (mat == 0) { Mm[i * MS + j] = (i > j) ? bet[i] * cc[mj][rg] * dec : 0.f; Tm[i * MS + j] = 0.f; }
                  else rec[24576 + i * 64 + gdn_pos(i, j, 64)] = (bf16_t)f2bf(cc[mj][rg] * dec); } } }
        __syncthreads();
        }
#pragma unroll 1
        for (int rep_ = 0; rep_ < GP_REP_C; ++rep_) {
        { LAS float* SCR = (LAS float*)(F.lds + 55296);
#define MM16(Ap, lda, Bp, ldb, accv) do { _Pragma("unroll") for (int ks = 0; ks < 4; ++ks) accv = __builtin_amdgcn_mfma_f32_16x16x4f32((Ap)[n * (lda) + 4 * ks + qd], (Bp)[(4 * ks + qd) * (ldb) + n], accv, 0, 0, 0); } while (0)
#define ST16(Dp, ldd, v, sgn) do { _Pragma("unroll") for (int rg = 0; rg < 4; ++rg) (Dp)[(4 * qd + rg) * (ldd) + n] = (sgn) * (v)[rg]; } while (0)
          if (wave < 4) { const int b = wave; const LAS float* N = Mm + (16 * b) * MS + 16 * b; LAS float* X = Tm + (16 * b) * MS + 16 * b; LAS float* S2 = SCR + b * 768; LAS float* S4 = S2 + 256; LAS float* S8 = S2 + 512;
              f32x4 p = {0.f, 0.f, 0.f, 0.f}; MM16(N, MS, N, MS, p); ST16(S2, 16, p, 1.f);
              f32x4 x;
#pragma unroll
              for (int rg = 0; rg < 4; ++rg) x[rg] = ((4 * qd + rg == n) ? 1.f : 0.f) - N[(4 * qd + rg) * MS + n];
              ST16(X, MS, x, 1.f);
              WAVE_SYNC();
              p = (f32x4){0.f, 0.f, 0.f, 0.f}; MM16(S2, 16, S2, 16, p); ST16(S4, 16, p, 1.f);
              MM16(X, MS, S2, 16, x);
              WAVE_SYNC(); ST16(X, MS, x, 1.f); WAVE_SYNC();
              p = (f32x4){0.f, 0.f, 0.f, 0.f}; MM16(S4, 16, S4, 16, p); ST16(S8, 16, p, 1.f);
              MM16(X, MS, S4, 16, x);
              WAVE_SYNC(); ST16(X, MS, x, 1.f); WAVE_SYNC();
              MM16(X, MS, S8, 16, x);
              WAVE_SYNC(); ST16(X, MS, x, 1.f); }
          __syncthreads();
#pragma unroll 1
          for (int dl = 1; dl < 4; ++dl) {
              if (wave < 4 - dl) { const int bi = wave + dl, bj = wave; LAS float* P = Pt + wave * 256;
                  f32x4 p = {0.f, 0.f, 0.f, 0.f};
                  for (int kb2 = bj; kb2 < bi; ++kb2) MM16(Mm + (16 * bi) * MS + 16 * kb2, MS, Tm + (16 * kb2) * MS + 16 * bj, MS, p);
                  ST16(P, 16, p, 1.f); WAVE_SYNC();
                  f32x4 r = {0.f, 0.f, 0.f, 0.f}; MM16(Tm + (16 * bi) * MS + 16 * bi, MS, P, 16, r);
                  ST16(Tm + (16 * bi) * MS + 16 * bj, MS, r, -1.f); }
              __syncthreads(); }
#undef MM16
#undef ST16
        }
        for (int e = tid; e < 64 * 32; e += 512) { const int i = e >> 5, j2 = (e & 31) * 2; *(LAS unsigned*)(Tb + i * RT_S + j2) = pk2(Tm[i * MS + j2], Tm[i * MS + j2 + 1]); }
        __syncthreads();
        }
#pragma unroll 1
        for (int rep_ = 0; rep_ < GP_REP_D; ++rep_) {
        { bf16x8 tf[4][2];
#pragma unroll
          for (int mi = 0; mi < 4; ++mi)
#pragma unroll
              for (int s2 = 0; s2 < 2; ++s2) tf[mi][s2] = *(const LAS bf16x8*)(Tb + (16 * mi + n) * RT_S + 32 * s2 + qd * 8);
#pragma unroll
          for (int nl = 0; nl < 2; ++nl) { const int c = 16 * (2 * wave + nl) + n; bf16x8 rf[2];
#pragma unroll
              for (int s2 = 0; s2 < 2; ++s2) rf[s2] = *(const LAS bf16x8*)(RT + c * RT_S + (((4 * s2 + qd) ^ ((2 * wave + nl) & 7)) << 3));
#pragma unroll
              for (int mi = 0; mi < 4; ++mi) { f32x4 a = {0.f, 0.f, 0.f, 0.f};
#pragma unroll
                  for (int s2 = 0; s2 < 2; ++s2) a = __builtin_amdgcn_mfma_f32_16x16x32_bf16(tf[mi][s2], rf[s2], a, 0, 0, 0);
                  if (wave < 4) { u32x2 o; o.x = pk2(a[0], a[1]); o.y = pk2(a[2], a[3]); *(u32x2*)(rec + 28672 + c * 64 + 16 * mi + 4 * qd) = o; }
                  else { const int d = c - 128;
#pragma unroll
                      for (int rg = 0; rg < 4; ++rg) { const int i = 16 * mi + 4 * qd + rg; rec[i * 128 + gdn_pos(i, d, 128)] = (bf16_t)f2bf(a[rg]); } } } } }
        }
    }
}

__device__ __forceinline__ void gdn_dma(const bf16_t* rec, LAS unsigned char* buf, int tid, int wave) {
#pragma unroll
    for (int r = 0; r < 7; ++r) __builtin_amdgcn_global_load_lds((const unsigned*)((const char*)rec + r * 8192 + tid * 16), (LAS unsigned*)(buf + r * 8192 + wave * 1024), 16, 0, 0);
}
__device__ __forceinline__ bf16x8 pack_b(const f32x4 v0, const f32x4 v1) { return __builtin_bit_cast(bf16x8, pack8(v0, v1)); }
__device__ __forceinline__ void ph_gdn_chain(Frame& F, int l) {
    const bf16_t* GD = (const bf16_t*)(F.ws + WS_GDN); const float* GLAST = (const float*)(F.ws + WS_GLAST); const bf16_t* P1 = (const bf16_t*)(F.ws + WS_P1); bf16_t* BR = (bf16_t*)(F.ws + WS_BR);
    const float* ng = F.ap->in[I_GNG] + (size_t)l * 128;
    LAS unsigned char* L = F.lds; LAS unsigned char* obuf = L + 2 * 57344;
    const int tid = F.tid, lane = F.lane, w = F.wave, n = lane & 15, qd = lane >> 4;
    float gn[16];
#pragma unroll
    for (int q = 0; q < 16; ++q) gn[q] = ng[(lane & 7) * 16 + q];
    for (int bh = F.bid; bh < BH * 4; bh += F.G) {
        const int bl = bh >> 2, h = bh & 3;
        f32x4 S[8];
#pragma unroll
        for (int m = 0; m < 8; ++m) S[m] = (f32x4){0.f, 0.f, 0.f, 0.f};
        u32x2 up[4]; unsigned zp[8]; float lastp;
        { const bf16_t* rec = GD + (size_t)(bh * 64) * GDN_CH;
#pragma unroll
          for (int m = 0; m < 4; ++m) up[m] = *(const u32x2*)(rec + 28672 + (16 * w + n) * 64 + 16 * m + 4 * qd);
          lastp = GLAST[bh * 64];
          asm volatile("" ::: "memory");
          __syncthreads();
          gdn_dma(rec, L, tid, w); }
#pragma unroll
        for (int rr = 0; rr < 8; ++rr) zp[rr] = 0u;
#define GDN_NORM(chn, zc) do { const int r8 = lane >> 3, part = lane & 7, row = 8 * w + r8; \
            const u32x4 oa = *(const LAS u32x4*)(obuf + row * 256 + part * 32), ob = *(const LAS u32x4*)(obuf + row * 256 + part * 32 + 16); float ss = 0.f; \
            _Pragma("unroll") for (int q = 0; q < 4; ++q) { ss += bflo(oa[q]) * bflo(oa[q]) + bfhi(oa[q]) * bfhi(oa[q]) + bflo(ob[q]) * bflo(ob[q]) + bfhi(ob[q]) * bfhi(ob[q]); } \
            ss += __shfl_xor(ss, 1); ss += __shfl_xor(ss, 2); ss += __shfl_xor(ss, 4); \
            const float rs = 1.f / sqrtf(ss * (1.f / 128.f) + EPS); u32x4 ya, yb; \
            _Pragma("unroll") for (int q = 0; q < 4; ++q) { \
                ya[q] = pk2(bflo(oa[q]) * rs * gn[2 * q] * siluf_(bflo(zc[q])), bfhi(oa[q]) * rs * gn[2 * q + 1] * siluf_(bfhi(zc[q]))); \
                yb[q] = pk2(bflo(ob[q]) * rs * gn[8 + 2 * q] * siluf_(bflo(zc[4 + q])), bfhi(ob[q]) * rs * gn[8 + 2 * q + 1] * siluf_(bfhi(zc[4 + q]))); } \
            bf16_t* dst = BR + ((size_t)bl * T + (chn) * 64 + row) * BRW + 1536 + h * 128 + part * 16; *(u32x4*)dst = ya; *(u32x4*)(dst + 8) = yb; } while (0)
        for (int ch = 0; ch < 64; ++ch) {
            const int cu = bh * 64 + ch, cur = ch & 1;
            asm volatile("s_waitcnt vmcnt(0) lgkmcnt(0)\n\ts_barrier" ::: "memory");
            u32x2 uc[4]; unsigned zc[8]; const float last = lastp;
#pragma unroll
            for (int m = 0; m < 4; ++m) uc[m] = up[m];
#pragma unroll
            for (int rr = 0; rr < 8; ++rr) zc[rr] = zp[rr];
#ifndef REP_NORM
#define REP_NORM 1
#endif
            for (int rp_ = 0; rp_ < REP_NORM; ++rp_) { if (ch > 0) GDN_NORM(ch - 1, zc); }
            { const int cn = (ch + 1 < 64) ? cu + 1 : cu; const bf16_t* rec = GD + (size_t)cn * GDN_CH;
#pragma unroll
                for (int m = 0; m < 4; ++m) up[m] = *(const u32x2*)(rec + 28672 + (16 * w + n) * 64 + 16 * m + 4 * qd);
                lastp = GLAST[cn];
                { const bf16_t* zsrc = P1 + ((size_t)bl * T + ch * 64 + 8 * w + (lane >> 3)) * P1W + C_Z + h * 128 + (lane & 7) * 16; const u32x4 z0 = *(const u32x4*)zsrc, z1 = *(const u32x4*)(zsrc + 8);
#pragma unroll
                  for (int q = 0; q < 4; ++q) { zp[q] = z0[q]; zp[4 + q] = z1[q]; } }
                asm volatile("" ::: "memory");
                if (ch + 1 < 64) gdn_dma(rec, L + (cur ^ 1) * 57344, tid, w); }
            const LAS unsigned char* B = L + cur * 57344;
            const int rb256 = n * 256, rb128 = n * 128; int xo[4], x7[2];
#pragma unroll
            for (int s2 = 0; s2 < 4; ++s2) xo[s2] = ((4 * s2 + qd) ^ n) << 4;
#pragma unroll
            for (int s2 = 0; s2 < 2; ++s2) x7[s2] = ((4 * s2 + qd) ^ (n & 7)) << 4;
#define GF(off) (*(const LAS bf16x8*)(B + (off)))
#define LD_G1(f, m) do { _Pragma("unroll") for (int s2 = 0; s2 < 4; ++s2) { f[s2] = GF((16 * (m)) * 256 + rb256 + xo[s2]); f[4 + s2] = GF(16384 + (16 * (m)) * 256 + rb256 + xo[s2]); } } while (0)
#define MM_G1(f, m) do { _Pragma("unroll") for (int s2 = 0; s2 < 4; ++s2) { WS[m] = __builtin_amdgcn_mfma_f32_16x16x32_bf16(f[s2], Sb[s2], WS[m], 0, 0, 0); QS[m] = __builtin_amdgcn_mfma_f32_16x16x32_bf16(f[4 + s2], Sb[s2], QS[m], 0, 0, 0); } } while (0)
#define LD_AT(f) do { _Pragma("unroll") for (int m = 0; m < 4; ++m) _Pragma("unroll") for (int s2 = 0; s2 < 2; ++s2) f[2 * m + s2] = GF(49152 + (16 * m) * 128 + rb128 + x7[s2]); } while (0)
#define MM_AT(f) do { _Pragma("unroll") for (int m = 0; m < 4; ++m) _Pragma("unroll") for (int s2 = 0; s2 < 2; ++s2) QS[m] = __builtin_amdgcn_mfma_f32_16x16x32_bf16(f[2 * m + s2], Vb[s2], QS[m], 0, 0, 0); } while (0)
#define LD_KT(f, hf) do { _Pragma("unroll") for (int m = 0; m < 4; ++m) _Pragma("unroll") for (int s2 = 0; s2 < 2; ++s2) f[2 * m + s2] = GF(32768 + (16 * (4 * (hf) + m)) * 128 + rb128 + x7[s2]); } while (0)
#define MM_KT(f, hf) do { _Pragma("unroll") for (int m = 0; m < 4; ++m) _Pragma("unroll") for (int s2 = 0; s2 < 2; ++s2) S[4 * (hf) + m] = __builtin_amdgcn_mfma_f32_16x16x32_bf16(f[2 * m + s2], Vb[s2], S[4 * (hf) + m], 0, 0, 0); } while (0)
#define SBAR __builtin_amdgcn_sched_barrier(0)
            bf16x8 Sb[4];
#pragma unroll
            for (int s2 = 0; s2 < 4; ++s2) Sb[s2] = pack_b(S[2 * s2], S[2 * s2 + 1]);
            f32x4 WS[4], QS[4];
#pragma unroll
            for (int m = 0; m < 4; ++m) { WS[m] = (f32x4){0.f, 0.f, 0.f, 0.f}; QS[m] = (f32x4){0.f, 0.f, 0.f, 0.f}; }
            bf16x8 fa[8], fb[8];
            LD_G1(fa, 0); SBAR;
            LD_G1(fb, 1); SBAR; MM_G1(fa, 0); SBAR;
            LD_G1(fa, 2); SBAR; MM_G1(fb, 1); SBAR;
            LD_G1(fb, 3); SBAR; MM_G1(fa, 2); SBAR;
            LD_AT(fa);    SBAR; MM_G1(fb, 3); SBAR;
            f32x4 vn[4];
#pragma unroll
            for (int m = 0; m < 4; ++m) { vn[m][0] = bflo(uc[m].x) - WS[m][0]; vn[m][1] = bfhi(uc[m].x) - WS[m][1]; vn[m][2] = bflo(uc[m].y) - WS[m][2]; vn[m][3] = bfhi(uc[m].y) - WS[m][3]; }
            bf16x8 Vb[2]; Vb[0] = pack_b(vn[0], vn[1]); Vb[1] = pack_b(vn[2], vn[3]);
#pragma unroll
            for (int mk = 0; mk < 8; ++mk) S[mk] = S[mk] * last;
            LD_KT(fb, 0); SBAR; MM_AT(fa); SBAR;
            LD_KT(fa, 1); SBAR; MM_KT(fb, 0); SBAR;
            MM_KT(fa, 1);
#undef GF
#undef LD_G1
#undef MM_G1
#undef LD_AT
#undef MM_AT
#undef LD_KT
#undef MM_KT
#undef SBAR
            asm volatile("s_waitcnt lgkmcnt(0)\n\ts_barrier" ::: "memory");
#pragma unroll
            for (int m = 0; m < 4; ++m)
#pragma unroll
                for (int j = 0; j < 4; ++j) *(LAS bf16_t*)(obuf + ((16 * m + 4 * qd + j) * 128 + 16 * w + n) * 2) = (bf16_t)f2bf(QS[m][j]);
        }
        asm volatile("s_waitcnt vmcnt(0) lgkmcnt(0)\n\ts_barrier" ::: "memory");
        GDN_NORM(63, zp);
#undef GDN_NORM
        asm volatile("s_waitcnt vmcnt(0)" ::: "memory");
        __syncthreads();
    }
}

struct OneUnit { int pm, pn; __device__ bool next(int i, Unit& u) const { if (i != 0) return false; u.pm = pm; u.pn = pn; return true; } };
__device__ __forceinline__ void s5_unit(Frame& F, int g, int bi) {
    float* S = (float*)(F.ws + WS_S5S); bf16_t* S5A = (bf16_t*)(F.ws + WS_S5A); const float* S5P = (const float*)(F.ws + WS_S5P);
    { pg8::Gemm gm{(const bf16_t*)S5A, (const bf16_t*)(F.ws + WS_S5W1), S5LD, 256, 256}; OneUnit U{g * 4 + bi, g}; EpiS5S E{S}; pg8::gemm_phase(F.lds, F.tid, gm, U, E); }
    asm volatile("s_waitcnt vmcnt(0)" ::: "memory"); __syncthreads();
    __builtin_amdgcn_fence(__ATOMIC_ACQUIRE, "agent"); asm volatile("s_waitcnt vmcnt(0)" ::: "memory");
    {
        const int p = F.lane, k = F.wave; const size_t r0 = (size_t)(g * 4 + bi) * 256 + 32 * k;
        const float ar = S5P[g * 128 + p], ai = S5P[g * 128 + 64 + p];
        float sr[32], si[32];
#pragma unroll
        for (int j = 0; j < 32; ++j) { sr[j] = S[(r0 + j) * 128 + p]; si[j] = S[(r0 + j) * 128 + 64 + p]; }
        float lr = 0.f, li = 0.f;
#pragma unroll
        for (int j = 0; j < 32; ++j) { const float xr = sr[j], xi = si[j]; sr[j] = lr; si[j] = li; const float nr = ar * lr - ai * li + xr, ni = ar * li + ai * lr + xi; lr = nr; li = ni; }
        LAS float* ex = (LAS float*)F.lds;
        ex[k * 128 + p] = lr; ex[k * 128 + 64 + p] = li;
        float a32r = ar, a32i = ai;
#pragma unroll
        for (int q = 0; q < 5; ++q) { const float tr = a32r * a32r - a32i * a32i, ti = 2.f * a32r * a32i; a32r = tr; a32i = ti; }
        __syncthreads();
        float cr = 0.f, ci = 0.f;
        for (int k2 = 0; k2 < k; ++k2) { const float er = ex[k2 * 128 + p], ei = ex[k2 * 128 + 64 + p]; const float nr = a32r * cr - a32i * ci + er, ni = a32r * ci + a32i * cr + ei; cr = nr; ci = ni; }
        float pr = 1.f, pi = 0.f;
#pragma unroll
        for (int j = 0; j < 32; ++j) { const float hr = sr[j] + pr * cr - pi * ci, hi = si[j] + pr * ci + pi * cr;
            S5A[(r0 + j) * S5LD + 256 + p] = (bf16_t)f2bf(hr); S5A[(r0 + j) * S5LD + 320 + p] = (bf16_t)f2bf(hi);
            const float tr = pr * ar - pi * ai, ti = pr * ai + pi * ar; pr = tr; pi = ti; }
    }
    asm volatile("s_waitcnt vmcnt(0)" ::: "memory"); __syncthreads();
    __builtin_amdgcn_fence(__ATOMIC_ACQUIRE, "agent"); asm volatile("s_waitcnt vmcnt(0)" ::: "memory");
    { pg8::Gemm gm{(const bf16_t*)S5A, (const bf16_t*)(F.ws + WS_S5T), S5LD, S5LD, S5LD}; OneUnit U{g * 4 + bi, g}; EpiS5Y E{(bf16_t*)(F.ws + WS_YG)}; pg8::gemm_phase(F.lds, F.tid, gm, U, E); }
}

__device__ __forceinline__ unsigned umed3_(unsigned a, unsigned b, unsigned c) { unsigned r; asm("v_med3_u32 %0, %1, %2, %3" : "=v"(r) : "v"(a), "v"(b), "v"(c)); return r; }
template <int NR, bool SURV>
__device__ __forceinline__ void sel_core(const unsigned (&key)[NR], int lane, LAS int* ixo, const LAS int* sidx, unsigned Kt0, int topbit) {
    constexpr int NVB = (NR >= 64) ? 7 : (NR >= 32) ? 6 : (NR >= 16) ? 5 : 4;
    unsigned Kt = Kt0;
    for (int bit = topbit; bit >= 0; --bit) { const unsigned cand = Kt | (1u << bit); unsigned cl = 0u;
#pragma unroll
        for (int i = 0; i < NR; ++i) cl += (key[i] >= cand) ? 1u : 0u;
        int cnt = 0;
#pragma unroll
        for (int b = 0; b < NVB; ++b) cnt += __builtin_popcountll(__ballot((cl >> b) & 1u)) << b;
        if (cnt >= 256) { Kt = cand; if (cnt == 256) break; } }
    int ngt = 0;
    { unsigned cl = 0u;
#pragma unroll
      for (int i = 0; i < NR; ++i) cl += (key[i] > Kt) ? 1u : 0u;
#pragma unroll
      for (int b = 0; b < NVB; ++b) ngt += __builtin_popcountll(__ballot((cl >> b) & 1u)) << b; }
    const int need = 256 - ngt; int pos = 0, ties = 0; const unsigned long long lt = (1ull << lane) - 1ull;
#pragma unroll
    for (int i = 0; i < NR; ++i) { const bool gtk = key[i] > Kt, eq = key[i] == Kt; const unsigned long long mt = __ballot(eq);
        const bool take = gtk || (eq && (ties + __builtin_popcountll(mt & lt)) < need); const unsigned long long mk = __ballot(take);
        if (take) { const int pp = pos + __builtin_popcountll(mk & lt); if (pp < 256) ixo[pp] = SURV ? sidx[i * 64 + lane] : i * 64 + lane; }
        pos += __builtin_popcountll(mk); ties += __builtin_popcountll(mt); }
}
template <int NR>
__device__ __forceinline__ void dsa_select(const LAS float* row, int limit, int lane, LAS int* ixo) {
    unsigned key[NR];
    const int nreg = limit >> 6;
#pragma unroll
    for (int i = 0; i < NR; ++i) { unsigned kx = 0u; if (i < nreg) { const unsigned b = __builtin_bit_cast(unsigned, row[i * 64 + lane]); kx = (b & 0x80000000u) ? ~b : (b | 0x80000000u); } key[i] = kx; }
    WAVE_SYNC();
    if (NR >= 32) {
        unsigned a1 = 0u, a2 = 0u, a3 = 0u, a4 = 0u;
#pragma unroll
        for (int i = 0; i < NR; ++i) { const unsigned k = key[i]; a4 = umed3_(a3, a4, k); a3 = umed3_(a2, a3, k); a2 = umed3_(a1, a2, k); a1 = (a1 > k) ? a1 : k; }
        unsigned L = a4, Mx = a1;
#pragma unroll
        for (int o = 1; o < 64; o <<= 1) { const unsigned x = (unsigned)__shfl_xor((int)L, o); L = (x < L) ? x : L; const unsigned y = (unsigned)__shfl_xor((int)Mx, o); Mx = (y > Mx) ? y : Mx; }
        int S = 0;
#pragma unroll
        for (int i = 0; i < NR; ++i) S += __builtin_popcountll(__ballot(key[i] >= L));
        if (S <= 1024) {
            LAS unsigned* sk = (LAS unsigned*)row + 1024; LAS int* si = (LAS int*)row + 2048; int base = 0;
#pragma unroll
            for (int i = 0; i < NR; ++i) { const bool p = key[i] >= L; const unsigned long long m = __ballot(p);
                if (p) { const int pp = base + (int)__builtin_amdgcn_mbcnt_hi((unsigned)(m >> 32), __builtin_amdgcn_mbcnt_lo((unsigned)m, 0u)); sk[pp] = key[i]; si[pp] = i * 64 + lane; }
                base += __builtin_popcountll(m); }
            WAVE_SYNC();
            const unsigned dx = Mx - L + 1u; const int tb = 31 - __builtin_clz(dx);
            if (S <= 768) { unsigned k2[12];
#pragma unroll
                for (int j = 0; j < 12; ++j) k2[j] = (j * 64 + lane < S) ? sk[j * 64 + lane] - L + 1u : 0u;
                sel_core<12, true>(k2, lane, ixo, si, 0u, tb); }
            else { unsigned k2[16];
#pragma unroll
                for (int j = 0; j < 16; ++j) k2[j] = (j * 64 + lane < S) ? sk[j * 64 + lane] - L + 1u : 0u;
                sel_core<16, true>(k2, lane, ixo, si, 0u, tb); }
            return;
        }
    }
    sel_core<NR, false>(key, lane, ixo, nullptr, 0u, 31);
}
__device__ __forceinline__ float relu_bits(float x) { return __builtin_bit_cast(float, __builtin_elementwise_max(__builtin_bit_cast(int, x), 0)); }
__device__ __forceinline__ void dsa_unit(Frame& F, int un) {
    const bf16_t* P1 = (const bf16_t*)(F.ws + WS_P1); const bf16_t* CN = (const bf16_t*)(F.ws + WS_CN); bf16_t* BR = (bf16_t*)(F.ws + WS_BR);
    LAS float* sc = (LAS float*)F.lds; constexpr int SCS = 4100;
    int lane_ = F.lane; asm volatile("" : "+v"(lane_));
    const int lane = lane_, wave = F.wave, n = lane & 15, qd = lane >> 4;
    const int bl = un & 3, qb = 511 - (un >> 2), t0 = qb * 8, limit = ((t0 >> 6) + 1) * 64;
    const size_t rbase = (size_t)bl * T;
    if (limit > 256) {
        bf16x8 bq[2][2]; float iwv[2];
        { const bf16_t* qp = P1 + (rbase + t0 + (n & 7)) * P1W;
#pragma unroll
          for (int pr = 0; pr < 2; ++pr) { const int hh = 2 * pr + (n >> 3);
#pragma unroll
              for (int ks = 0; ks < 2; ++ks) bq[pr][ks] = *(const bf16x8*)(qp + C_IQ + hh * 64 + ks * 32 + qd * 8);
              iwv[pr] = bf2f(qp[C_IW + hh]) * 0.0625f; } }
        const int nkb = limit >> 4;
        const bf16_t* kbase = (const bf16_t*)(F.ws + WS_IKC) + (rbase >> 4) * 1024 + (qd * 16 + n) * 8;
        bf16x8 a0[4], a1[4], A0[4], A1[4], B0[4], B1[4];
#define DSA_LDK(kb, X0, X1) _Pragma("unroll") for (int u4 = 0; u4 < 4; ++u4) { const bf16_t* kp = kbase + (size_t)((kb) + u4) * 1024; X0[u4] = *(const bf16x8*)kp; X1[u4] = *(const bf16x8*)(kp + 512); }
        auto score = [&](int kb0) {
#pragma unroll
            for (int u4 = 0; u4 < 4; ++u4) { f32x4 sv = {0.f, 0.f, 0.f, 0.f};
#pragma unroll
                for (int pr = 0; pr < 2; ++pr) { f32x4 c = {0.f, 0.f, 0.f, 0.f};
                    c = __builtin_amdgcn_mfma_f32_16x16x32_bf16(a0[u4], bq[pr][0], c, 0, 0, 0); c = __builtin_amdgcn_mfma_f32_16x16x32_bf16(a1[u4], bq[pr][1], c, 0, 0, 0);
#pragma unroll
                    for (int j = 0; j < 4; ++j) sv[j] = fmaf(relu_bits(c[j]), iwv[pr], sv[j]); }
#pragma unroll
                for (int j = 0; j < 4; ++j) { float r; asm("s_nop 1\n\tv_add_f32_dpp %0, %1, %1 row_ror:8 row_mask:0xf bank_mask:0xf" : "=v"(r) : "v"(sv[j])); sv[j] = r; }
                *(LAS f32x4*)(sc + (n & 7) * SCS + (kb0 + u4) * 16 + qd * 4) = sv; }
        };
        if (wave * 4 < nkb) { DSA_LDK(wave * 4, A0, A1) }
        if (wave * 4 + 32 < nkb) { DSA_LDK(wave * 4 + 32, B0, B1) }
        for (int kb0 = wave * 4; kb0 < nkb; kb0 += 64) {
#pragma unroll
            for (int u4 = 0; u4 < 4; ++u4) { a0[u4] = A0[u4]; a1[u4] = A1[u4]; }
            if (kb0 + 64 < nkb) { DSA_LDK(kb0 + 64, A0, A1) }
            score(kb0);
            if (kb0 + 32 < nkb) {
#pragma unroll
                for (int u4 = 0; u4 < 4; ++u4) { a0[u4] = B0[u4]; a1[u4] = B1[u4]; }
                if (kb0 + 96 < nkb) { DSA_LDK(kb0 + 96, B0, B1) }
                score(kb0 + 32); }
        }
#undef DSA_LDK
    }
    __syncthreads();
    LAS float* myrow = sc + wave * SCS; LAS int* ix = (LAS int*)myrow; LAS float* pp = myrow + 256;
    const int qrow = bl * T + t0 + wave; int nv = 256;
    if (limit <= 256) { nv = limit;
#pragma unroll
        for (int r = 0; r < 4; ++r) { const int kk = r * 64 + lane; ix[kk] = (kk < limit) ? kk : 0; } }
    else if (limit <= 1024) dsa_select<16>(myrow, limit, lane, ix);
    else if (limit <= 2048) dsa_select<32>(myrow, limit, lane, ix);
    else if (limit <= 3072) dsa_select<48>(myrow, limit, lane, ix);
    else dsa_select<64>(myrow, limit, lane, ix);
    bf16x8 bq[4];
#pragma unroll
    for (int ks = 0; ks < 4; ++ks) { bf16x8 v = *(const bf16x8*)(P1 + (size_t)qrow * P1W + C_QL + (n & 7) * 128 + ks * 32 + qd * 8); if (n >= 8) v = (bf16x8){0, 0, 0, 0, 0, 0, 0, 0}; bq[ks] = v; }
    WAVE_SYNC();
    LAS unsigned char* tile = (LAS unsigned char*)(myrow + 256);
    constexpr int TS = 272;
    const int grow = lane >> 4, gch = lane & 15;
    u32x4 gA[8], gB[8];
#define DSA_GATHER(g, tt) _Pragma("unroll") for (int i = 0; i < 8; ++i) g[i] = *(const u32x4*)(CN + (rbase + ix[(tt) * 32 + grow + 4 * i]) * 128 + gch * 8);
    DSA_GATHER(gA, 0) DSA_GATHER(gB, 1)
    f32x4 O[8];
#pragma unroll
    for (int rt = 0; rt < 8; ++rt) O[rt] = (f32x4){0.f, 0.f, 0.f, 0.f};
    float mrun = -INFINITY, lrun = 0.f;
    const int trow = 4 * qd + (n >> 2), tcol = (n & 3) * 8;
    auto step = [&](int t, u32x4 (&g)[8]) {
#pragma unroll
        for (int i = 0; i < 8; ++i) *(LAS u32x4*)(tile + (grow + 4 * i) * TS + gch * 16) = g[i];
        if (t < 6) { DSA_GATHER(g, t + 2) }
        WAVE_SYNC();
        f32x4 c[2];
#pragma unroll
        for (int kb2 = 0; kb2 < 2; ++kb2) { c[kb2] = (f32x4){0.f, 0.f, 0.f, 0.f};
#pragma unroll
            for (int ks = 0; ks < 4; ++ks) c[kb2] = __builtin_amdgcn_mfma_f32_16x16x32_bf16(*(const LAS bf16x8*)(tile + (kb2 * 16 + n) * TS + (4 * ks + qd) * 16), bq[ks], c[kb2], 0, 0, 0); }
        float mx = mrun;
#pragma unroll
        for (int kb2 = 0; kb2 < 2; ++kb2)
#pragma unroll
            for (int j = 0; j < 4; ++j) { if (t * 32 + kb2 * 16 + 4 * qd + j >= nv) c[kb2][j] = -INFINITY; mx = fmaxf(mx, c[kb2][j]); }
        mx = fmaxf(mx, __shfl_xor(mx, 16)); mx = fmaxf(mx, __shfl_xor(mx, 32));
        const float scl = __expf(mrun - mx); float ps = 0.f;
#pragma unroll
        for (int kb2 = 0; kb2 < 2; ++kb2)
#pragma unroll
            for (int j = 0; j < 4; ++j) { c[kb2][j] = __expf(c[kb2][j] - mx); ps += c[kb2][j]; }
        ps += __shfl_xor(ps, 16); ps += __shfl_xor(ps, 32);
        lrun = lrun * scl + ps; mrun = mx;
        const bf16x8 pb = pack_b(c[0], c[1]);
#pragma unroll
        for (int rt = 0; rt < 8; ++rt) { O[rt] = O[rt] * scl;
            typedef short v4i16_t __attribute__((ext_vector_type(4)));
            const v4i16_t a0 = __builtin_amdgcn_ds_read_tr16_b64_v4i16((LAS v4i16_t*)(tile + trow * TS + rt * 32 + tcol));
            const v4i16_t a1 = __builtin_amdgcn_ds_read_tr16_b64_v4i16((LAS v4i16_t*)(tile + (16 + trow) * TS + rt * 32 + tcol));
            const bf16x8 af = {a0[0], a0[1], a0[2], a0[3], a1[0], a1[1], a1[2], a1[3]};
            O[rt] = __builtin_amdgcn_mfma_f32_16x16x32_bf16(af, pb, O[rt], 0, 0, 0); }
        WAVE_SYNC();
    };
    for (int t = 0; t < 8; t += 2) {
        if (t * 32 >= nv) break;
        step(t, gA);
        if ((t + 1) * 32 >= nv) break;
        step(t + 1, gB);
    }
#undef DSA_GATHER
    if (n < 8) { const float inv = 1.f / lrun; bf16_t* dst = BR + (size_t)qrow * BRW + n * 128 + 4 * qd;
#pragma unroll
        for (int rt = 0; rt < 8; ++rt) { u32x2 o; o.x = pk2(O[rt][0] * inv, O[rt][1] * inv); o.y = pk2(O[rt][2] * inv, O[rt][3] * inv); *(u32x2*)(dst + rt * 16) = o; } }
#ifdef PROBE_ATT
    WAVE_SYNC();
    {
    bf16x8 bq2[4];
#pragma unroll
    for (int ks = 0; ks < 4; ++ks) { bf16x8 v = *(const bf16x8*)(P1 + (size_t)qrow * P1W + C_QL + (n & 7) * 128 + ks * 32 + qd * 8); if (n >= 8) v = (bf16x8){0, 0, 0, 0, 0, 0, 0, 0}; bq2[ks] = v; }
    WAVE_SYNC();
    LAS float* pp = myrow + 256; f32x4 lg[16];
#pragma unroll
    for (int kb4 = 0; kb4 < 4; ++kb4) { bf16x8 a[4][4];
#pragma unroll
        for (int k2 = 0; k2 < 4; ++k2) { const bf16_t* cp = CN + (rbase + ix[(kb4 * 4 + k2) * 16 + n]) * 128 + qd * 8;
#pragma unroll
            for (int ks = 0; ks < 4; ++ks) a[k2][ks] = *(const bf16x8*)(cp + ks * 32); }
#pragma unroll
        for (int k2 = 0; k2 < 4; ++k2) { f32x4 c = {0.f, 0.f, 0.f, 0.f};
#pragma unroll
            for (int ks = 0; ks < 4; ++ks) c = __builtin_amdgcn_mfma_f32_16x16x32_bf16(a[k2][ks], bq2[ks], c, 0, 0, 0);
            lg[kb4 * 4 + k2] = c; } }
    float mx = -INFINITY;
#pragma unroll
    for (int kb = 0; kb < 16; ++kb)
#pragma unroll
        for (int j = 0; j < 4; ++j) { const int kk = kb * 16 + qd * 4 + j; if (kk >= nv) lg[kb][j] = -INFINITY; mx = fmaxf(mx, lg[kb][j]); }
    mx = fmaxf(mx, __shfl_xor(mx, 16)); mx = fmaxf(mx, __shfl_xor(mx, 32));
    float sm = 0.f;
#pragma unroll
    for (int kb = 0; kb < 16; ++kb)
#pragma unroll
        for (int j = 0; j < 4; ++j) { const float e = __expf(lg[kb][j] - mx); lg[kb][j] = e; sm += e; }
    sm += __shfl_xor(sm, 16); sm += __shfl_xor(sm, 32);
    const float inv = 1.f / sm;
    if (n < 8) {
#pragma unroll
        for (int kb = 0; kb < 16; ++kb)
#pragma unroll
            for (int j = 0; j < 4; ++j) pp[(kb * 16 + qd * 4 + j) * 8 + n] = lg[kb][j] * inv; }
    WAVE_SYNC();
    f32x2 o[8];
#pragma unroll
    for (int hh = 0; hh < 8; ++hh) o[hh] = (f32x2){0.f, 0.f};
    const unsigned* cbase = (const unsigned*)(CN + rbase * 128) + lane;
    unsigned cw[8];
#pragma unroll
    for (int j = 0; j < 8; ++j) { const int key = __builtin_amdgcn_readfirstlane(ix[j]); cw[j] = cbase[(size_t)key * 64]; }
    for (int kk = 0; kk < nv; kk += 8) { unsigned nx[8];
        const int kn = (kk + 8 < nv) ? kk + 8 : kk;
#pragma unroll
        for (int j = 0; j < 8; ++j) { const int key = __builtin_amdgcn_readfirstlane(ix[kn + j]); nx[j] = cbase[(size_t)key * 64]; }
#pragma unroll
        for (int j = 0; j < 8; ++j) { const f32x2 cv = {bflo(cw[j]), bfhi(cw[j])}; const f32x4 pa = *(const LAS f32x4*)(pp + (kk + j) * 8), pb = *(const LAS f32x4*)(pp + (kk + j) * 8 + 4);
#pragma unroll
            for (int hh = 0; hh < 4; ++hh) { o[hh] += cv * pa[hh]; o[4 + hh] += cv * pb[hh]; } }
#pragma unroll
        for (int j = 0; j < 8; ++j) cw[j] = nx[j]; }
#pragma unroll
    for (int hh = 0; hh < 8; ++hh) *((unsigned*)((bf16_t*)(F.ws + WS_MG) + (size_t)qrow * 1024 + hh * 128) + lane) = pk2(o[hh].x, o[hh].y);
    }
#endif
}
__device__ __forceinline__ void ph_dsa(Frame& F, gu32* ctr, int k0, int k1) {
    volatile LAS unsigned* MISC = (volatile LAS unsigned*)(F.lds + MISC_OFF);
    const int hq = (F.bid & 7) >> 1;
    for (int qi = 0; qi < 4; ++qi) { const int q = (hq + qi) & 3;
        for (;;) {
            __syncthreads();
            if (F.tid == 0) MISC[0] = __hip_atomic_fetch_add(ctr + q * 16, 1u, RLX_AGENT);
            __syncthreads();
            const int k = k0 + (int)MISC[0];
            if (k >= k1) break;
            dsa_unit(F, k * 4 + q);
        } }
}

#ifdef PROBE_ATT
constexpr int CW_DIAG = 32768;
__device__ __forceinline__ void ph_att_cmp(Frame& F) {
    gu32* ctl = (gu32*)(F.ws + WS_CTL); const bf16_t* BA = (const bf16_t*)(F.ws + WS_BR); const bf16_t* BB = (const bf16_t*)(F.ws + WS_MG);
    const int gw = F.bid * 8 + F.wave, NGW = F.G * 8, lane = F.lane; float d2 = 0.f, r2 = 0.f;
    for (int q = gw; q < MH; q += NGW)
        for (int c = lane; c < 512; c += 64) { const unsigned wa = *((const unsigned*)(BA + (size_t)q * BRW) + c), wb = *((const unsigned*)(BB + (size_t)q * 1024) + c);
            const float a0 = bflo(wa) - bflo(wb), a1 = bfhi(wa) - bfhi(wb); d2 += a0 * a0 + a1 * a1; r2 += bflo(wb) * bflo(wb) + bfhi(wb) * bfhi(wb); }
    d2 = wave_sum(d2); r2 = wave_sum(r2);
    if (lane == 0) { atomicAdd((float*)(ctl + CW_DIAG + 64), d2); atomicAdd((float*)(ctl + CW_DIAG + 128), r2); }
}
#endif
__device__ __forceinline__ void ph_ffn_act(Frame& F, int l, int q) {
    const bf16_t* RAW = (const bf16_t*)(F.ws + WS_RAW + (size_t)(q & 1) * 88 * MiB); bf16_t* ACT = (bf16_t*)(F.ws + WS_ACT) + (size_t)q * 8192 * DFF;
    const float* cw = F.ap->in[I_FCW] + (size_t)l * 3 * 2 * DFF;
    gu32* ctr = (gu32*)(F.ws + WS_CTL) + CW_Q + (24 + l * 4 + q) * 64;
    volatile LAS unsigned* MISC = (volatile LAS unsigned*)(F.lds + MISC_OFF);
    for (;;) {
        __syncthreads();
        if (F.tid == 0) MISC[0] = __hip_atomic_fetch_add(ctr, 1u, RLX_AGENT);
        __syncthreads();
        const int rg = (int)MISC[0];
        if (rg >= 256) break;
        const int pc = F.tid;
        if (pc < 352) { const int c0 = pc * 8, j = c0 >> 7, i0 = c0 & 127, r0 = rg * 32;
            const bf16_t* gp = RAW + (size_t)r0 * (2 * DFF) + j * 256 + i0; const bf16_t* vp = gp + 128;
            float wg[3][8], wv[3][8];
#pragma unroll
            for (int k = 0; k < 3; ++k)
#pragma unroll
                for (int x = 0; x < 8; ++x) { wg[k][x] = cw[k * 2 * DFF + c0 + x]; wv[k][x] = cw[k * 2 * DFF + DFF + c0 + x]; }
            const bool head = (r0 & 4095) == 0;
            u32x4 g0 = {0, 0, 0, 0}, g1 = {0, 0, 0, 0}, v0 = {0, 0, 0, 0}, v1 = {0, 0, 0, 0};
            if (!head) { g0 = *(const u32x4*)(gp - 2 * (2 * DFF)); g1 = *(const u32x4*)(gp - (2 * DFF)); v0 = *(const u32x4*)(vp - 2 * (2 * DFF)); v1 = *(const u32x4*)(vp - (2 * DFF)); }
            for (int r = 0; r < 32; ++r) { const u32x4 g2 = *(const u32x4*)(gp + (size_t)r * (2 * DFF)), v2 = *(const u32x4*)(vp + (size_t)r * (2 * DFF)); u32x4 o;
#pragma unroll
                for (int w = 0; w < 4; ++w) {
                    const float hg0 = wg[0][2 * w] * bflo(g0[w]) + wg[1][2 * w] * bflo(g1[w]) + wg[2][2 * w] * bflo(g2[w]), hg1 = wg[0][2 * w + 1] * bfhi(g0[w]) + wg[1][2 * w + 1] * bfhi(g1[w]) + wg[2][2 * w + 1] * bfhi(g2[w]);
                    const float hv0 = wv[0][2 * w] * bflo(v0[w]) + wv[1][2 * w] * bflo(v1[w]) + wv[2][2 * w] * bflo(v2[w]), hv1 = wv[0][2 * w + 1] * bfhi(v0[w]) + wv[1][2 * w + 1] * bfhi(v1[w]) + wv[2][2 * w + 1] * bfhi(v2[w]);
                    o[w] = pk2(siluf_(hg0) * hv0, siluf_(hg1) * hv1); }
                *(u32x4*)(ACT + (size_t)(r0 + r) * DFF + c0) = o; g0 = g1; g1 = g2; v0 = v1; v1 = v2; } }
    }
}

__device__ __forceinline__ void ph_ffn_fix(Frame& F, int l) {
    const bf16_t* HALO = (const bf16_t*)(F.ws + WS_FHALO); const bf16_t* FIRST = (const bf16_t*)(F.ws + WS_FFIRST); bf16_t* ACT = (bf16_t*)(F.ws + WS_ACT);
    const float* cw = F.ap->in[I_FCW] + (size_t)l * 3 * 2 * DFF;
    const int gt = F.bid * 512 + F.tid, NT = F.G * 512;
    for (int e = gt; e < 128 * 22 * 16; e += NT) { const int cg = e & 15, pn = (e >> 4) % 22, pm = (e >> 4) / 22, cb = cg * 8;
        if ((pm & 15) == 0) continue;
        const bf16_t* hp = HALO + ((size_t)((pm - 1) * 22 + pn) * 2) * 256 + cb; const bf16_t* fp = FIRST + ((size_t)(pm * 22 + pn) * 2) * 256 + cb;
        const u32x4 hg0 = *(const u32x4*)hp, hg1 = *(const u32x4*)(hp + 256), fg0 = *(const u32x4*)fp, fg1 = *(const u32x4*)(fp + 256);
        const u32x4 hv0 = *(const u32x4*)(hp + 128), hv1 = *(const u32x4*)(hp + 256 + 128), fv0 = *(const u32x4*)(fp + 128), fv1 = *(const u32x4*)(fp + 256 + 128);
        u32x4 o0, o1;
#pragma unroll
        for (int q = 0; q < 4; ++q) { float r0[2], r1[2];
#pragma unroll
            for (int hl = 0; hl < 2; ++hl) { const int c = pn * 128 + cb + 2 * q + hl;
                const float wg0 = cw[c], wg1 = cw[2 * DFF + c], wg2 = cw[4 * DFF + c], wv0 = cw[DFF + c], wv1 = cw[2 * DFF + DFF + c], wv2 = cw[4 * DFF + DFF + c];
                const float Hg0 = hl ? bfhi(hg0[q]) : bflo(hg0[q]), Hg1 = hl ? bfhi(hg1[q]) : bflo(hg1[q]), Fg0 = hl ? bfhi(fg0[q]) : bflo(fg0[q]), Fg1 = hl ? bfhi(fg1[q]) : bflo(fg1[q]);
                const float Hv0 = hl ? bfhi(hv0[q]) : bflo(hv0[q]), Hv1 = hl ? bfhi(hv1[q]) : bflo(hv1[q]), Fv0 = hl ? bfhi(fv0[q]) : bflo(fv0[q]), Fv1 = hl ? bfhi(fv1[q]) : bflo(fv1[q]);
                r0[hl] = siluf_(wg0 * Hg0 + wg1 * Hg1 + wg2 * Fg0) * (wv0 * Hv0 + wv1 * Hv1 + wv2 * Fv0);
                r1[hl] = siluf_(wg0 * Hg1 + wg1 * Fg0 + wg2 * Fg1) * (wv0 * Hv1 + wv1 * Fv0 + wv2 * Fv1); }
            o0[q] = pk2(r0[0], r0[1]); o1[q] = pk2(r1[0], r1[1]); }
        *(u32x4*)(ACT + (size_t)(pm * 256) * DFF + pn * 128 + cb) = o0; *(u32x4*)(ACT + (size_t)(pm * 256 + 1) * DFF + pn * 128 + cb) = o1; }
}

__device__ __forceinline__ void ph_final(Frame& F) {
    float* X = F.ap->out; const float* SS = (const float*)(F.ws + WS_SS); const float* g = F.ap->in[I_FING];
    const int gw = F.bid * 8 + F.wave, NGW = F.G * 8;
    float dscale = 1.f;
#ifdef PROBE_ATT
    { const float* dg = (const float*)((const unsigned*)(F.ws + WS_CTL) + CW_DIAG); dscale = 1.f + sqrtf(dg[64] / fmaxf(dg[128], 1e-30f)); }
#endif
    const bf16_t* XB = (const bf16_t*)(F.ws + WS_XB);
    for (int r = gw; r < M; r += NGW) { const float rs = row_rstd(SS, r) * dscale; f32x4* xr = (f32x4*)(X + (size_t)r * D) + F.lane; const f32x4* gr = (const f32x4*)g + F.lane;
        const u32x2* xb = (const u32x2*)(XB + (size_t)r * D) + F.lane;
#pragma unroll
        for (int j = 0; j < 4; ++j) { const u32x2 w = xb[64 * j]; f32x4 v = {bflo(w.x), bfhi(w.x), bflo(w.y), bfhi(w.y)}; const f32x4 gg = gr[64 * j]; v = v * rs * gg; xr[64 * j] = v; } }
}

constexpr int DSA_Q1 = 1792;
#ifdef PROBE_ATT
constexpr int PH_PER_HALF = 8,
#else
constexpr int PH_PER_HALF = 6,
#endif
    PH_PER_LAYER = 1 + NHALF * PH_PER_HALF + 3 - (NHALF - 1), NPHASE = NLAYER * PH_PER_LAYER + 1;

__global__ void __launch_bounds__(512, 2) fwd(Args args) {
    extern __shared__ __attribute__((aligned(16))) unsigned char lds_raw[];
    Frame F0;
    F0.lds = (LAS unsigned char*)lds_raw; F0.ap = (CArgs*)__builtin_amdgcn_kernarg_segment_ptr(); F0.ws = nullptr;
    F0.tid = threadIdx.x; F0.lane = F0.tid & 63; F0.wave = __builtin_amdgcn_readfirstlane(F0.tid >> 6); F0.G = gridDim.x; F0.bid = blockIdx.x;
    volatile LAS unsigned* MISC = (volatile LAS unsigned*)(F0.lds + MISC_OFF);
    if (F0.tid < 64) MISC[F0.tid] = 0u;
    __syncthreads();
    const int lo = args.ph_lo, hi = args.ph_hi;
    XcdBarrier bar; bar.bar = (unsigned*)(args.ws + WS_CTL) + CW_BAR; bar.x = 0; bar.st = nullptr;
    if (hi - lo > 1) bar = xcd_barrier_post((unsigned*)(args.ws + WS_CTL) + CW_BAR, MISC + 8);
    int pc = 0;
#ifndef SITE_MASK
#define SITE_MASK 0xFFFFFFFFu
#endif
#ifndef DUP_MASK
#define DUP_MASK 0u
#endif
#define PH_BEGIN(id) if (((SITE_MASK >> (id)) & 1u) && pc >= lo && pc < hi) for (int rep_ = 0, nrep_ = 1 + ((DUP_MASK >> (id)) & 1u); rep_ < nrep_; ++rep_) { Frame F = F0; asm volatile("v_mbcnt_lo_u32_b32 %0, -1, 0\n\tv_mbcnt_hi_u32_b32 %0, -1, %0" : "=v"(F.lane)); asm volatile("" : "+s"(F.ap), "+s"(F.wave)); F.tid = F.wave * 64 + F.lane; F.ws = F.ap->ws; \
        LAS unsigned char* glds = F.lds; bf16_t* XB = (bf16_t*)(F.ws + WS_XB); float* SS = (float*)(F.ws + WS_SS); bf16_t* P1 = (bf16_t*)(F.ws + WS_P1); bf16_t* BR = (bf16_t*)(F.ws + WS_BR); bf16_t* MG = (bf16_t*)(F.ws + WS_MG); \
        (void)glds; (void)XB; (void)SS; (void)P1; (void)BR; (void)MG;
#define PH_END if (pc + 1 < hi || rep_ + 1 < nrep_) xcd_barrier(bar); } ++pc;
#define RELAUNDER do { asm volatile("v_mbcnt_lo_u32_b32 %0, -1, 0\n\tv_mbcnt_hi_u32_b32 %0, -1, %0" : "=v"(F.lane)); asm volatile("" : "+s"(F.ap), "+s"(F.wave)); F.tid = F.wave * 64 + F.lane; F.ws = F.ap->ws; } while (0)

    for (int l = 0; l < NLAYER; ++l) {
        PH_BEGIN(1) ph_wprep(F, l); if (l == 0) ph_x0(F); PH_END
        for (int h = 0; h < NHALF; ++h) {
            const size_t r0 = (size_t)h * MH;
            if (h == 0) {
            PH_BEGIN(2)
                pg8::Gemm g{XB + r0 * D, (const bf16_t*)(F.ws + WS_WIN1), D, D, D}; pg8::StaticOrder S; S.init(MH, P1W, F.G, F.bid);
                EpiNormBf16<2> E{P1, P1W, rstd_table(F, S, SS + r0 * 16), (bf16_t*)(F.ws + WS_S5A), (bf16_t*)(F.ws + WS_IKC)}; pg8::gemm_phase(glds, F.tid, g, S, E);
            PH_END
            }
            PH_BEGIN(3) ph_prep_a(F, l); ph_gdn_prep(F, l); PH_END
            PH_BEGIN(5)
                if (F.bid < 16) ph_gdn_chain(F, l);
                gu32* s5c = (gu32*)(F.ws + WS_CTL) + CW_Q + (40 + l * 2 + h) * 64;
                for (int su = (F.bid - 16 + F.G) % F.G; su < 128; su += F.G) {
                    s5_unit(F, su >> 2, su & 3);
                    if (F.tid == 0) { __builtin_amdgcn_fence(__ATOMIC_RELEASE, "agent"); asm volatile("s_waitcnt vmcnt(0)" ::: "memory"); (void)xb_add((unsigned*)s5c + (su & 3) * 16, 1u); }
                    RELAUNDER; }
                for (int su = (F.bid - 16 + F.G) % F.G; su < 128; su += F.G) { const int pm = su >> 1, pn = su & 1;
                    if (F.tid == 0) { unsigned sp = 0u;
                        while (xb_ld((unsigned*)s5c + (pm >> 4) * 16) < 32u) { __builtin_amdgcn_s_sleep(1); if (++sp > XB_SPIN_CAP) break; }
                        __builtin_amdgcn_fence(__ATOMIC_ACQUIRE, "agent"); asm volatile("s_waitcnt vmcnt(0)" ::: "memory"); }
                    __syncthreads();
                    { pg8::Gemm g{(const bf16_t*)(F.ws + WS_YG), (const bf16_t*)(F.ws + WS_WGLU), 512, 512, 512}; OneUnit U{pm, pn};
                      EpiS5G E{(const bf16_t*)(F.ws + WS_YG), BR}; pg8::gemm_phase(glds, F.tid, g, U, E); }
                    RELAUNDER; }
                RELAUNDER;
                ph_dsa(F, (gu32*)(F.ws + WS_CTL) + CW_Q + ((l * 2 + h) * 2 + 0) * 64, 0, 512);
            PH_END
#ifdef PROBE_ATT
            PH_BEGIN(22) ph_att_cmp(F); PH_END
#endif
            PH_BEGIN(13)
                pg8::Gemm g{XB + r0 * D, (const bf16_t*)(F.ws + WS_WIN2), D, D, D}; pg8::StaticOrder S; S.init(MH, GW, F.G, F.bid);
                EpiNormBf16<1> E{P1, GW, rstd_table(F, S, SS + r0 * 16), nullptr, nullptr}; pg8::gemm_phase(glds, F.tid, g, S, E);
            PH_END
            PH_BEGIN(14)
                pg8::Gemm g{BR, (const bf16_t*)(F.ws + WS_WMRG), BRW, BRW, BRW}; pg8::StaticOrder S; S.init(MH, D, F.G, F.bid);
                EpiMerge E{MG, P1}; pg8::gemm_phase(glds, F.tid, g, S, E);
            PH_END
            PH_BEGIN(15)
                pg8::Gemm g{MG, (const bf16_t*)(F.ws + WS_WOUT), D, D, D}; pg8::StaticOrder S; S.init(MH, D, F.G, F.bid);
                float* xf = F.ap->out;
                EpiResid E{xf + r0 * D, XB + r0 * D, SS + r0 * 16, false}; pg8::gemm_phase(glds, F.tid, g, S, E);
                if (h + 1 < NHALF) {
                    RELAUNDER;
                    const size_t r1 = r0 + MH;
                    pg8::Gemm g1{XB + r1 * D, (const bf16_t*)(F.ws + WS_WIN1), D, D, D}; pg8::StaticOrder S1; S1.init(MH, P1W, F.G, F.bid);
                    EpiNormBf16<2> E1{P1, P1W, rstd_table(F, S1, SS + r1 * 16), (bf16_t*)(F.ws + WS_S5A), (bf16_t*)(F.ws + WS_IKC)}; pg8::gemm_phase(glds, F.tid, g1, S1, E1); }
            PH_END
        }
        PH_BEGIN(16)
            pg8::Gemm g{XB, (const bf16_t*)(F.ws + WS_WUP), D, D, D}; pg8::StaticOrder S; S.init(M, 2 * DFF, F.G, F.bid);
            EpiUpConv E{(bf16_t*)(F.ws + WS_ACT), rstd_table(F, S, SS), F.lds + 131072 + 11264, F.ap->in[I_FCW] + (size_t)l * 3 * 2 * DFF, (bf16_t*)(F.ws + WS_FHALO), (bf16_t*)(F.ws + WS_FFIRST)};
            pg8::gemm_phase(glds, F.tid, g, S, E);
        PH_END
        PH_BEGIN(17) ph_ffn_fix(F, l); PH_END
        PH_BEGIN(18)
            pg8::Gemm g{(const bf16_t*)(F.ws + WS_ACT), (const bf16_t*)(F.ws + WS_WDN), DFF, DFF, DFF}; pg8::StaticOrder S; S.init(M, D, F.G, F.bid);
            float* xf = F.ap->out;
            EpiResid E{xf, XB, SS, false}; pg8::gemm_phase(glds, F.tid, g, S, E);
        PH_END
    }
    PH_BEGIN(19) ph_final(F); PH_END
}

extern "C" void kernel_launch(void* const* d_in, const int* in_sizes, int n_in, void* d_out, int out_size, void* d_ws, size_t ws_size, hipStream_t stream) {
    static int grid = 0;
    if (grid == 0) {
        if (n_in != 28 || in_sizes[0] != M * D || out_size != M * D || ws_size < WS_END) { fprintf(stderr, "kernel_launch: unexpected shapes (n_in %d, ws %zu)\n", n_in, ws_size); grid = -1; return; }
        int dev = 0, cus = 0, per_cu = 0;
        if (hipGetDevice(&dev) != hipSuccess || hipDeviceGetAttribute(&cus, hipDeviceAttributeMultiprocessorCount, dev) != hipSuccess) { grid = -1; return; }
        if (hipFuncSetAttribute((const void*)fwd, hipFuncAttributeMaxDynamicSharedMemorySize, LDS_BYTES) != hipSuccess) { grid = -1; return; }
        if (hipOccupancyMaxActiveBlocksPerMultiprocessor(&per_cu, (const void*)fwd, 512, LDS_BYTES) != hipSuccess || per_cu < 1) fprintf(stderr, "kernel_launch: occupancy query says %d\n", per_cu);
        (void)hipGetLastError();
        grid = cus;
    }
    if (grid < 0) return;
    (void)hipMemsetAsync((char*)d_ws + WS_CTL, 0, CTL_ZERO_BYTES, stream);
    Args a{};
    for (int i = 0; i < 28; ++i) a.in[i] = (const float*)d_in[i];
    a.out = (float*)d_out; a.ws = (unsigned char*)d_ws;
#if MK_ONE_LAUNCH
    a.ph_lo = 0; a.ph_hi = NPHASE;
    hipLaunchKernelGGL(fwd, dim3(grid), dim3(512), LDS_BYTES, stream, a);
#else
    for (int p = 0; p < NPHASE; ++p) { a.ph_lo = p; a.ph_hi = p + 1; hipLaunchKernelGGL(fwd, dim3(grid), dim3(512), LDS_BYTES, stream, a); }
#endif
}
```
